# Optimizing an MI355X kernel written in HIP

```python
import jax, jax.numpy as jnp
from jax import lax
import numpy as np

D_MODEL = 1024
BATCH = 1
SEQ = 16384
DEPTH = 2
DEC_BATCH = 4
DEC_SEQ = 4096
PAST_LEN = 128

HEAD_DIM = 64
GRID_W = 64
BLOCK = 128
D_FF = 2816
EPS = 1e-6
NEG = -1e30
A_HEADS = 8
A_BRANCHES = ((128, 1), (512, 4), (2048, 16))
B_Q_HEADS = 8
B_KV_HEADS = 2
ROPE_THETA = 10000.0
C_Q_HEADS = 16
C_KV_HEADS = 4
C_WINDOW = 128

N_EVEN = (DEPTH + 1) // 2
N_ODD = DEPTH // 2
A_W = A_HEADS * HEAD_DIM
BQ_W = B_Q_HEADS * HEAD_DIM
BKV_W = B_KV_HEADS * HEAD_DIM
AB_COLS = 3 * A_W + BQ_W + 2 * BKV_W
AB_OUT = A_W + BQ_W
CQ_W = C_Q_HEADS * HEAD_DIM
CKV_W = C_KV_HEADS * HEAD_DIM
C_COLS = CQ_W + 2 * CKV_W

kernel_name = "hybrid_dilated_axial_sink_encoder"


def alibi_slopes(n):
    return jnp.asarray(2.0 ** (-8.0 * (np.arange(n) + 1) / n), dtype=jnp.float32)


def rmsnorm(x, g):
    xf = x.astype(jnp.float32)
    y = xf * lax.rsqrt(jnp.mean(xf * xf, axis=-1, keepdims=True) + EPS)
    return (y * g.astype(jnp.float32)).astype(x.dtype)


def swiglu(x, w1, w3, w2):
    return (jax.nn.silu(x @ w1) * (x @ w3)) @ w2


def dilated_attention(q, k, v, slopes):
    bsz, T, H, Dh = q.shape
    nb = T // BLOCK
    scale = Dh ** -0.5
    offsets = [np.arange(-(w // (2 * d)), w // (2 * d) + 1) * d for (w, d) in A_BRANCHES]
    qb = q.reshape(bsz, nb, BLOCK, H, Dh).swapaxes(0, 1)
    starts = jnp.arange(nb) * BLOCK

    def one_block(args):
        qblk, start = args
        qf = qblk.astype(jnp.float32) * scale
        qpos = start + jnp.arange(BLOCK)
        ms, ls, os_ = [], [], []
        for off in offsets:
            off_j = jnp.asarray(off, dtype=jnp.int32)
            idx = qpos[:, None] + off_j[None, :]
            valid = (idx >= 0) & (idx < T)
            idxc = jnp.clip(idx, 0, T - 1)
            kg = jnp.take(k, idxc, axis=1).astype(jnp.float32)
            vg = jnp.take(v, idxc, axis=1).astype(jnp.float32)
            s = jnp.einsum('bqhd,bqkhd->bhqk', qf, kg)
            s = s - slopes[:, None, None] * jnp.abs(off_j.astype(jnp.float32))[None, None, :]
            s = jnp.where(valid[None, None], s, NEG)
            m = jnp.max(s, axis=-1, keepdims=True)
            p = jnp.exp(s - m)
            l = jnp.sum(p, axis=-1, keepdims=True)
            o = jnp.einsum('bhqk,bqkhd->bhqd', p, vg) / l
            ms.append(m); ls.append(l); os_.append(o)
        m_all = jnp.stack(ms)
        wgt = jnp.exp(m_all - jnp.max(m_all, axis=0, keepdims=True)) * jnp.stack(ls)
        out = jnp.sum(wgt * jnp.stack(os_), axis=0) / jnp.sum(wgt, axis=0)
        return out.transpose(0, 2, 1, 3)

    out = lax.map(one_block, (qb, starts))
    return out.swapaxes(0, 1).reshape(bsz, T, H, Dh)


def axial_rope(T):
    rows = T // GRID_W
    row = jnp.repeat(jnp.arange(rows), GRID_W).astype(jnp.float32)
    col = jnp.tile(jnp.arange(GRID_W), rows).astype(jnp.float32)
    half = HEAD_DIM // 2
    freqs = ROPE_THETA ** (-jnp.arange(0, half, 2, dtype=jnp.float32) / half)
    ang = jnp.concatenate([row[:, None] * freqs, col[:, None] * freqs], axis=-1)
    return jnp.cos(ang)[:, None, :], jnp.sin(ang)[:, None, :]


def apply_rope(x, cos, sin):
    xf = x.astype(jnp.float32)
    x1, x2 = xf[..., 0::2], xf[..., 1::2]
    r = jnp.stack([x1 * cos - x2 * sin, x1 * sin + x2 * cos], axis=-1)
    return r.reshape(xf.shape)


def global_gqa(q, k, v):
    bsz, T, Hq, Dh = q.shape
    Hkv = k.shape[2]
    G = Hq // Hkv
    nb = T // BLOCK
    scale = Dh ** -0.5
    kf = k.astype(jnp.float32)
    vf = v.astype(jnp.float32)
    qb = (q * scale).reshape(bsz, nb, BLOCK, Hkv, G, Dh).swapaxes(0, 1)

    def one_block(qblk):
        s = jnp.einsum('bqhgd,bkhd->bhgqk', qblk, kf)
        p = jax.nn.softmax(s, axis=-1)
        return jnp.einsum('bhgqk,bkhd->bqhgd', p, vf)

    out = lax.map(one_block, qb)
    return out.swapaxes(0, 1).reshape(bsz, T, Hq, Dh)


def banded_sink_gqa(q, k, v, sinks, slopes):
    bsz, T, Hq, Dh = q.shape
    Hkv = k.shape[2]
    G = Hq // Hkv
    nb = T // BLOCK
    scale = Dh ** -0.5
    qb = q.astype(jnp.float32).reshape(bsz, nb, BLOCK, Hkv, G, Dh) * scale

    def band(x):
        xp = jnp.pad(x.astype(jnp.float32), ((0, 0), (BLOCK, BLOCK), (0, 0), (0, 0)))
        xp = xp.reshape(bsz, nb + 2, BLOCK, Hkv, Dh)
        return jnp.concatenate([xp[:, :-2], xp[:, 1:-1], xp[:, 2:]], axis=2)

    kw, vw = band(k), band(v)
    rel = (jnp.arange(3 * BLOCK) - BLOCK)[None, :] - jnp.arange(BLOCK)[:, None]
    kpos = (jnp.arange(nb) * BLOCK)[:, None] + jnp.arange(3 * BLOCK)[None, :] - BLOCK
    valid = (jnp.abs(rel)[None] <= C_WINDOW) & ((kpos >= 0) & (kpos < T))[:, None, :]
    s = jnp.einsum('bnqhgd,bnkhd->bnhgqk', qb, kw)
    s = s - slopes.reshape(Hkv, G)[:, :, None, None] * jnp.abs(rel).astype(jnp.float32)
    s = jnp.where(valid[None, :, None, None], s, NEG)
    sk = sinks.astype(jnp.float32).reshape(Hkv, G)[:, :, None, None]
    m = jnp.maximum(jnp.max(s, axis=-1, keepdims=True), sk)
    p = jnp.exp(s - m)
    denom = jnp.sum(p, axis=-1, keepdims=True) + jnp.exp(sk - m)
    o = jnp.einsum('bnhgqk,bnkhd->bnqhgd', p / denom, vw)
    return o.reshape(bsz, T, Hq, Dh)


def mixer_ab(u, w_in, w_out, q_gain, k_gain):
    bsz, T, _ = u.shape
    proj = u @ w_in
    splits = list(np.cumsum([A_W, A_W, A_W, BQ_W, BKV_W]))
    aq, ak, av, bq, bk, bv = jnp.split(proj, splits, axis=-1)
    shp = lambda t, h: t.reshape(bsz, T, h, HEAD_DIM)
    a_out = dilated_attention(shp(aq, A_HEADS), shp(ak, A_HEADS), shp(av, A_HEADS), alibi_slopes(A_HEADS))
    cos, sin = axial_rope(T)
    bqh = apply_rope(rmsnorm(shp(bq, B_Q_HEADS), q_gain), cos, sin)
    bkh = apply_rope(rmsnorm(shp(bk, B_KV_HEADS), k_gain), cos, sin)
    b_out = global_gqa(bqh, bkh, shp(bv, B_KV_HEADS))
    cat = jnp.concatenate([a_out.reshape(bsz, T, A_W), b_out.reshape(bsz, T, BQ_W)], axis=-1).astype(u.dtype)
    return cat @ w_out


def mixer_c(u, w_in, w_out, sinks):
    bsz, T, _ = u.shape
    proj = u @ w_in
    cq, ck, cv = jnp.split(proj, [CQ_W, CQ_W + CKV_W], axis=-1)
    o = banded_sink_gqa(cq.reshape(bsz, T, C_Q_HEADS, HEAD_DIM), ck.reshape(bsz, T, C_KV_HEADS, HEAD_DIM),
                        cv.reshape(bsz, T, C_KV_HEADS, HEAD_DIM), sinks, alibi_slopes(C_Q_HEADS))
    return o.reshape(bsz, T, CQ_W).astype(u.dtype) @ w_out


def trunk(x, norm_g, ffn_w1, ffn_w3, ffn_w2, ab_w_in, ab_w_out, ab_q_gain, ab_k_gain,
          c_w_in, c_w_out, c_sink, final_g):
    h = x
    for layer in range(DEPTH):
        h = h + 0.5 * swiglu(rmsnorm(h, norm_g[layer, 0]), ffn_w1[layer, 0], ffn_w3[layer, 0], ffn_w2[layer, 0])
        u = rmsnorm(h, norm_g[layer, 1])
        i = layer // 2
        if layer % 2 == 0:
            h = h + mixer_ab(u, ab_w_in[i], ab_w_out[i], ab_q_gain[i], ab_k_gain[i])
        else:
            h = h + mixer_c(u, c_w_in[i], c_w_out[i], c_sink[i])
        h = h + 0.5 * swiglu(rmsnorm(h, norm_g[layer, 2]), ffn_w1[layer, 1], ffn_w3[layer, 1], ffn_w2[layer, 1])
    return rmsnorm(h, final_g)


def setup_inputs(seed: int = 0) -> dict:
    key = jax.random.key(seed)
    ks = jax.random.split(key, 16)
    f32 = jnp.float32
    nrm = lambda k, shape, fan_in: jax.random.normal(k, shape, f32) * (fan_in ** -0.5)
    return {
        "x_prompt": jax.random.normal(ks[0], (BATCH, SEQ, D_MODEL), f32),
        "x_sample": jax.random.normal(ks[1], (DEC_BATCH, DEC_SEQ, D_MODEL), f32),
        "norm_g": 1.0 + 0.01 * jax.random.normal(ks[2], (DEPTH, 3, D_MODEL), f32),
        "ffn_w1": nrm(ks[3], (DEPTH, 2, D_MODEL, D_FF), D_MODEL),
        "ffn_w3": nrm(ks[4], (DEPTH, 2, D_MODEL, D_FF), D_MODEL),
        "ffn_w2": nrm(ks[5], (DEPTH, 2, D_FF, D_MODEL), D_FF),
        "ab_w_in": nrm(ks[6], (N_EVEN, D_MODEL, AB_COLS), D_MODEL),
        "ab_w_out": nrm(ks[7], (N_EVEN, AB_OUT, D_MODEL), AB_OUT),
        "ab_q_gain": 1.0 + 0.01 * jax.random.normal(ks[8], (N_EVEN, HEAD_DIM), f32),
        "ab_k_gain": 1.0 + 0.01 * jax.random.normal(ks[9], (N_EVEN, HEAD_DIM), f32),
        "c_w_in": nrm(ks[10], (N_ODD, D_MODEL, C_COLS), D_MODEL),
        "c_w_out": nrm(ks[11], (N_ODD, CQ_W, D_MODEL), CQ_W),
        "c_sink": jax.random.normal(ks[12], (N_ODD, C_Q_HEADS), f32),
        "final_g": 1.0 + 0.01 * jax.random.normal(ks[13], (D_MODEL,), f32),
    }


def reference(x_prompt, x_sample, norm_g, ffn_w1, ffn_w3, ffn_w2, ab_w_in, ab_w_out, ab_q_gain, ab_k_gain,
              c_w_in, c_w_out, c_sink, final_g):
    y_prompt = trunk(x_prompt, norm_g, ffn_w1, ffn_w3, ffn_w2, ab_w_in, ab_w_out, ab_q_gain, ab_k_gain,
                     c_w_in, c_w_out, c_sink, final_g)
    y_sample = trunk(x_sample, norm_g, ffn_w1, ffn_w3, ffn_w2, ab_w_in, ab_w_out, ab_q_gain, ab_k_gain,
                     c_w_in, c_w_out, c_sink, final_g)
    return (y_prompt, y_sample)
```

```cpp
#include <hip/hip_runtime.h>
#include <hip/hip_cooperative_groups.h>
#include <cstdio>
namespace cg = cooperative_groups;

typedef unsigned short bf16_t;
typedef short bf16x8 __attribute__((ext_vector_type(8)));
typedef float f32x16 __attribute__((ext_vector_type(16)));
#define DI __device__ __forceinline__
#define MFMA32(a, b, c) __builtin_amdgcn_mfma_f32_32x32x16_bf16((a), (b), (c), 0, 0, 0)

constexpr int NTOK = 32768, DM = 1024, DFF = 2816;
constexpr int PROMPT_T = 16384, SAMPLE_T = 4096;
constexpr float EPS = 1e-6f;
constexpr float LOG2E = 1.4426950408889634f;

constexpr size_t W_UPA = 0, W_DNA = 5767168, W_UPB = 8650752, W_DNB = 14417920, W_IN = 17301504, W_OUT = 19660800, W_TOTAL = 20709376;

struct Params {
  const float* x_prompt; const float* x_sample; const float* norm_g; const float* w1; const float* w3; const float* w2;
  const float* ab_w_in; const float* ab_w_out; const float* ab_qg; const float* ab_kg;
  const float* c_w_in; const float* c_w_out; const float* c_sink; const float* final_g;
  float* h; bf16_t* wts; bf16_t* xn; bf16_t* big;
  int ffn_chunks; int pad;
};

DI bf16_t f2bf(float x) { unsigned u = __float_as_uint(x); u += 0x7fffu + ((u >> 16) & 1u); return (bf16_t)(u >> 16); }
DI float bf2f(bf16_t v) { return __uint_as_float(((unsigned)v) << 16); }
DI float bflo(unsigned u) { return __uint_as_float(u << 16); }
DI float bfhi(unsigned u) { return __uint_as_float(u & 0xffff0000u); }
DI unsigned pack2(float lo, float hi) { return (unsigned)f2bf(lo) | ((unsigned)f2bf(hi) << 16); }
DI int crow(int reg, int h) { return (reg & 3) + 8 * (reg >> 2) + 4 * h; }

DI void convert_tile(const float* __restrict__ src, int K, int N, int kt, int nt, bf16_t* __restrict__ dst, int mode, float* lds) {
  const int tid = threadIdx.x;
#pragma unroll 4
  for (int i = 0; i < 16; ++i) { int e = tid + 256 * i; int kk = e >> 6, nn = e & 63; lds[kk * 65 + nn] = src[(size_t)(kt * 64 + kk) * N + nt * 64 + nn]; }
  __syncthreads();
#pragma unroll 4
  for (int i = 0; i < 16; ++i) {
    int e = tid + 256 * i; int nn = e >> 6, kk = e & 63; int n = nt * 64 + nn;
    int drow = (mode == 0) ? n : ((n >> 5) * 64 + (n & 31) + (mode == 2 ? 32 : 0));
    dst[(size_t)drow * K + kt * 64 + kk] = f2bf(lds[kk * 65 + nn]);
  }
  __syncthreads();
}

DI void convert_phase(const Params& p, int layer, float* lds) {
  const int n_in = (layer == 0) ? 2304 : 1536;
  const int t_up = 16 * 44, t_dn = 44 * 16, t_in = 16 * (n_in / 64), t_out = 16 * 16;
  const int total = 4 * t_up + 2 * t_dn + t_in + t_out;
  for (int u = blockIdx.x; u < total; u += gridDim.x) {
    int r = u; const float* src; bf16_t* dst; int K, N, mode;
    if (r < 6 * t_up) {
      int mtx = r / t_up; r -= mtx * t_up; int f = mtx / 3, which = mtx % 3;
      size_t base = (size_t)(layer * 2 + f) * DM * DFF;
      if (which == 0) { src = p.w1 + base; K = DM; N = DFF; mode = 1; dst = p.wts + (f ? W_UPB : W_UPA); }
      else if (which == 1) { src = p.w3 + base; K = DM; N = DFF; mode = 2; dst = p.wts + (f ? W_UPB : W_UPA); }
      else { src = p.w2 + base; K = DFF; N = DM; mode = 0; dst = p.wts + (f ? W_DNB : W_DNA); }
    } else if (r < 6 * t_up + t_in) {
      r -= 6 * t_up; src = (layer == 0) ? p.ab_w_in : p.c_w_in; K = DM; N = n_in; mode = 0; dst = p.wts + W_IN;
    } else {
      r -= 6 * t_up + t_in; src = (layer == 0) ? p.ab_w_out : p.c_w_out; K = DM; N = DM; mode = 0; dst = p.wts + W_OUT;
    }
    const int ntn = N / 64; const int kt = r / ntn, nt = r % ntn;
    convert_tile(src, K, N, kt, nt, dst, mode, lds);
  }
}

DI void norm_phase(const Params& p, int mode, const float* __restrict__ g) {
  const int lane = threadIdx.x & 63, wave = threadIdx.x >> 6;
  float4 gv[4];
#pragma unroll
  for (int i = 0; i < 4; ++i) gv[i] = *(const float4*)(g + lane * 4 + 256 * i);
  for (int row = blockIdx.x * 4 + wave; row < NTOK; row += gridDim.x * 4) {
    const float* src = (mode == 0) ? ((row < PROMPT_T) ? p.x_prompt + (size_t)row * DM : p.x_sample + (size_t)(row - PROMPT_T) * DM) : p.h + (size_t)row * DM;
    float4 v[4]; float ss = 0.f;
#pragma unroll
    for (int i = 0; i < 4; ++i) { v[i] = *(const float4*)(src + lane * 4 + 256 * i); ss += v[i].x * v[i].x + v[i].y * v[i].y + v[i].z * v[i].z + v[i].w * v[i].w; }
#pragma unroll
    for (int o = 32; o > 0; o >>= 1) ss += __shfl_xor(ss, o);
    const float r = rsqrtf(ss * (1.0f / DM) + EPS);
#pragma unroll
    for (int i = 0; i < 4; ++i) {
      float4 y; y.x = v[i].x * r * gv[i].x; y.y = v[i].y * r * gv[i].y; y.z = v[i].z * r * gv[i].z; y.w = v[i].w * r * gv[i].w;
      if (mode == 0) *(float4*)(p.h + (size_t)row * DM + lane * 4 + 256 * i) = v[i];
      if (mode == 2) *(float4*)(p.h + (size_t)row * DM + lane * 4 + 256 * i) = y;
      else { uint2 o2; o2.x = pack2(y.x, y.y); o2.y = pack2(y.z, y.w); *(uint2*)(p.xn + (size_t)row * DM + lane * 4 + 256 * i) = o2; }
    }
  }
}

constexpr int GS = 72;
constexpr int G_TILE = 128 * GS;
constexpr int EPI_UP = 0, EPI_RESID = 1, EPI_BF16 = 2;

template <int EPI>
DI void gemm_phase(const bf16_t* __restrict__ A, int lda, const bf16_t* __restrict__ Bt, int K, int M, int N,
                   void* outp, int ldc, float coef, bf16_t* lds) {
  const int tid = threadIdx.x, lane = tid & 63, wave = tid >> 6, wm = wave >> 1, wn = wave & 1, r32 = lane & 31, hh = lane >> 5;
  bf16_t* As = lds; bf16_t* Bs = lds + 2 * G_TILE;
  const int NT = N / 128, MT = M / 128, ntiles = MT * NT, nk = K / 64;
  const int prow = tid >> 3, pc = tid & 7;
  for (int t = blockIdx.x; t < ntiles; t += gridDim.x) {
    const int mt = t / NT, nt = t % NT; const int m0 = mt * 128, n0 = nt * 128;
    const bf16_t* Ag = A + (size_t)(m0 + prow) * lda + pc * 8;
    const bf16_t* Bg = Bt + (size_t)(n0 + prow) * K + pc * 8;
    f32x16 acc[2][2];
#pragma unroll
    for (int i = 0; i < 2; ++i)
#pragma unroll
      for (int j = 0; j < 2; ++j)
#pragma unroll
        for (int r = 0; r < 16; ++r) acc[i][j][r] = 0.f;
    uint4 ra[4], rb[4];
#pragma unroll
    for (int i = 0; i < 4; ++i) { ra[i] = *(const uint4*)(Ag + (size_t)(32 * i) * lda); rb[i] = *(const uint4*)(Bg + (size_t)(32 * i) * K); }
#pragma unroll
    for (int i = 0; i < 4; ++i) { *(uint4*)(As + (prow + 32 * i) * GS + pc * 8) = ra[i]; *(uint4*)(Bs + (prow + 32 * i) * GS + pc * 8) = rb[i]; }
    __syncthreads();
    for (int kt = 0; kt < nk; ++kt) {
      const int buf = kt & 1;
      if (kt + 1 < nk) {
#pragma unroll
        for (int i = 0; i < 4; ++i) { ra[i] = *(const uint4*)(Ag + (size_t)(32 * i) * lda + (kt + 1) * 64); rb[i] = *(const uint4*)(Bg + (size_t)(32 * i) * K + (kt + 1) * 64); }
      }
      const bf16_t* Ab = As + buf * G_TILE + (wm * 64 + r32) * GS + hh * 8;
      const bf16_t* Bb = Bs + buf * G_TILE + (wn * 64 + r32) * GS + hh * 8;
#pragma unroll
      for (int ks = 0; ks < 4; ++ks) {
        bf16x8 a0 = *(const bf16x8*)(Ab + ks * 16), a1 = *(const bf16x8*)(Ab + 32 * GS + ks * 16);
        bf16x8 b0 = *(const bf16x8*)(Bb + ks * 16), b1 = *(const bf16x8*)(Bb + 32 * GS + ks * 16);
        acc[0][0] = MFMA32(a0, b0, acc[0][0]); acc[0][1] = MFMA32(a0, b1, acc[0][1]);
        acc[1][0] = MFMA32(a1, b0, acc[1][0]); acc[1][1] = MFMA32(a1, b1, acc[1][1]);
      }
      if (kt + 1 < nk) {
        bf16_t* Aw = As + (buf ^ 1) * G_TILE; bf16_t* Bw = Bs + (buf ^ 1) * G_TILE;
#pragma unroll
        for (int i = 0; i < 4; ++i) { *(uint4*)(Aw + (prow + 32 * i) * GS + pc * 8) = ra[i]; *(uint4*)(Bw + (prow + 32 * i) * GS + pc * 8) = rb[i]; }
      }
      __syncthreads();
    }
#pragma unroll
    for (int mi = 0; mi < 2; ++mi) {
#pragma unroll
      for (int r = 0; r < 16; ++r) {
        const int row = m0 + wm * 64 + mi * 32 + crow(r, hh);
        if (EPI == EPI_UP) {
          const float u1 = acc[mi][0][r], u3 = acc[mi][1][r];
          const float a = u1 / (1.f + __expf(-u1)) * u3;
          ((bf16_t*)outp)[(size_t)row * ldc + nt * 64 + wn * 32 + r32] = f2bf(a);
        } else {
#pragma unroll
          for (int ni = 0; ni < 2; ++ni) {
            const int col = n0 + wn * 64 + ni * 32 + r32;
            if (EPI == EPI_RESID) { float* hp = (float*)outp + (size_t)row * ldc + col; *hp = *hp + coef * acc[mi][ni][r]; }
            else ((bf16_t*)outp)[(size_t)row * ldc + col] = f2bf(acc[mi][ni][r]);
          }
        }
      }
    }
  }
}

DI void bprep_phase(const Params& p) {
  const int tid = threadIdx.x, pi = tid & 31, tl = tid >> 5;
  const float fr = exp2f(-(float)((pi & 15) * 2) * (1.0f / 32.0f) * 13.287712379549449f);
  const float qg0 = p.ab_qg[2 * pi], qg1 = p.ab_qg[2 * pi + 1], kg0 = p.ab_kg[2 * pi], kg1 = p.ab_kg[2 * pi + 1];
  for (int t = blockIdx.x * 8 + tl; t < NTOK; t += gridDim.x * 8) {
    const int pos = (t < PROMPT_T) ? t : ((t - PROMPT_T) & (SAMPLE_T - 1));
    const float ang = (float)((pi < 16) ? (pos >> 6) : (pos & 63)) * fr;
    const float cs = __cosf(ang), sn = __sinf(ang);
    unsigned* rowp = (unsigned*)(p.big + (size_t)t * 2304);
#pragma unroll
    for (int hd = 0; hd < 10; ++hd) {
      const int col = (hd < 8) ? (1536 + hd * 64) : (2048 + (hd - 8) * 64);
      unsigned u = rowp[(col >> 1) + pi];
      float x1 = bflo(u), x2 = bfhi(u);
      float ss = x1 * x1 + x2 * x2;
#pragma unroll
      for (int o = 16; o > 0; o >>= 1) ss += __shfl_xor(ss, o);
      const float r = rsqrtf(ss * (1.0f / 64.0f) + EPS);
      x1 = x1 * r * ((hd < 8) ? qg0 : kg0); x2 = x2 * r * ((hd < 8) ? qg1 : kg1);
      rowp[(col >> 1) + pi] = pack2(x1 * cs - x2 * sn, x1 * sn + x2 * cs);
    }
  }
}

template <int MODE>
DI void naive_attn(const Params& p, const bf16_t* __restrict__ proj, int ld, int qoff, int koff, int voff, int nqh, int G, bf16_t* cat, int cat_off) {
  const int total = NTOK * nqh;
  for (int idx = blockIdx.x * 256 + threadIdx.x; idx < total; idx += gridDim.x * 256) {
    const int head = idx / NTOK, t = idx % NTOK, hk = head / G;
    const int seq_base = (t < PROMPT_T) ? 0 : (PROMPT_T + ((t - PROMPT_T) / SAMPLE_T) * SAMPLE_T);
    const int T = (t < PROMPT_T) ? PROMPT_T : SAMPLE_T;
    const int pos = t - seq_base;
    float q[64], o[64];
    { const uint4* qp = (const uint4*)(proj + (size_t)t * ld + qoff + head * 64);
#pragma unroll
      for (int c = 0; c < 8; ++c) { uint4 v = qp[c]; q[8*c] = bflo(v.x); q[8*c+1] = bfhi(v.x); q[8*c+2] = bflo(v.y); q[8*c+3] = bfhi(v.y); q[8*c+4] = bflo(v.z); q[8*c+5] = bfhi(v.z); q[8*c+6] = bflo(v.w); q[8*c+7] = bfhi(v.w); } }
#pragma unroll
    for (int d = 0; d < 64; ++d) o[d] = 0.f;
    float m = -1e30f, l = 0.f, slope = 0.f;
    if (MODE == 0) slope = exp2f(-(float)(head + 1));
    if (MODE == 2) { slope = exp2f(-0.5f * (float)(head + 1)); m = p.c_sink[head]; l = 1.f; }
    const int nkeys = (MODE == 0) ? 387 : (MODE == 1 ? T : 257);
    for (int j = 0; j < nkeys; ++j) {
      int off;
      if (MODE == 0) { const int br = j / 129, jj = j % 129 - 64; off = jj * (br == 0 ? 1 : (br == 1 ? 4 : 16)); }
      else if (MODE == 1) off = j - pos;
      else off = j - 128;
      const int kp = pos + off;
      if (kp < 0 || kp >= T) continue;
      const uint4* kptr = (const uint4*)(proj + (size_t)(seq_base + kp) * ld + koff + hk * 64);
      float s = 0.f;
#pragma unroll
      for (int c = 0; c < 8; ++c) { uint4 v = kptr[c];
        s += q[8*c] * bflo(v.x) + q[8*c+1] * bfhi(v.x) + q[8*c+2] * bflo(v.y) + q[8*c+3] * bfhi(v.y) + q[8*c+4] * bflo(v.z) + q[8*c+5] * bfhi(v.z) + q[8*c+6] * bflo(v.w) + q[8*c+7] * bfhi(v.w); }
      s *= 0.125f;
      if (MODE != 1) s -= slope * fabsf((float)off);
      const float mn = fmaxf(m, s); const float al = __expf(m - mn), pw = __expf(s - mn);
      m = mn; l = l * al + pw;
      const uint4* vptr = (const uint4*)(proj + (size_t)(seq_base + kp) * ld + voff + hk * 64);
#pragma unroll
      for (int c = 0; c < 8; ++c) { uint4 v = vptr[c];
        o[8*c] = o[8*c] * al + pw * bflo(v.x); o[8*c+1] = o[8*c+1] * al + pw * bfhi(v.x); o[8*c+2] = o[8*c+2] * al + pw * bflo(v.y); o[8*c+3] = o[8*c+3] * al + pw * bfhi(v.y);
        o[8*c+4] = o[8*c+4] * al + pw * bflo(v.z); o[8*c+5] = o[8*c+5] * al + pw * bfhi(v.z); o[8*c+6] = o[8*c+6] * al + pw * bflo(v.w); o[8*c+7] = o[8*c+7] * al + pw * bfhi(v.w); }
    }
    const float inv = 1.f / l;
    uint4* op = (uint4*)(cat + (size_t)t * DM + cat_off + head * 64);
#pragma unroll
    for (int c = 0; c < 8; ++c) { uint4 v; v.x = pack2(o[8*c] * inv, o[8*c+1] * inv); v.y = pack2(o[8*c+2] * inv, o[8*c+3] * inv); v.z = pack2(o[8*c+4] * inv, o[8*c+5] * inv); v.w = pack2(o[8*c+6] * inv, o[8*c+7] * inv); op[c] = v; }
  }
}

__global__ void __launch_bounds__(256, 2) fwd_megakernel(Params p) {
  cg::grid_group grid = cg::this_grid();
  __shared__ __attribute__((aligned(16))) bf16_t lds[4 * G_TILE];
  convert_phase(p, 0, (float*)lds);
  norm_phase(p, 0, p.norm_g);
  grid.sync();
  for (int layer = 0; layer < 2; ++layer) {
    for (int f = 0; f < 2; ++f) {
      if (f == 1) {
        const int ncol = (layer == 0) ? 2304 : 1536;
        gemm_phase<EPI_BF16>(p.xn, DM, p.wts + W_IN, DM, NTOK, ncol, p.big, ncol, 0.f, lds);
        grid.sync();
        if (layer == 0) {
          bprep_phase(p);
          grid.sync();
          naive_attn<1>(p, p.big, 2304, 1536, 2048, 2176, 8, 4, p.xn, 512);
          naive_attn<0>(p, p.big, 2304, 0, 512, 1024, 8, 1, p.xn, 0);
        } else {
          naive_attn<2>(p, p.big, 1536, 0, 1024, 1280, 16, 4, p.xn, 0);
        }
        grid.sync();
        gemm_phase<EPI_RESID>(p.xn, DM, p.wts + W_OUT, DM, NTOK, DM, p.h, DM, 1.0f, lds);
        grid.sync();
        norm_phase(p, 1, p.norm_g + (layer * 3 + 2) * DM);
        grid.sync();
      }
      const int rows = NTOK / p.ffn_chunks;
      for (int c = 0; c < p.ffn_chunks; ++c) {
        gemm_phase<EPI_UP>(p.xn + (size_t)c * rows * DM, DM, p.wts + (f ? W_UPB : W_UPA), DM, rows, 2 * DFF, p.big, DFF, 0.f, lds);
        grid.sync();
        gemm_phase<EPI_RESID>(p.big, DFF, p.wts + (f ? W_DNB : W_DNA), DFF, rows, DM, p.h + (size_t)c * rows * DM, DM, 0.5f, lds);
        grid.sync();
      }
      if (f == 0) { norm_phase(p, 1, p.norm_g + (layer * 3 + 1) * DM); grid.sync(); }
    }
    if (layer == 0) { convert_phase(p, 1, (float*)lds); norm_phase(p, 1, p.norm_g + 3 * DM); grid.sync(); }
  }
  norm_phase(p, 2, p.final_g);
}

extern "C" void kernel_launch(void* const* d_in, const int* in_sizes, int n_in, void* d_out, int out_size, void* d_ws, size_t ws_size, hipStream_t stream) {
  static int grid_blocks = 0;
  if (!grid_blocks) {
    int dev = 0, cus = 0, per_cu = 0;
    hipGetDevice(&dev);
    hipDeviceGetAttribute(&cus, hipDeviceAttributeMultiprocessorCount, dev);
    hipOccupancyMaxActiveBlocksPerMultiprocessor(&per_cu, fwd_megakernel, 256, 0);
    if (per_cu > 2) per_cu = 2;
    if (per_cu < 1) per_cu = 1;
    grid_blocks = cus * per_cu;
  }
  Params p{};
  p.x_prompt = (const float*)d_in[0]; p.x_sample = (const float*)d_in[1]; p.norm_g = (const float*)d_in[2];
  p.w1 = (const float*)d_in[3]; p.w3 = (const float*)d_in[4]; p.w2 = (const float*)d_in[5];
  p.ab_w_in = (const float*)d_in[6]; p.ab_w_out = (const float*)d_in[7]; p.ab_qg = (const float*)d_in[8]; p.ab_kg = (const float*)d_in[9];
  p.c_w_in = (const float*)d_in[10]; p.c_w_out = (const float*)d_in[11]; p.c_sink = (const float*)d_in[12]; p.final_g = (const float*)d_in[13];
  p.h = (float*)d_out;
  char* ws = (char*)d_ws;
  const size_t MiB = 1024 * 1024;
  p.wts = (bf16_t*)ws;
  p.xn = (bf16_t*)(ws + 40 * MiB);
  p.big = (bf16_t*)(ws + 104 * MiB);
  p.ffn_chunks = (ws_size >= 280 * MiB) ? 1 : 2;
  p.pad = 0;
  void* args[] = {&p};
  hipError_t e = hipLaunchCooperativeKernel((void*)fwd_megakernel, dim3(grid_blocks), dim3(256), args, 0, stream);
  if (e != hipSuccess) fprintf(stderr, "cooperative launch failed: %s (grid %d)\n", hipGetErrorString(e), grid_blocks);
}
```

```cpp
#include <hip/hip_runtime.h>
#include <hip/hip_cooperative_groups.h>
#include <cstdio>
namespace cg = cooperative_groups;

typedef unsigned short bf16_t;
typedef short bf16x8 __attribute__((ext_vector_type(8)));
typedef float f32x16 __attribute__((ext_vector_type(16)));
#define DI __device__ __forceinline__
#define MFMA32(a, b, c) __builtin_amdgcn_mfma_f32_32x32x16_bf16((a), (b), (c), 0, 0, 0)

constexpr int NTOK = 32768, DM = 1024, DFF = 2816;
constexpr int PROMPT_T = 16384, SAMPLE_T = 4096;
constexpr float EPS = 1e-6f;
constexpr float LOG2E = 1.4426950408889634f;

constexpr size_t W_UPA = 0, W_DNA = 5767168, W_UPB = 8650752, W_DNB = 14417920, W_IN = 17301504, W_OUT = 19660800, W_TOTAL = 20709376;

struct Params {
  const float* x_prompt; const float* x_sample; const float* norm_g; const float* w1; const float* w3; const float* w2;
  const float* ab_w_in; const float* ab_w_out; const float* ab_qg; const float* ab_kg;
  const float* c_w_in; const float* c_w_out; const float* c_sink; const float* final_g;
  float* h; bf16_t* wts; bf16_t* xn; bf16_t* big;
  int ffn_chunks; int pad;
};

DI bf16_t f2bf(float x) { unsigned u = __float_as_uint(x); u += 0x7fffu + ((u >> 16) & 1u); return (bf16_t)(u >> 16); }
DI float bf2f(bf16_t v) { return __uint_as_float(((unsigned)v) << 16); }
DI float bflo(unsigned u) { return __uint_as_float(u << 16); }
DI float bfhi(unsigned u) { return __uint_as_float(u & 0xffff0000u); }
DI unsigned pack2(float lo, float hi) { return (unsigned)f2bf(lo) | ((unsigned)f2bf(hi) << 16); }
DI int crow(int reg, int h) { return (reg & 3) + 8 * (reg >> 2) + 4 * h; }

DI void convert_tile(const float* __restrict__ src, int K, int N, int kt, int nt, bf16_t* __restrict__ dst, int mode, float* lds) {
  const int tid = threadIdx.x;
#pragma unroll 4
  for (int i = 0; i < 16; ++i) { int e = tid + 256 * i; int kk = e >> 6, nn = e & 63; lds[kk * 65 + nn] = src[(size_t)(kt * 64 + kk) * N + nt * 64 + nn]; }
  __syncthreads();
#pragma unroll 4
  for (int i = 0; i < 16; ++i) {
    int e = tid + 256 * i; int nn = e >> 6, kk = e & 63; int n = nt * 64 + nn;
    int drow = (mode == 0) ? n : ((n >> 5) * 64 + (n & 31) + (mode == 2 ? 32 : 0));
    dst[(size_t)drow * K + kt * 64 + kk] = f2bf(lds[kk * 65 + nn]);
  }
  __syncthreads();
}

DI void convert_phase(const Params& p, int layer, float* lds) {
  const int n_in = (layer == 0) ? 2304 : 1536;
  const int t_up = 16 * 44, t_dn = 44 * 16, t_in = 16 * (n_in / 64), t_out = 16 * 16;
  const int total = 4 * t_up + 2 * t_dn + t_in + t_out;
  for (int u = blockIdx.x; u < total; u += gridDim.x) {
    int r = u; const float* src; bf16_t* dst; int K, N, mode;
    if (r < 6 * t_up) {
      int mtx = r / t_up; r -= mtx * t_up; int f = mtx / 3, which = mtx % 3;
      size_t base = (size_t)(layer * 2 + f) * DM * DFF;
      if (which == 0) { src = p.w1 + base; K = DM; N = DFF; mode = 1; dst = p.wts + (f ? W_UPB : W_UPA); }
      else if (which == 1) { src = p.w3 + base; K = DM; N = DFF; mode = 2; dst = p.wts + (f ? W_UPB : W_UPA); }
      else { src = p.w2 + base; K = DFF; N = DM; mode = 0; dst = p.wts + (f ? W_DNB : W_DNA); }
    } else if (r < 6 * t_up + t_in) {
      r -= 6 * t_up; src = (layer == 0) ? p.ab_w_in : p.c_w_in; K = DM; N = n_in; mode = 0; dst = p.wts + W_IN;
    } else {
      r -= 6 * t_up + t_in; src = (layer == 0) ? p.ab_w_out : p.c_w_out; K = DM; N = DM; mode = 0; dst = p.wts + W_OUT;
    }
    const int ntn = N / 64; const int kt = r / ntn, nt = r % ntn;
    convert_tile(src, K, N, kt, nt, dst, mode, lds);
  }
}

DI void norm_phase(const Params& p, int mode, const float* __restrict__ g) {
  const int lane = threadIdx.x & 63, wave = threadIdx.x >> 6;
  float4 gv[4];
#pragma unroll
  for (int i = 0; i < 4; ++i) gv[i] = *(const float4*)(g + lane * 4 + 256 * i);
  for (int row = blockIdx.x * 4 + wave; row < NTOK; row += gridDim.x * 4) {
    const float* src = (mode == 0) ? ((row < PROMPT_T) ? p.x_prompt + (size_t)row * DM : p.x_sample + (size_t)(row - PROMPT_T) * DM) : p.h + (size_t)row * DM;
    float4 v[4]; float ss = 0.f;
#pragma unroll
    for (int i = 0; i < 4; ++i) { v[i] = *(const float4*)(src + lane * 4 + 256 * i); ss += v[i].x * v[i].x + v[i].y * v[i].y + v[i].z * v[i].z + v[i].w * v[i].w; }
#pragma unroll
    for (int o = 32; o > 0; o >>= 1) ss += __shfl_xor(ss, o);
    const float r = rsqrtf(ss * (1.0f / DM) + EPS);
#pragma unroll
    for (int i = 0; i < 4; ++i) {
      float4 y; y.x = v[i].x * r * gv[i].x; y.y = v[i].y * r * gv[i].y; y.z = v[i].z * r * gv[i].z; y.w = v[i].w * r * gv[i].w;
      if (mode == 0) *(float4*)(p.h + (size_t)row * DM + lane * 4 + 256 * i) = v[i];
      if (mode == 2) *(float4*)(p.h + (size_t)row * DM + lane * 4 + 256 * i) = y;
      else { uint2 o2; o2.x = pack2(y.x, y.y); o2.y = pack2(y.z, y.w); *(uint2*)(p.xn + (size_t)row * DM + lane * 4 + 256 * i) = o2; }
    }
  }
}

constexpr int GS = 72;
constexpr int G_TILE = 128 * GS;
constexpr int EPI_UP = 0, EPI_RESID = 1, EPI_BF16 = 2;

template <int EPI>
DI void gemm_phase(const bf16_t* __restrict__ A, int lda, const bf16_t* __restrict__ Bt, int K, int M, int N,
                   void* outp, int ldc, float coef, bf16_t* lds) {
  const int tid = threadIdx.x, lane = tid & 63, wave = tid >> 6, wm = wave >> 1, wn = wave & 1, r32 = lane & 31, hh = lane >> 5;
  bf16_t* As = lds; bf16_t* Bs = lds + 2 * G_TILE;
  const int NT = N / 128, MT = M / 128, ntiles = MT * NT, nk = K / 64;
  const int prow = tid >> 3, pc = tid & 7;
  for (int t = blockIdx.x; t < ntiles; t += gridDim.x) {
    const int mt = t / NT, nt = t % NT; const int m0 = mt * 128, n0 = nt * 128;
    const bf16_t* Ag = A + (size_t)(m0 + prow) * lda + pc * 8;
    const bf16_t* Bg = Bt + (size_t)(n0 + prow) * K + pc * 8;
    f32x16 acc[2][2];
#pragma unroll
    for (int i = 0; i < 2; ++i)
#pragma unroll
      for (int j = 0; j < 2; ++j)
#pragma unroll
        for (int r = 0; r < 16; ++r) acc[i][j][r] = 0.f;
    uint4 ra[4], rb[4];
#pragma unroll
    for (int i = 0; i < 4; ++i) { ra[i] = *(const uint4*)(Ag + (size_t)(32 * i) * lda); rb[i] = *(const uint4*)(Bg + (size_t)(32 * i) * K); }
#pragma unroll
    for (int i = 0; i < 4; ++i) { *(uint4*)(As + (prow + 32 * i) * GS + pc * 8) = ra[i]; *(uint4*)(Bs + (prow + 32 * i) * GS + pc * 8) = rb[i]; }
    __syncthreads();
    for (int kt = 0; kt < nk; ++kt) {
      const int buf = kt & 1;
      if (kt + 1 < nk) {
#pragma unroll
        for (int i = 0; i < 4; ++i) { ra[i] = *(const uint4*)(Ag + (size_t)(32 * i) * lda + (kt + 1) * 64); rb[i] = *(const uint4*)(Bg + (size_t)(32 * i) * K + (kt + 1) * 64); }
      }
      const bf16_t* Ab = As + buf * G_TILE + (wm * 64 + r32) * GS + hh * 8;
      const bf16_t* Bb = Bs + buf * G_TILE + (wn * 64 + r32) * GS + hh * 8;
#pragma unroll
      for (int ks = 0; ks < 4; ++ks) {
        bf16x8 a0 = *(const bf16x8*)(Ab + ks * 16), a1 = *(const bf16x8*)(Ab + 32 * GS + ks * 16);
        bf16x8 b0 = *(const bf16x8*)(Bb + ks * 16), b1 = *(const bf16x8*)(Bb + 32 * GS + ks * 16);
        acc[0][0] = MFMA32(a0, b0, acc[0][0]); acc[0][1] = MFMA32(a0, b1, acc[0][1]);
        acc[1][0] = MFMA32(a1, b0, acc[1][0]); acc[1][1] = MFMA32(a1, b1, acc[1][1]);
      }
      if (kt + 1 < nk) {
        bf16_t* Aw = As + (buf ^ 1) * G_TILE; bf16_t* Bw = Bs + (buf ^ 1) * G_TILE;
#pragma unroll
        for (int i = 0; i < 4; ++i) { *(uint4*)(Aw + (prow + 32 * i) * GS + pc * 8) = ra[i]; *(uint4*)(Bw + (prow + 32 * i) * GS + pc * 8) = rb[i]; }
      }
      __syncthreads();
    }
#pragma unroll
    for (int mi = 0; mi < 2; ++mi) {
#pragma unroll
      for (int r = 0; r < 16; ++r) {
        const int row = m0 + wm * 64 + mi * 32 + crow(r, hh);
        if (EPI == EPI_UP) {
          const float u1 = acc[mi][0][r], u3 = acc[mi][1][r];
          const float a = u1 / (1.f + __expf(-u1)) * u3;
          ((bf16_t*)outp)[(size_t)row * ldc + nt * 64 + wn * 32 + r32] = f2bf(a);
        } else {
#pragma unroll
          for (int ni = 0; ni < 2; ++ni) {
            const int col = n0 + wn * 64 + ni * 32 + r32;
            if (EPI == EPI_RESID) { float* hp = (float*)outp + (size_t)row * ldc + col; *hp = *hp + coef * acc[mi][ni][r]; }
            else ((bf16_t*)outp)[(size_t)row * ldc + col] = f2bf(acc[mi][ni][r]);
          }
        }
      }
    }
  }
}

DI void bprep_phase(const Params& p) {
  const int tid = threadIdx.x, pi = tid & 31, tl = tid >> 5;
  const float fr = exp2f(-(float)((pi & 15) * 2) * (1.0f / 32.0f) * 13.287712379549449f);
  const float qg0 = p.ab_qg[2 * pi], qg1 = p.ab_qg[2 * pi + 1], kg0 = p.ab_kg[2 * pi], kg1 = p.ab_kg[2 * pi + 1];
  for (int t = blockIdx.x * 8 + tl; t < NTOK; t += gridDim.x * 8) {
    const int pos = (t < PROMPT_T) ? t : ((t - PROMPT_T) & (SAMPLE_T - 1));
    const float ang = (float)((pi < 16) ? (pos >> 6) : (pos & 63)) * fr;
    const float cs = __cosf(ang), sn = __sinf(ang);
    unsigned* rowp = (unsigned*)(p.big + (size_t)t * 2304);
#pragma unroll
    for (int hd = 0; hd < 10; ++hd) {
      const int col = (hd < 8) ? (1536 + hd * 64) : (2048 + (hd - 8) * 64);
      unsigned u = rowp[(col >> 1) + pi];
      float x1 = bflo(u), x2 = bfhi(u);
      float ss = x1 * x1 + x2 * x2;
#pragma unroll
      for (int o = 16; o > 0; o >>= 1) ss += __shfl_xor(ss, o);
      const float r = rsqrtf(ss * (1.0f / 64.0f) + EPS);
      x1 = x1 * r * ((hd < 8) ? qg0 : kg0); x2 = x2 * r * ((hd < 8) ? qg1 : kg1);
      rowp[(col >> 1) + pi] = pack2(x1 * cs - x2 * sn, x1 * sn + x2 * cs);
    }
  }
}

template <int MODE>
DI void naive_attn(const Params& p, const bf16_t* __restrict__ proj, int ld, int qoff, int koff, int voff, int nqh, int G, bf16_t* cat, int cat_off) {
  const int total = NTOK * nqh;
  for (int idx = blockIdx.x * 256 + threadIdx.x; idx < total; idx += gridDim.x * 256) {
    const int head = idx / NTOK, t = idx % NTOK, hk = head / G;
    const int seq_base = (t < PROMPT_T) ? 0 : (PROMPT_T + ((t - PROMPT_T) / SAMPLE_T) * SAMPLE_T);
    const int T = (t < PROMPT_T) ? PROMPT_T : SAMPLE_T;
    const int pos = t - seq_base;
    float q[64], o[64];
    { const uint4* qp = (const uint4*)(proj + (size_t)t * ld + qoff + head * 64);
#pragma unroll
      for (int c = 0; c < 8; ++c) { uint4 v = qp[c]; q[8*c] = bflo(v.x); q[8*c+1] = bfhi(v.x); q[8*c+2] = bflo(v.y); q[8*c+3] = bfhi(v.y); q[8*c+4] = bflo(v.z); q[8*c+5] = bfhi(v.z); q[8*c+6] = bflo(v.w); q[8*c+7] = bfhi(v.w); } }
#pragma unroll
    for (int d = 0; d < 64; ++d) o[d] = 0.f;
    float m = -1e30f, l = 0.f, slope = 0.f;
    if (MODE == 0) slope = exp2f(-(float)(head + 1));
    if (MODE == 2) { slope = exp2f(-0.5f * (float)(head + 1)); m = p.c_sink[head]; l = 1.f; }
    const int nkeys = (MODE == 0) ? 387 : (MODE == 1 ? T : 257);
    for (int j = 0; j < nkeys; ++j) {
      int off;
      if (MODE == 0) { const int br = j / 129, jj = j % 129 - 64; off = jj * (br == 0 ? 1 : (br == 1 ? 4 : 16)); }
      else if (MODE == 1) off = j - pos;
      else off = j - 128;
      const int kp = pos + off;
      if (kp < 0 || kp >= T) continue;
      const uint4* kptr = (const uint4*)(proj + (size_t)(seq_base + kp) * ld + koff + hk * 64);
      float s = 0.f;
#pragma unroll
      for (int c = 0; c < 8; ++c) { uint4 v = kptr[c];
        s += q[8*c] * bflo(v.x) + q[8*c+1] * bfhi(v.x) + q[8*c+2] * bflo(v.y) + q[8*c+3] * bfhi(v.y) + q[8*c+4] * bflo(v.z) + q[8*c+5] * bfhi(v.z) + q[8*c+6] * bflo(v.w) + q[8*c+7] * bfhi(v.w); }
      s *= 0.125f;
      if (MODE != 1) s -= slope * fabsf((float)off);
      const float mn = fmaxf(m, s); const float al = __expf(m - mn), pw = __expf(s - mn);
      m = mn; l = l * al + pw;
      const uint4* vptr = (const uint4*)(proj + (size_t)(seq_base + kp) * ld + voff + hk * 64);
#pragma unroll
      for (int c = 0; c < 8; ++c) { uint4 v = vptr[c];
        o[8*c] = o[8*c] * al + pw * bflo(v.x); o[8*c+1] = o[8*c+1] * al + pw * bfhi(v.x); o[8*c+2] = o[8*c+2] * al + pw * bflo(v.y); o[8*c+3] = o[8*c+3] * al + pw * bfhi(v.y);
        o[8*c+4] = o[8*c+4] * al + pw * bflo(v.z); o[8*c+5] = o[8*c+5] * al + pw * bfhi(v.z); o[8*c+6] = o[8*c+6] * al + pw * bflo(v.w); o[8*c+7] = o[8*c+7] * al + pw * bfhi(v.w); }
    }
    const float inv = 1.f / l;
    uint4* op = (uint4*)(cat + (size_t)t * DM + cat_off + head * 64);
#pragma unroll
    for (int c = 0; c < 8; ++c) { uint4 v; v.x = pack2(o[8*c] * inv, o[8*c+1] * inv); v.y = pack2(o[8*c+2] * inv, o[8*c+3] * inv); v.z = pack2(o[8*c+4] * inv, o[8*c+5] * inv); v.w = pack2(o[8*c+6] * inv, o[8*c+7] * inv); op[c] = v; }
  }
}

typedef short s16x4 __attribute__((ext_vector_type(4)));
typedef __attribute__((address_space(3))) s16x4* lds_s16x4_ptr;
DI s16x4 vtr(const char* p) { return __builtin_amdgcn_ds_read_tr16_b64_v4i16((lds_s16x4_ptr)p); }

template <int MODE>
DI void attn_unit(const bf16_t* __restrict__ proj, int ld, int seq_base, int kt0, int kt1, int koff, int voff,
                  int q0w, int qoff, int ooff, float slope2, float sink2, bf16_t* __restrict__ cat, char* lds) {
  const int tid = threadIdx.x, lane = tid & 63, wave = tid >> 6, r32 = lane & 31, hh = lane >> 5;
  constexpr float C2 = 0.125f * LOG2E;
  bf16x8 qf[4];
  { const bf16_t* qp = proj + (size_t)(seq_base + q0w + r32) * ld + qoff + hh * 8;
#pragma unroll
    for (int ks = 0; ks < 4; ++ks) qf[ks] = *(const bf16x8*)(qp + ks * 16); }
  f32x16 o0, o1;
#pragma unroll
  for (int r = 0; r < 16; ++r) { o0[r] = 0.f; o1[r] = 0.f; }
  float m = (MODE == 2) ? sink2 : -1e30f, l = 0.f;
  const int qpos = q0w + r32;
  const int skey = wave * 16 + (lane & 7), sc = lane >> 3;
  const bf16_t* kg = proj + (size_t)(seq_base + skey) * ld + koff + sc * 8;
  const bf16_t* vg = proj + (size_t)(seq_base + skey) * ld + voff + sc * 8;
  const int kw = sc * 1024 + skey * 16, vw = 16384 + (sc >> 2) * 4096 + skey * 64 + (sc & 3) * 16;
  uint4 rk0, rk1, rv0, rv1;
  { const size_t go = (size_t)kt0 * 64 * ld;
    rk0 = *(const uint4*)(kg + go); rk1 = *(const uint4*)(kg + go + (size_t)8 * ld); rv0 = *(const uint4*)(vg + go); rv1 = *(const uint4*)(vg + go + (size_t)8 * ld); }
  *(uint4*)(lds + kw) = rk0; *(uint4*)(lds + kw + 128) = rk1; *(uint4*)(lds + vw) = rv0; *(uint4*)(lds + vw + 512) = rv1;
  __syncthreads();
  const int kfo = hh * 1024 + r32 * 16;
  const int vfo = 16384 + (4 * hh + ((lane & 15) >> 2)) * 64 + ((lane >> 4) & 1) * 32 + (lane & 3) * 8;
  for (int kt = kt0; kt < kt1; ++kt) {
    const int buf = (kt - kt0) & 1;
    if (kt + 1 < kt1) { const size_t go = (size_t)(kt + 1) * 64 * ld;
      rk0 = *(const uint4*)(kg + go); rk1 = *(const uint4*)(kg + go + (size_t)8 * ld); rv0 = *(const uint4*)(vg + go); rv1 = *(const uint4*)(vg + go + (size_t)8 * ld); }
    bool active = true;
    if (MODE == 0) active = (kt * 64 + 63 >= q0w - 1024) && (kt * 64 <= q0w + 31 + 1024);
    if (active) {
      const char* kb_ = lds + buf * 8192 + kfo;
      f32x16 s0, s1;
#pragma unroll
      for (int r = 0; r < 16; ++r) { s0[r] = 0.f; s1[r] = 0.f; }
#pragma unroll
      for (int ks = 0; ks < 4; ++ks) {
        bf16x8 k0 = *(const bf16x8*)(kb_ + ks * 2048), k1 = *(const bf16x8*)(kb_ + ks * 2048 + 512);
        s0 = MFMA32(k0, qf[ks], s0); s1 = MFMA32(k1, qf[ks], s1);
      }
      const int d0 = kt * 64 + 4 * hh - qpos;
      float cw0[16], cw1[16];
      float mx = -1e30f;
#pragma unroll
      for (int r = 0; r < 16; ++r) {
        const int oa = d0 + (r & 3) + 8 * (r >> 2), ob = oa + 32;
        float va = s0[r] * C2, vb = s1[r] * C2;
        if (MODE == 0) {
          const int aa = oa < 0 ? -oa : oa, ab = ob < 0 ? -ob : ob;
          const int ca = (aa <= 64 ? 1 : 0) + (((oa & 3) == 0 && aa <= 256) ? 1 : 0) + (((oa & 15) == 0 && aa <= 1024) ? 1 : 0);
          const int cb = (ab <= 64 ? 1 : 0) + (((ob & 3) == 0 && ab <= 256) ? 1 : 0) + (((ob & 15) == 0 && ab <= 1024) ? 1 : 0);
          cw0[r] = (float)ca; cw1[r] = (float)cb;
          va = ca ? va - slope2 * (float)aa : -1e30f; vb = cb ? vb - slope2 * (float)ab : -1e30f;
        } else if (MODE == 2) {
          const int aa = oa < 0 ? -oa : oa, ab = ob < 0 ? -ob : ob;
          va = (aa <= 128) ? va - slope2 * (float)aa : -1e30f; vb = (ab <= 128) ? vb - slope2 * (float)ab : -1e30f;
        }
        s0[r] = va; s1[r] = vb; mx = fmaxf(mx, fmaxf(va, vb));
      }
      mx = fmaxf(mx, __shfl_xor(mx, 32));
      const float mn = fmaxf(m, mx), alpha = exp2f(m - mn);
      m = mn; l *= alpha;
#pragma unroll
      for (int r = 0; r < 16; ++r) { o0[r] *= alpha; o1[r] *= alpha; }
      float ls = 0.f;
#pragma unroll
      for (int r = 0; r < 16; ++r) {
        float pa = exp2f(s0[r] - mn), pb = exp2f(s1[r] - mn);
        if (MODE == 0) { pa *= cw0[r]; pb *= cw1[r]; }
        s0[r] = pa; s1[r] = pb; ls += pa + pb;
      }
      l += ls;
      bf16x8 pf[4];
#pragma unroll
      for (int ks = 0; ks < 4; ++ks) {
        unsigned w[4];
#pragma unroll
        for (int j = 0; j < 4; ++j) {
          const int r = 8 * (ks & 1) + 2 * j;
          w[j] = (ks < 2) ? pack2(s0[r], s0[r + 1]) : pack2(s1[r], s1[r + 1]);
        }
        uint4 t4; t4.x = w[0]; t4.y = w[1]; t4.z = w[2]; t4.w = w[3];
        pf[ks] = __builtin_bit_cast(bf16x8, t4);
      }
      const char* vb_ = lds + buf * 8192 + vfo;
#pragma unroll
      for (int ks = 0; ks < 4; ++ks) {
        s16x4 a0 = vtr(vb_ + ks * 1024), a1 = vtr(vb_ + ks * 1024 + 512);
        s16x4 b0 = vtr(vb_ + 4096 + ks * 1024), b1 = vtr(vb_ + 4096 + ks * 1024 + 512);
        bf16x8 v0 = __builtin_shufflevector(a0, a1, 0, 1, 2, 3, 4, 5, 6, 7);
        bf16x8 v1 = __builtin_shufflevector(b0, b1, 0, 1, 2, 3, 4, 5, 6, 7);
        o0 = MFMA32(v0, pf[ks], o0); o1 = MFMA32(v1, pf[ks], o1);
      }
    }
    if (kt + 1 < kt1) { char* wb = lds + (buf ^ 1) * 8192;
      *(uint4*)(wb + kw) = rk0; *(uint4*)(wb + kw + 128) = rk1; *(uint4*)(wb + vw) = rv0; *(uint4*)(wb + vw + 512) = rv1; }
    __syncthreads();
  }
  float lt = l + __shfl_xor(l, 32);
  if (MODE == 2) lt += exp2f(sink2 - m);
  const float inv = 1.f / lt;
  bf16_t* op = cat + (size_t)(seq_base + qpos) * DM + ooff + 4 * hh;
#pragma unroll
  for (int g = 0; g < 4; ++g) {
    uint2 a, b;
    a.x = pack2(o0[4 * g] * inv, o0[4 * g + 1] * inv); a.y = pack2(o0[4 * g + 2] * inv, o0[4 * g + 3] * inv);
    b.x = pack2(o1[4 * g] * inv, o1[4 * g + 1] * inv); b.y = pack2(o1[4 * g + 2] * inv, o1[4 * g + 3] * inv);
    *(uint2*)(op + 8 * g) = a; *(uint2*)(op + 32 + 8 * g) = b;
  }
}

DI void attn_phase_l0(const Params& p, char* lds) {
  const int wave = threadIdx.x >> 6;
  for (int u = blockIdx.x; u < 4096; u += gridDim.x) {
    if (u < 2048) {
      int seq_base, T, kvh, qt;
      if (u < 1024) { seq_base = 0; T = PROMPT_T; kvh = u >> 9; qt = u & 511; }
      else { const int v = u - 1024; seq_base = PROMPT_T + (v >> 8) * SAMPLE_T; T = SAMPLE_T; kvh = (v >> 7) & 1; qt = v & 127; }
      const int head = kvh * 4 + wave;
      attn_unit<1>(p.big, 2304, seq_base, 0, T >> 6, 2048 + kvh * 64, 2176 + kvh * 64, qt * 32, 1536 + head * 64, 512 + head * 64, 0.f, 0.f, p.xn, lds);
    } else {
      const int v = u - 2048, head = v >> 8, tok0 = (v & 255) * 128;
      const int seq_base = (tok0 < PROMPT_T) ? 0 : (PROMPT_T + ((tok0 - PROMPT_T) / SAMPLE_T) * SAMPLE_T);
      const int T = (tok0 < PROMPT_T) ? PROMPT_T : SAMPLE_T;
      const int q0b = tok0 - seq_base;
      int kt0 = (q0b - 1024) >> 6; if (kt0 < 0) kt0 = 0;
      int kt1 = ((q0b + 127 + 1024) >> 6) + 1; if (kt1 > (T >> 6)) kt1 = T >> 6;
      attn_unit<0>(p.big, 2304, seq_base, kt0, kt1, 512 + head * 64, 1024 + head * 64, q0b + wave * 32, head * 64, head * 64,
                   exp2f(-(float)(head + 1)) * LOG2E, 0.f, p.xn, lds);
    }
  }
}

DI void attn_phase_l1(const Params& p, char* lds) {
  const int wave = threadIdx.x >> 6;
  for (int u = blockIdx.x; u < 4096; u += gridDim.x) {
    const int kvh = u >> 10, tok0 = (u & 1023) * 32;
    const int seq_base = (tok0 < PROMPT_T) ? 0 : (PROMPT_T + ((tok0 - PROMPT_T) / SAMPLE_T) * SAMPLE_T);
    const int T = (tok0 < PROMPT_T) ? PROMPT_T : SAMPLE_T;
    const int q0 = tok0 - seq_base, head = kvh * 4 + wave;
    int kt0 = (q0 - 128) >> 6; if (kt0 < 0) kt0 = 0;
    int kt1 = ((q0 + 31 + 128) >> 6) + 1; if (kt1 > (T >> 6)) kt1 = T >> 6;
    attn_unit<2>(p.big, 1536, seq_base, kt0, kt1, 1024 + kvh * 64, 1280 + kvh * 64, q0, head * 64, head * 64,
                 exp2f(-0.5f * (float)(head + 1)) * LOG2E, p.c_sink[head] * LOG2E, p.xn, lds);
  }
}

__global__ void __launch_bounds__(256, 2) fwd_megakernel(Params p) {
  cg::grid_group grid = cg::this_grid();
  __shared__ __attribute__((aligned(16))) bf16_t lds[4 * G_TILE];
  convert_phase(p, 0, (float*)lds);
  norm_phase(p, 0, p.norm_g);
  grid.sync();
  for (int layer = 0; layer < 2; ++layer) {
    for (int f = 0; f < 2; ++f) {
      if (f == 1) {
        const int ncol = (layer == 0) ? 2304 : 1536;
        gemm_phase<EPI_BF16>(p.xn, DM, p.wts + W_IN, DM, NTOK, ncol, p.big, ncol, 0.f, lds);
        grid.sync();
        if (layer == 0) {
          bprep_phase(p);
          grid.sync();
          attn_phase_l0(p, (char*)lds);
        } else {
          attn_phase_l1(p, (char*)lds);
        }
        grid.sync();
        gemm_phase<EPI_RESID>(p.xn, DM, p.wts + W_OUT, DM, NTOK, DM, p.h, DM, 1.0f, lds);
        grid.sync();
        norm_phase(p, 1, p.norm_g + (layer * 3 + 2) * DM);
        grid.sync();
      }
      const int rows = NTOK / p.ffn_chunks;
      for (int c = 0; c < p.ffn_chunks; ++c) {
        gemm_phase<EPI_UP>(p.xn + (size_t)c * rows * DM, DM, p.wts + (f ? W_UPB : W_UPA), DM, rows, 2 * DFF, p.big, DFF, 0.f, lds);
        grid.sync();
        gemm_phase<EPI_RESID>(p.big, DFF, p.wts + (f ? W_DNB : W_DNA), DFF, rows, DM, p.h + (size_t)c * rows * DM, DM, 0.5f, lds);
        grid.sync();
      }
      if (f == 0) { norm_phase(p, 1, p.norm_g + (layer * 3 + 1) * DM); grid.sync(); }
    }
    if (layer == 0) { convert_phase(p, 1, (float*)lds); norm_phase(p, 1, p.norm_g + 3 * DM); grid.sync(); }
  }
  norm_phase(p, 2, p.final_g);
}

extern "C" void kernel_launch(void* const* d_in, const int* in_sizes, int n_in, void* d_out, int out_size, void* d_ws, size_t ws_size, hipStream_t stream) {
  static int grid_blocks = 0;
  if (!grid_blocks) {
    int dev = 0, cus = 0, per_cu = 0;
    hipGetDevice(&dev);
    hipDeviceGetAttribute(&cus, hipDeviceAttributeMultiprocessorCount, dev);
    hipOccupancyMaxActiveBlocksPerMultiprocessor(&per_cu, fwd_megakernel, 256, 0);
    if (per_cu > 2) per_cu = 2;
    if (per_cu < 1) per_cu = 1;
    grid_blocks = cus * per_cu;
  }
  Params p{};
  p.x_prompt = (const float*)d_in[0]; p.x_sample = (const float*)d_in[1]; p.norm_g = (const float*)d_in[2];
  p.w1 = (const float*)d_in[3]; p.w3 = (const float*)d_in[4]; p.w2 = (const float*)d_in[5];
  p.ab_w_in = (const float*)d_in[6]; p.ab_w_out = (const float*)d_in[7]; p.ab_qg = (const float*)d_in[8]; p.ab_kg = (const float*)d_in[9];
  p.c_w_in = (const float*)d_in[10]; p.c_w_out = (const float*)d_in[11]; p.c_sink = (const float*)d_in[12]; p.final_g = (const float*)d_in[13];
  p.h = (float*)d_out;
  char* ws = (char*)d_ws;
  const size_t MiB = 1024 * 1024;
  p.wts = (bf16_t*)ws;
  p.xn = (bf16_t*)(ws + 40 * MiB);
  p.big = (bf16_t*)(ws + 104 * MiB);
  p.ffn_chunks = (ws_size >= 280 * MiB) ? 1 : 2;
  p.pad = 0;
  void* args[] = {&p};
  hipError_t e = hipLaunchCooperativeKernel((void*)fwd_megakernel, dim3(grid_blocks), dim3(256), args, 0, stream);
  if (e != hipSuccess) fprintf(stderr, "cooperative launch failed: %s (grid %d)\n", hipGetErrorString(e), grid_blocks);
}
```

```cpp
#include <hip/hip_runtime.h>
#include <hip/hip_cooperative_groups.h>
#include <cstdio>
namespace cg = cooperative_groups;

typedef unsigned short bf16_t;
typedef short bf16x8 __attribute__((ext_vector_type(8)));
typedef float f32x16 __attribute__((ext_vector_type(16)));
#define DI __device__ __forceinline__
#define OPAQUE_TID(v) int v = threadIdx.x; asm volatile("" : "+v"(v))
#define MFMA32(a, b, c) __builtin_amdgcn_mfma_f32_32x32x16_bf16((a), (b), (c), 0, 0, 0)

constexpr int NTOK = 32768, DM = 1024, DFF = 2816;
constexpr int PROMPT_T = 16384, SAMPLE_T = 4096;
constexpr float EPS = 1e-6f;
constexpr float LOG2E = 1.4426950408889634f;

constexpr size_t W_UPA = 0, W_DNA = 5767168, W_UPB = 8650752, W_DNB = 14417920, W_IN = 17301504, W_OUT = 19660800, W_TOTAL = 20709376;

struct Params {
  const float* x_prompt; const float* x_sample; const float* norm_g; const float* w1; const float* w3; const float* w2;
  const float* ab_w_in; const float* ab_w_out; const float* ab_qg; const float* ab_kg;
  const float* c_w_in; const float* c_w_out; const float* c_sink; const float* final_g;
  float* h; bf16_t* wts; bf16_t* xn; bf16_t* big;
  int ffn_chunks; int pad;
};

DI bf16_t f2bf(float x) { unsigned u = __float_as_uint(x); u += 0x7fffu + ((u >> 16) & 1u); return (bf16_t)(u >> 16); }
DI float bf2f(bf16_t v) { return __uint_as_float(((unsigned)v) << 16); }
DI float bflo(unsigned u) { return __uint_as_float(u << 16); }
DI float bfhi(unsigned u) { return __uint_as_float(u & 0xffff0000u); }
DI unsigned pack2(float lo, float hi) { return (unsigned)f2bf(lo) | ((unsigned)f2bf(hi) << 16); }
DI int crow(int reg, int h) { return (reg & 3) + 8 * (reg >> 2) + 4 * h; }

DI void convert_tile(const float* __restrict__ src, int K, int N, int kt, int nt, bf16_t* __restrict__ dst, int mode, float* lds) {
  OPAQUE_TID(tid);
#pragma unroll 4
  for (int i = 0; i < 8; ++i) { int e = tid + 512 * i; int kk = e >> 6, nn = e & 63; lds[kk * 65 + nn] = src[(size_t)(kt * 64 + kk) * N + nt * 64 + nn]; }
  __syncthreads();
#pragma unroll 4
  for (int i = 0; i < 8; ++i) {
    int e = tid + 512 * i; int nn = e >> 6, kk = e & 63; int n = nt * 64 + nn;
    int drow = (mode == 0) ? n : ((n >> 5) * 64 + (n & 31) + (mode == 2 ? 32 : 0));
    dst[(size_t)drow * K + kt * 64 + kk] = f2bf(lds[kk * 65 + nn]);
  }
  __syncthreads();
}

DI void convert_phase(const Params& p, int layer, float* lds) {
  const int n_in = (layer == 0) ? 2304 : 1536;
  const int t_up = 16 * 44, t_dn = 44 * 16, t_in = 16 * (n_in / 64), t_out = 16 * 16;
  const int total = 4 * t_up + 2 * t_dn + t_in + t_out;
  for (int u = blockIdx.x; u < total; u += gridDim.x) {
    int r = u; const float* src; bf16_t* dst; int K, N, mode;
    if (r < 6 * t_up) {
      int mtx = r / t_up; r -= mtx * t_up; int f = mtx / 3, which = mtx % 3;
      size_t base = (size_t)(layer * 2 + f) * DM * DFF;
      if (which == 0) { src = p.w1 + base; K = DM; N = DFF; mode = 1; dst = p.wts + (f ? W_UPB : W_UPA); }
      else if (which == 1) { src = p.w3 + base; K = DM; N = DFF; mode = 2; dst = p.wts + (f ? W_UPB : W_UPA); }
      else { src = p.w2 + base; K = DFF; N = DM; mode = 0; dst = p.wts + (f ? W_DNB : W_DNA); }
    } else if (r < 6 * t_up + t_in) {
      r -= 6 * t_up; src = (layer == 0) ? p.ab_w_in : p.c_w_in; K = DM; N = n_in; mode = 0; dst = p.wts + W_IN;
    } else {
      r -= 6 * t_up + t_in; src = (layer == 0) ? p.ab_w_out : p.c_w_out; K = DM; N = DM; mode = 0; dst = p.wts + W_OUT;
    }
    const int ntn = N / 64; const int kt = r / ntn, nt = r % ntn;
    convert_tile(src, K, N, kt, nt, dst, mode, lds);
  }
}

DI void norm_phase(const Params& p, int mode, const float* __restrict__ g) {
  OPAQUE_TID(tid);
  const int lane = tid & 63, wave = tid >> 6;
  float4 gv[4];
#pragma unroll
  for (int i = 0; i < 4; ++i) gv[i] = *(const float4*)(g + lane * 4 + 256 * i);
  for (int row = blockIdx.x * 8 + wave; row < NTOK; row += gridDim.x * 8) {
    const float* src = (mode == 0) ? ((row < PROMPT_T) ? p.x_prompt + (size_t)row * DM : p.x_sample + (size_t)(row - PROMPT_T) * DM) : p.h + (size_t)row * DM;
    float4 v[4]; float ss = 0.f;
#pragma unroll
    for (int i = 0; i < 4; ++i) { v[i] = *(const float4*)(src + lane * 4 + 256 * i); ss += v[i].x * v[i].x + v[i].y * v[i].y + v[i].z * v[i].z + v[i].w * v[i].w; }
#pragma unroll
    for (int o = 32; o > 0; o >>= 1) ss += __shfl_xor(ss, o);
    const float r = rsqrtf(ss * (1.0f / DM) + EPS);
#pragma unroll
    for (int i = 0; i < 4; ++i) {
      float4 y; y.x = v[i].x * r * gv[i].x; y.y = v[i].y * r * gv[i].y; y.z = v[i].z * r * gv[i].z; y.w = v[i].w * r * gv[i].w;
      if (mode == 0) *(float4*)(p.h + (size_t)row * DM + lane * 4 + 256 * i) = v[i];
      if (mode == 2) *(float4*)(p.h + (size_t)row * DM + lane * 4 + 256 * i) = y;
      else { uint2 o2; o2.x = pack2(y.x, y.y); o2.y = pack2(y.z, y.w); *(uint2*)(p.xn + (size_t)row * DM + lane * 4 + 256 * i) = o2; }
    }
  }
}

typedef float f32x4 __attribute__((ext_vector_type(4)));
constexpr int EPI_UP = 0, EPI_RESID = 1, EPI_BF16 = 2;
constexpr int TILE_B = 256 * 64 * 2, STAGE_B = 2 * TILE_B;
#define WAIT_V0() asm volatile("s_waitcnt vmcnt(0)" ::: "memory")
DI int lds_byte(int r, int c) { const int st = (r >> 4) * 2 + (c >> 5), ob = (r & 15) * 64 + (c & 31) * 2; return st * 1024 + (ob ^ (((ob >> 9) & 1) << 5)); }
DI void stage_rc(int b, int& R, int& C) { const int st = b >> 10, sb = b & 1023, swz = sb ^ (((sb >> 9) & 1) << 5); R = (st >> 1) * 16 + (swz >> 6); C = (st & 1) * 32 + ((swz & 63) >> 1); }

template <int EPI, int K, int N>
DI void gemm_phase(const bf16_t* __restrict__ A, const bf16_t* __restrict__ Bt, int M, void* outp, float coef, char* shm) {
  constexpr int lda = K, ldc = (EPI == EPI_UP) ? N / 2 : N;
  OPAQUE_TID(tid);
  const int wid = tid >> 6, lane = tid & 63, wr = wid >> 2, wc = wid & 3, fr = lane & 15, fq = lane >> 4;
  int sR0, sC0; stage_rc(wid * 1024 + lane * 16, sR0, sC0);
  const int soff = sR0 * K + sC0;
  const int nM = M / 256, nwg = nM * (N / 256);
  constexpr int nN = N / 256, nt = K / 64;
  for (int it = 0;; ++it) {
    int wgid = it * gridDim.x + blockIdx.x;
    if (wgid >= nwg) break;
    { const int q = nwg / 8, r = nwg % 8, xcd = wgid % 8, off = wgid / 8; wgid = (xcd < r ? xcd * (q + 1) : r * (q + 1) + (xcd - r) * q) + off; }
    const int nig = 8 * nN, gid = wgid / nig, fm = gid * 8, gsz = (nM - fm) < 8 ? (nM - fm) : 8;
    const int pm = fm + ((wgid % nig) % gsz), pn = (wgid % nig) / gsz, brow = pm * 256, bcol = pn * 256;
    const bf16_t* Ab = A + (size_t)brow * lda;
    const bf16_t* Bb = Bt + (size_t)bcol * K;
    f32x4 acc[4][8];
#pragma unroll
    for (int n = 0; n < 4; ++n)
#pragma unroll
      for (int m = 0; m < 8; ++m) acc[n][m] = f32x4{0.f, 0.f, 0.f, 0.f};
#define GLDS_STAGE(buf, kt) do { _Pragma("unroll") for (int i = 0; i < 4; ++i) { \
      __builtin_amdgcn_global_load_lds((const unsigned*)(Ab + soff + i * 64 * K + (kt) * 64), (unsigned*)(shm + (buf) * STAGE_B + wid * 1024 + i * 8192), 16, 0, 0); \
      __builtin_amdgcn_global_load_lds((const unsigned*)(Bb + soff + i * 64 * K + (kt) * 64), (unsigned*)(shm + (buf) * STAGE_B + TILE_B + wid * 1024 + i * 8192), 16, 0, 0); } } while (0)
    GLDS_STAGE(0, 0); WAIT_V0(); __syncthreads();
    for (int t = 0; t < nt; ++t) {
      const int cur = t & 1;
      if (t + 1 < nt) GLDS_STAGE(cur ^ 1, t + 1);
      const char* sa = shm + cur * STAGE_B; const char* sb = sa + TILE_B;
#pragma unroll
      for (int ks = 0; ks < 2; ++ks) {
        bf16x8 At[8], Bf[4];
#pragma unroll
        for (int m = 0; m < 8; ++m) At[m] = *(const bf16x8*)(sa + lds_byte(wr * 128 + m * 16 + fr, ks * 32 + fq * 8));
#pragma unroll
        for (int n = 0; n < 4; ++n) Bf[n] = *(const bf16x8*)(sb + lds_byte(wc * 64 + n * 16 + fr, ks * 32 + fq * 8));
#pragma unroll
        for (int m = 0; m < 8; ++m)
#pragma unroll
          for (int n = 0; n < 4; ++n) acc[n][m] = __builtin_amdgcn_mfma_f32_16x16x32_bf16(Bf[n], At[m], acc[n][m], 0, 0, 0);
        __builtin_amdgcn_sched_barrier(0);
      }
      WAIT_V0(); __syncthreads();
    }
#undef GLDS_STAGE
#pragma unroll
    for (int m = 0; m < 8; ++m) {
      const int row = brow + wr * 128 + m * 16 + fr;
      if (EPI == EPI_UP) {
#pragma unroll
        for (int n = 0; n < 2; ++n) {
          float a[4];
#pragma unroll
          for (int j = 0; j < 4; ++j) { const float u1 = acc[n][m][j], u3 = acc[n + 2][m][j]; a[j] = u1 / (1.f + __expf(-u1)) * u3; }
          uint2 o2; o2.x = pack2(a[0], a[1]); o2.y = pack2(a[2], a[3]);
          *(uint2*)((bf16_t*)outp + (size_t)row * ldc + pn * 128 + wc * 32 + n * 16 + 4 * fq) = o2;
        }
      } else {
#pragma unroll
        for (int n = 0; n < 4; ++n) {
          const int col = bcol + wc * 64 + n * 16 + 4 * fq;
          if (EPI == EPI_RESID) {
            float4* hp = (float4*)((float*)outp + (size_t)row * ldc + col); float4 v = *hp;
            v.x += coef * acc[n][m][0]; v.y += coef * acc[n][m][1]; v.z += coef * acc[n][m][2]; v.w += coef * acc[n][m][3]; *hp = v;
          } else {
            uint2 o2; o2.x = pack2(acc[n][m][0], acc[n][m][1]); o2.y = pack2(acc[n][m][2], acc[n][m][3]);
            *(uint2*)((bf16_t*)outp + (size_t)row * ldc + col) = o2;
          }
        }
      }
      __builtin_amdgcn_sched_barrier(0);
    }
  }
}

DI void bprep_phase(const Params& p) {
  OPAQUE_TID(tid);
  const int pi = tid & 31, tl = tid >> 5;
  const float fr = exp2f(-(float)((pi & 15) * 2) * (1.0f / 32.0f) * 13.287712379549449f);
  const float qg0 = p.ab_qg[2 * pi], qg1 = p.ab_qg[2 * pi + 1], kg0 = p.ab_kg[2 * pi], kg1 = p.ab_kg[2 * pi + 1];
  for (int t = blockIdx.x * 16 + tl; t < NTOK; t += gridDim.x * 16) {
    const int pos = (t < PROMPT_T) ? t : ((t - PROMPT_T) & (SAMPLE_T - 1));
    const float ang = (float)((pi < 16) ? (pos >> 6) : (pos & 63)) * fr;
    const float cs = __cosf(ang), sn = __sinf(ang);
    unsigned* rowp = (unsigned*)(p.big + (size_t)t * 2304);
#pragma unroll
    for (int hd = 0; hd < 10; ++hd) {
      const int col = (hd < 8) ? (1536 + hd * 64) : (2048 + (hd - 8) * 64);
      unsigned u = rowp[(col >> 1) + pi];
      float x1 = bflo(u), x2 = bfhi(u);
      float ss = x1 * x1 + x2 * x2;
#pragma unroll
      for (int o = 16; o > 0; o >>= 1) ss += __shfl_xor(ss, o);
      const float r = rsqrtf(ss * (1.0f / 64.0f) + EPS);
      x1 = x1 * r * ((hd < 8) ? qg0 : kg0); x2 = x2 * r * ((hd < 8) ? qg1 : kg1);
      rowp[(col >> 1) + pi] = pack2(x1 * cs - x2 * sn, x1 * sn + x2 * cs);
    }
  }
}

template <int MODE>
DI void naive_attn(const Params& p, const bf16_t* __restrict__ proj, int ld, int qoff, int koff, int voff, int nqh, int G, bf16_t* cat, int cat_off) {
  const int total = NTOK * nqh;
  for (int idx = blockIdx.x * 256 + threadIdx.x; idx < total; idx += gridDim.x * 256) {
    const int head = idx / NTOK, t = idx % NTOK, hk = head / G;
    const int seq_base = (t < PROMPT_T) ? 0 : (PROMPT_T + ((t - PROMPT_T) / SAMPLE_T) * SAMPLE_T);
    const int T = (t < PROMPT_T) ? PROMPT_T : SAMPLE_T;
    const int pos = t - seq_base;
    float q[64], o[64];
    { const uint4* qp = (const uint4*)(proj + (size_t)t * ld + qoff + head * 64);
#pragma unroll
      for (int c = 0; c < 8; ++c) { uint4 v = qp[c]; q[8*c] = bflo(v.x); q[8*c+1] = bfhi(v.x); q[8*c+2] = bflo(v.y); q[8*c+3] = bfhi(v.y); q[8*c+4] = bflo(v.z); q[8*c+5] = bfhi(v.z); q[8*c+6] = bflo(v.w); q[8*c+7] = bfhi(v.w); } }
#pragma unroll
    for (int d = 0; d < 64; ++d) o[d] = 0.f;
    float m = -1e30f, l = 0.f, slope = 0.f;
    if (MODE == 0) slope = exp2f(-(float)(head + 1));
    if (MODE == 2) { slope = exp2f(-0.5f * (float)(head + 1)); m = p.c_sink[head]; l = 1.f; }
    const int nkeys = (MODE == 0) ? 387 : (MODE == 1 ? T : 257);
    for (int j = 0; j < nkeys; ++j) {
      int off;
      if (MODE == 0) { const int br = j / 129, jj = j % 129 - 64; off = jj * (br == 0 ? 1 : (br == 1 ? 4 : 16)); }
      else if (MODE == 1) off = j - pos;
      else off = j - 128;
      const int kp = pos + off;
      if (kp < 0 || kp >= T) continue;
      const uint4* kptr = (const uint4*)(proj + (size_t)(seq_base + kp) * ld + koff + hk * 64);
      float s = 0.f;
#pragma unroll
      for (int c = 0; c < 8; ++c) { uint4 v = kptr[c];
        s += q[8*c] * bflo(v.x) + q[8*c+1] * bfhi(v.x) + q[8*c+2] * bflo(v.y) + q[8*c+3] * bfhi(v.y) + q[8*c+4] * bflo(v.z) + q[8*c+5] * bfhi(v.z) + q[8*c+6] * bflo(v.w) + q[8*c+7] * bfhi(v.w); }
      s *= 0.125f;
      if (MODE != 1) s -= slope * fabsf((float)off);
      const float mn = fmaxf(m, s); const float al = __expf(m - mn), pw = __expf(s - mn);
      m = mn; l = l * al + pw;
      const uint4* vptr = (const uint4*)(proj + (size_t)(seq_base + kp) * ld + voff + hk * 64);
#pragma unroll
      for (int c = 0; c < 8; ++c) { uint4 v = vptr[c];
        o[8*c] = o[8*c] * al + pw * bflo(v.x); o[8*c+1] = o[8*c+1] * al + pw * bfhi(v.x); o[8*c+2] = o[8*c+2] * al + pw * bflo(v.y); o[8*c+3] = o[8*c+3] * al + pw * bfhi(v.y);
        o[8*c+4] = o[8*c+4] * al + pw * bflo(v.z); o[8*c+5] = o[8*c+5] * al + pw * bfhi(v.z); o[8*c+6] = o[8*c+6] * al + pw * bflo(v.w); o[8*c+7] = o[8*c+7] * al + pw * bfhi(v.w); }
    }
    const float inv = 1.f / l;
    uint4* op = (uint4*)(cat + (size_t)t * DM + cat_off + head * 64);
#pragma unroll
    for (int c = 0; c < 8; ++c) { uint4 v; v.x = pack2(o[8*c] * inv, o[8*c+1] * inv); v.y = pack2(o[8*c+2] * inv, o[8*c+3] * inv); v.z = pack2(o[8*c+4] * inv, o[8*c+5] * inv); v.w = pack2(o[8*c+6] * inv, o[8*c+7] * inv); op[c] = v; }
  }
}

typedef short s16x4 __attribute__((ext_vector_type(4)));
typedef __attribute__((address_space(3))) s16x4* lds_s16x4_ptr;
DI s16x4 vtr(const char* p) { return __builtin_amdgcn_ds_read_tr16_b64_v4i16((lds_s16x4_ptr)p); }

template <int MODE>
DI void attn_unit(const bf16_t* __restrict__ proj, int ld, int seq_base, int kt0, int kt1, int koff, int voff,
                  int q0w, int qoff, int ooff, float slope2, float sink2, bf16_t* __restrict__ cat, char* lds) {
  OPAQUE_TID(tid);
  const int lane = tid & 63, wave = tid >> 6, r32 = lane & 31, hh = lane >> 5;
  constexpr float C2 = 0.125f * LOG2E;
  bf16x8 qf[4];
  { const bf16_t* qp = proj + (size_t)(seq_base + q0w + r32) * ld + qoff + hh * 8;
#pragma unroll
    for (int ks = 0; ks < 4; ++ks) qf[ks] = *(const bf16x8*)(qp + ks * 16); }
  f32x16 o0, o1;
#pragma unroll
  for (int r = 0; r < 16; ++r) { o0[r] = 0.f; o1[r] = 0.f; }
  float m = (MODE == 2) ? sink2 : -1e30f, l = 0.f;
  const int qpos = q0w + r32;
  const int skey = wave * 8 + (lane & 7), sc = lane >> 3;
  const bf16_t* kg = proj + (size_t)(seq_base + skey) * ld + koff + sc * 8;
  const bf16_t* vg = proj + (size_t)(seq_base + skey) * ld + voff + sc * 8;
  const int kw = sc * 1024 + skey * 16, vw = 16384 + (sc >> 2) * 4096 + skey * 64 + (sc & 3) * 16;
  uint4 rk0, rv0;
  { const size_t go = (size_t)kt0 * 64 * ld;
    rk0 = *(const uint4*)(kg + go); rv0 = *(const uint4*)(vg + go); }
  *(uint4*)(lds + kw) = rk0; *(uint4*)(lds + vw) = rv0;
  __syncthreads();
  const int kfo = hh * 1024 + r32 * 16;
  const int vfo = 16384 + (4 * hh + ((lane & 15) >> 2)) * 64 + ((lane >> 4) & 1) * 32 + (lane & 3) * 8;
  for (int kt = kt0; kt < kt1; ++kt) {
    const int buf = (kt - kt0) & 1;
    if (kt + 1 < kt1) { const size_t go = (size_t)(kt + 1) * 64 * ld;
      rk0 = *(const uint4*)(kg + go); rv0 = *(const uint4*)(vg + go); }
    bool active = true;
    if (MODE == 0) active = (kt * 64 + 63 >= q0w - 1024) && (kt * 64 <= q0w + 31 + 1024);
    if (active) {
      const char* kb_ = lds + buf * 8192 + kfo;
      f32x16 s0, s1;
#pragma unroll
      for (int r = 0; r < 16; ++r) { s0[r] = 0.f; s1[r] = 0.f; }
#pragma unroll
      for (int ks = 0; ks < 4; ++ks) {
        bf16x8 k0 = *(const bf16x8*)(kb_ + ks * 2048), k1 = *(const bf16x8*)(kb_ + ks * 2048 + 512);
        s0 = MFMA32(k0, qf[ks], s0); s1 = MFMA32(k1, qf[ks], s1);
      }
      const int d0 = kt * 64 + 4 * hh - qpos;
      float cw0[16], cw1[16];
      float mx = -1e30f;
#pragma unroll
      for (int r = 0; r < 16; ++r) {
        const int oa = d0 + (r & 3) + 8 * (r >> 2), ob = oa + 32;
        float va = s0[r] * C2, vb = s1[r] * C2;
        if (MODE == 0) {
          const int aa = oa < 0 ? -oa : oa, ab = ob < 0 ? -ob : ob;
          const int ca = (aa <= 64 ? 1 : 0) + (((oa & 3) == 0 && aa <= 256) ? 1 : 0) + (((oa & 15) == 0 && aa <= 1024) ? 1 : 0);
          const int cb = (ab <= 64 ? 1 : 0) + (((ob & 3) == 0 && ab <= 256) ? 1 : 0) + (((ob & 15) == 0 && ab <= 1024) ? 1 : 0);
          cw0[r] = (float)ca; cw1[r] = (float)cb;
          va = ca ? va - slope2 * (float)aa : -1e30f; vb = cb ? vb - slope2 * (float)ab : -1e30f;
        } else if (MODE == 2) {
          const int aa = oa < 0 ? -oa : oa, ab = ob < 0 ? -ob : ob;
          va = (aa <= 128) ? va - slope2 * (float)aa : -1e30f; vb = (ab <= 128) ? vb - slope2 * (float)ab : -1e30f;
        }
        s0[r] = va; s1[r] = vb; mx = fmaxf(mx, fmaxf(va, vb));
      }
      mx = fmaxf(mx, __shfl_xor(mx, 32));
      const float mn = fmaxf(m, mx), alpha = exp2f(m - mn);
      m = mn; l *= alpha;
#pragma unroll
      for (int r = 0; r < 16; ++r) { o0[r] *= alpha; o1[r] *= alpha; }
      float ls = 0.f;
#pragma unroll
      for (int r = 0; r < 16; ++r) {
        float pa = exp2f(s0[r] - mn), pb = exp2f(s1[r] - mn);
        if (MODE == 0) { pa *= cw0[r]; pb *= cw1[r]; }
        s0[r] = pa; s1[r] = pb; ls += pa + pb;
      }
      l += ls;
      bf16x8 pf[4];
#pragma unroll
      for (int ks = 0; ks < 4; ++ks) {
        unsigned w[4];
#pragma unroll
        for (int j = 0; j < 4; ++j) {
          const int r = 8 * (ks & 1) + 2 * j;
          w[j] = (ks < 2) ? pack2(s0[r], s0[r + 1]) : pack2(s1[r], s1[r + 1]);
        }
        uint4 t4; t4.x = w[0]; t4.y = w[1]; t4.z = w[2]; t4.w = w[3];
        pf[ks] = __builtin_bit_cast(bf16x8, t4);
      }
      const char* vb_ = lds + buf * 8192 + vfo;
#pragma unroll
      for (int ks = 0; ks < 4; ++ks) {
        s16x4 a0 = vtr(vb_ + ks * 1024), a1 = vtr(vb_ + ks * 1024 + 512);
        s16x4 b0 = vtr(vb_ + 4096 + ks * 1024), b1 = vtr(vb_ + 4096 + ks * 1024 + 512);
        bf16x8 v0 = __builtin_shufflevector(a0, a1, 0, 1, 2, 3, 4, 5, 6, 7);
        bf16x8 v1 = __builtin_shufflevector(b0, b1, 0, 1, 2, 3, 4, 5, 6, 7);
        o0 = MFMA32(v0, pf[ks], o0); o1 = MFMA32(v1, pf[ks], o1);
      }
    }
    if (kt + 1 < kt1) { char* wb = lds + (buf ^ 1) * 8192;
      *(uint4*)(wb + kw) = rk0; *(uint4*)(wb + vw) = rv0; }
    __syncthreads();
  }
  float lt = l + __shfl_xor(l, 32);
  if (MODE == 2) lt += exp2f(sink2 - m);
  const float inv = 1.f / lt;
  bf16_t* op = cat + (size_t)(seq_base + qpos) * DM + ooff + 4 * hh;
#pragma unroll
  for (int g = 0; g < 4; ++g) {
    uint2 a, b;
    a.x = pack2(o0[4 * g] * inv, o0[4 * g + 1] * inv); a.y = pack2(o0[4 * g + 2] * inv, o0[4 * g + 3] * inv);
    b.x = pack2(o1[4 * g] * inv, o1[4 * g + 1] * inv); b.y = pack2(o1[4 * g + 2] * inv, o1[4 * g + 3] * inv);
    *(uint2*)(op + 8 * g) = a; *(uint2*)(op + 32 + 8 * g) = b;
  }
}

DI void attn_phase_l0(const Params& p, char* lds) {
  OPAQUE_TID(tid0);
  const int wave = tid0 >> 6;
  for (int u = blockIdx.x; u < 2048; u += gridDim.x) {
    if (u < 1024) {
      int seq_base, T, kvh, qt;
      if (u < 512) { seq_base = 0; T = PROMPT_T; kvh = u >> 8; qt = u & 255; }
      else { const int v = u - 512; seq_base = PROMPT_T + (v >> 7) * SAMPLE_T; T = SAMPLE_T; kvh = (v >> 6) & 1; qt = v & 63; }
      const int head = kvh * 4 + (wave & 3);
      attn_unit<1>(p.big, 2304, seq_base, 0, T >> 6, 2048 + kvh * 64, 2176 + kvh * 64, qt * 64 + (wave >> 2) * 32, 1536 + head * 64, 512 + head * 64, 0.f, 0.f, p.xn, lds);
    } else {
      const int v = u - 1024, head = v >> 7, tok0 = (v & 127) * 256;
      const int seq_base = (tok0 < PROMPT_T) ? 0 : (PROMPT_T + ((tok0 - PROMPT_T) / SAMPLE_T) * SAMPLE_T);
      const int T = (tok0 < PROMPT_T) ? PROMPT_T : SAMPLE_T;
      const int q0b = tok0 - seq_base;
      int kt0 = (q0b - 1024) >> 6; if (kt0 < 0) kt0 = 0;
      int kt1 = ((q0b + 255 + 1024) >> 6) + 1; if (kt1 > (T >> 6)) kt1 = T >> 6;
      attn_unit<0>(p.big, 2304, seq_base, kt0, kt1, 512 + head * 64, 1024 + head * 64, q0b + wave * 32, head * 64, head * 64,
                   exp2f(-(float)(head + 1)) * LOG2E, 0.f, p.xn, lds);
    }
  }
}

DI void attn_phase_l1(const Params& p, char* lds) {
  OPAQUE_TID(tid0);
  const int wave = tid0 >> 6;
  for (int u = blockIdx.x; u < 2048; u += gridDim.x) {
    const int kvh = u >> 9, tok0 = (u & 511) * 64;
    const int seq_base = (tok0 < PROMPT_T) ? 0 : (PROMPT_T + ((tok0 - PROMPT_T) / SAMPLE_T) * SAMPLE_T);
    const int T = (tok0 < PROMPT_T) ? PROMPT_T : SAMPLE_T;
    const int q0 = tok0 - seq_base, head = kvh * 4 + (wave & 3);
    int kt0 = (q0 - 128) >> 6; if (kt0 < 0) kt0 = 0;
    int kt1 = ((q0 + 63 + 128) >> 6) + 1; if (kt1 > (T >> 6)) kt1 = T >> 6;
    attn_unit<2>(p.big, 1536, seq_base, kt0, kt1, 1024 + kvh * 64, 1280 + kvh * 64, q0 + (wave >> 2) * 32, head * 64, head * 64,
                 exp2f(-0.5f * (float)(head + 1)) * LOG2E, p.c_sink[head] * LOG2E, p.xn, lds);
  }
}

__global__ void __launch_bounds__(512) fwd_megakernel(Params p) {
  cg::grid_group grid = cg::this_grid();
  __shared__ __attribute__((aligned(1024))) char lds[2 * STAGE_B];
  convert_phase(p, 0, (float*)lds);
  norm_phase(p, 0, p.norm_g);
  grid.sync();
  for (int layer = 0; layer < 2; ++layer) {
    for (int f = 0; f < 2; ++f) {
      if (f == 1) {
        if (layer == 0) gemm_phase<EPI_BF16, DM, 2304>(p.xn, p.wts + W_IN, NTOK, p.big, 0.f, lds);
        else gemm_phase<EPI_BF16, DM, 1536>(p.xn, p.wts + W_IN, NTOK, p.big, 0.f, lds);
        grid.sync();
        if (layer == 0) {
          bprep_phase(p);
          grid.sync();
          attn_phase_l0(p, lds);
        } else {
          attn_phase_l1(p, lds);
        }
        grid.sync();
        gemm_phase<EPI_RESID, DM, DM>(p.xn, p.wts + W_OUT, NTOK, p.h, 1.0f, lds);
        grid.sync();
        norm_phase(p, 1, p.norm_g + (layer * 3 + 2) * DM);
        grid.sync();
      }
      const int rows = NTOK / p.ffn_chunks;
      for (int c = 0; c < p.ffn_chunks; ++c) {
        gemm_phase<EPI_UP, DM, 2 * DFF>(p.xn + (size_t)c * rows * DM, p.wts + (f ? W_UPB : W_UPA), rows, p.big, 0.f, lds);
        grid.sync();
        gemm_phase<EPI_RESID, DFF, DM>(p.big, p.wts + (f ? W_DNB : W_DNA), rows, p.h + (size_t)c * rows * DM, 0.5f, lds);
        grid.sync();
      }
      if (f == 0) { norm_phase(p, 1, p.norm_g + (layer * 3 + 1) * DM); grid.sync(); }
    }
    if (layer == 0) { convert_phase(p, 1, (float*)lds); norm_phase(p, 1, p.norm_g + 3 * DM); grid.sync(); }
  }
  norm_phase(p, 2, p.final_g);
}

extern "C" void kernel_launch(void* const* d_in, const int* in_sizes, int n_in, void* d_out, int out_size, void* d_ws, size_t ws_size, hipStream_t stream) {
  static int grid_blocks = 0;
  if (!grid_blocks) {
    int dev = 0, cus = 0, per_cu = 0;
    hipGetDevice(&dev);
    hipDeviceGetAttribute(&cus, hipDeviceAttributeMultiprocessorCount, dev);
    hipOccupancyMaxActiveBlocksPerMultiprocessor(&per_cu, fwd_megakernel, 512, 0);
    if (per_cu > 1) per_cu = 1;
    if (per_cu < 1) per_cu = 1;
    grid_blocks = cus * per_cu;
  }
  Params p{};
  p.x_prompt = (const float*)d_in[0]; p.x_sample = (const float*)d_in[1]; p.norm_g = (const float*)d_in[2];
  p.w1 = (const float*)d_in[3]; p.w3 = (const float*)d_in[4]; p.w2 = (const float*)d_in[5];
  p.ab_w_in = (const float*)d_in[6]; p.ab_w_out = (const float*)d_in[7]; p.ab_qg = (const float*)d_in[8]; p.ab_kg = (const float*)d_in[9];
  p.c_w_in = (const float*)d_in[10]; p.c_w_out = (const float*)d_in[11]; p.c_sink = (const float*)d_in[12]; p.final_g = (const float*)d_in[13];
  p.h = (float*)d_out;
  char* ws = (char*)d_ws;
  const size_t MiB = 1024 * 1024;
  p.wts = (bf16_t*)ws;
  p.xn = (bf16_t*)(ws + 40 * MiB);
  p.big = (bf16_t*)(ws + 104 * MiB);
  p.ffn_chunks = (ws_size >= 280 * MiB) ? 1 : 2;
  p.pad = 0;
  void* args[] = {&p};
  hipError_t e = hipLaunchCooperativeKernel((void*)fwd_megakernel, dim3(grid_blocks), dim3(512), args, 0, stream);
  if (e != hipSuccess) fprintf(stderr, "cooperative launch failed: %s (grid %d)\n", hipGetErrorString(e), grid_blocks);
}
```

```cpp
#include <hip/hip_runtime.h>
#include <hip/hip_cooperative_groups.h>
#include <cstdio>
namespace cg = cooperative_groups;

typedef unsigned short bf16_t;
typedef short bf16x8 __attribute__((ext_vector_type(8)));
typedef float f32x16 __attribute__((ext_vector_type(16)));
#define DI __device__ __forceinline__
#define OPAQUE_TID(v) int v = threadIdx.x; asm volatile("" : "+v"(v))
#define MFMA32(a, b, c) __builtin_amdgcn_mfma_f32_32x32x16_bf16((a), (b), (c), 0, 0, 0)

constexpr int NTOK = 32768, DM = 1024, DFF = 2816;
constexpr int PROMPT_T = 16384, SAMPLE_T = 4096;
constexpr float EPS = 1e-6f;
constexpr float LOG2E = 1.4426950408889634f;

constexpr size_t W_UPA = 0, W_DNA = 5767168, W_UPB = 8650752, W_DNB = 14417920, W_IN = 17301504, W_OUT = 19660800, W_TOTAL = 20709376;

struct Params {
  const float* x_prompt; const float* x_sample; const float* norm_g; const float* w1; const float* w3; const float* w2;
  const float* ab_w_in; const float* ab_w_out; const float* ab_qg; const float* ab_kg;
  const float* c_w_in; const float* c_w_out; const float* c_sink; const float* final_g;
  float* h; bf16_t* wts; bf16_t* xn; bf16_t* big; unsigned* bar;
  int ffn_chunks; int pad;
};

DI bf16_t f2bf(float x) { unsigned u = __float_as_uint(x); u += 0x7fffu + ((u >> 16) & 1u); return (bf16_t)(u >> 16); }
DI float bf2f(bf16_t v) { return __uint_as_float(((unsigned)v) << 16); }
DI float bflo(unsigned u) { return __uint_as_float(u << 16); }
DI float bfhi(unsigned u) { return __uint_as_float(u & 0xffff0000u); }
DI unsigned pack2(float lo, float hi) { return (unsigned)f2bf(lo) | ((unsigned)f2bf(hi) << 16); }
DI int crow(int reg, int h) { return (reg & 3) + 8 * (reg >> 2) + 4 * h; }

DI void convert_tile(const float* __restrict__ src, int K, int N, int kt, int nt, bf16_t* __restrict__ dst, int mode, float* lds) {
  OPAQUE_TID(tid);
#pragma unroll 4
  for (int i = 0; i < 8; ++i) { int e = tid + 512 * i; int kk = e >> 6, nn = e & 63; lds[kk * 65 + nn] = src[(size_t)(kt * 64 + kk) * N + nt * 64 + nn]; }
  __syncthreads();
#pragma unroll 4
  for (int i = 0; i < 8; ++i) {
    int e = tid + 512 * i; int nn = e >> 6, kk = e & 63; int n = nt * 64 + nn;
    int drow = (mode == 0) ? n : ((n >> 5) * 64 + (n & 31) + (mode == 2 ? 32 : 0));
    dst[(size_t)drow * K + kt * 64 + kk] = f2bf(lds[kk * 65 + nn]);
  }
  __syncthreads();
}

DI void convert_phase(const Params& p, int layer, float* lds) {
  const int n_in = (layer == 0) ? 2304 : 1536;
  const int t_up = 16 * 44, t_dn = 44 * 16, t_in = 16 * (n_in / 64), t_out = 16 * 16;
  const int total = 4 * t_up + 2 * t_dn + t_in + t_out;
  for (int u = blockIdx.x; u < total; u += gridDim.x) {
    int r = u; const float* src; bf16_t* dst; int K, N, mode;
    if (r < 6 * t_up) {
      int mtx = r / t_up; r -= mtx * t_up; int f = mtx / 3, which = mtx % 3;
      size_t base = (size_t)(layer * 2 + f) * DM * DFF;
      if (which == 0) { src = p.w1 + base; K = DM; N = DFF; mode = 1; dst = p.wts + (f ? W_UPB : W_UPA); }
      else if (which == 1) { src = p.w3 + base; K = DM; N = DFF; mode = 2; dst = p.wts + (f ? W_UPB : W_UPA); }
      else { src = p.w2 + base; K = DFF; N = DM; mode = 0; dst = p.wts + (f ? W_DNB : W_DNA); }
    } else if (r < 6 * t_up + t_in) {
      r -= 6 * t_up; src = (layer == 0) ? p.ab_w_in : p.c_w_in; K = DM; N = n_in; mode = 0; dst = p.wts + W_IN;
    } else {
      r -= 6 * t_up + t_in; src = (layer == 0) ? p.ab_w_out : p.c_w_out; K = DM; N = DM; mode = 0; dst = p.wts + W_OUT;
    }
    const int ntn = N / 64; const int kt = r / ntn, nt = r % ntn;
    convert_tile(src, K, N, kt, nt, dst, mode, lds);
  }
}

DI void norm_phase(const Params& p, int mode, const float* __restrict__ g) {
  OPAQUE_TID(tid);
  const int lane = tid & 63, wave = tid >> 6;
  float4 gv[4];
#pragma unroll
  for (int i = 0; i < 4; ++i) gv[i] = *(const float4*)(g + lane * 4 + 256 * i);
  for (int row = blockIdx.x * 8 + wave; row < NTOK; row += gridDim.x * 8) {
    const float* src = (mode == 0) ? ((row < PROMPT_T) ? p.x_prompt + (size_t)row * DM : p.x_sample + (size_t)(row - PROMPT_T) * DM) : p.h + (size_t)row * DM;
    float4 v[4]; float ss = 0.f;
#pragma unroll
    for (int i = 0; i < 4; ++i) { v[i] = *(const float4*)(src + lane * 4 + 256 * i); ss += v[i].x * v[i].x + v[i].y * v[i].y + v[i].z * v[i].z + v[i].w * v[i].w; }
#pragma unroll
    for (int o = 32; o > 0; o >>= 1) ss += __shfl_xor(ss, o);
    const float r = rsqrtf(ss * (1.0f / DM) + EPS);
#pragma unroll
    for (int i = 0; i < 4; ++i) {
      float4 y; y.x = v[i].x * r * gv[i].x; y.y = v[i].y * r * gv[i].y; y.z = v[i].z * r * gv[i].z; y.w = v[i].w * r * gv[i].w;
      if (mode == 0) *(float4*)(p.h + (size_t)row * DM + lane * 4 + 256 * i) = v[i];
      if (mode == 2) *(float4*)(p.h + (size_t)row * DM + lane * 4 + 256 * i) = y;
      else { uint2 o2; o2.x = pack2(y.x, y.y); o2.y = pack2(y.z, y.w); *(uint2*)(p.xn + (size_t)row * DM + lane * 4 + 256 * i) = o2; }
    }
  }
}

typedef float f32x4 __attribute__((ext_vector_type(4)));
constexpr int EPI_UP = 0, EPI_RESID = 1, EPI_BF16 = 2;
constexpr int TILE_B = 256 * 64 * 2, STAGE_B = 2 * TILE_B;
#define WAIT_V0() asm volatile("s_waitcnt vmcnt(0)" ::: "memory")
DI int lds_byte(int r, int c) { const int st = (r >> 4) * 2 + (c >> 5), ob = (r & 15) * 64 + (c & 31) * 2; return st * 1024 + (ob ^ (((ob >> 9) & 1) << 5)); }
DI void stage_rc(int b, int& R, int& C) { const int st = b >> 10, sb = b & 1023, swz = sb ^ (((sb >> 9) & 1) << 5); R = (st >> 1) * 16 + (swz >> 6); C = (st & 1) * 32 + ((swz & 63) >> 1); }

template <int EPI, int K, int N>
DI void gemm_phase(const bf16_t* __restrict__ A, const bf16_t* __restrict__ Bt, int M, void* outp, float coef, char* shm) {
  constexpr int lda = K, ldc = (EPI == EPI_UP) ? N / 2 : N;
  OPAQUE_TID(tid);
  const int wid = tid >> 6, lane = tid & 63, wr = wid >> 2, wc = wid & 3, fr = lane & 15, fq = lane >> 4;
  int sR0, sC0; stage_rc(wid * 1024 + lane * 16, sR0, sC0);
  const int soff = sR0 * K + sC0;
  const int nM = M / 256, nwg = nM * (N / 256);
  constexpr int nN = N / 256, nt = K / 64;
  for (int it = 0;; ++it) {
    int wgid = it * gridDim.x + blockIdx.x;
    if (wgid >= nwg) break;
    { const int q = nwg / 8, r = nwg % 8, xcd = wgid % 8, off = wgid / 8; wgid = (xcd < r ? xcd * (q + 1) : r * (q + 1) + (xcd - r) * q) + off; }
    const int nig = 8 * nN, gid = wgid / nig, fm = gid * 8, gsz = (nM - fm) < 8 ? (nM - fm) : 8;
    const int pm = fm + ((wgid % nig) % gsz), pn = (wgid % nig) / gsz, brow = pm * 256, bcol = pn * 256;
    const bf16_t* Ab = A + (size_t)brow * lda;
    const bf16_t* Bb = Bt + (size_t)bcol * K;
    f32x4 acc[4][8];
#pragma unroll
    for (int n = 0; n < 4; ++n)
#pragma unroll
      for (int m = 0; m < 8; ++m) acc[n][m] = f32x4{0.f, 0.f, 0.f, 0.f};
#define GLDS_STAGE(buf, kt) do { _Pragma("unroll") for (int i = 0; i < 4; ++i) { \
      __builtin_amdgcn_global_load_lds((const unsigned*)(Ab + soff + i * 64 * K + (kt) * 64), (unsigned*)(shm + (buf) * STAGE_B + wid * 1024 + i * 8192), 16, 0, 0); \
      __builtin_amdgcn_global_load_lds((const unsigned*)(Bb + soff + i * 64 * K + (kt) * 64), (unsigned*)(shm + (buf) * STAGE_B + TILE_B + wid * 1024 + i * 8192), 16, 0, 0); } } while (0)
    GLDS_STAGE(0, 0); WAIT_V0(); __syncthreads();
    for (int t = 0; t < nt; ++t) {
      const int cur = t & 1;
      if (t + 1 < nt) GLDS_STAGE(cur ^ 1, t + 1);
      const char* sa = shm + cur * STAGE_B; const char* sb = sa + TILE_B;
#pragma unroll
      for (int ks = 0; ks < 2; ++ks) {
        bf16x8 At[8], Bf[4];
#pragma unroll
        for (int m = 0; m < 8; ++m) At[m] = *(const bf16x8*)(sa + lds_byte(wr * 128 + m * 16 + fr, ks * 32 + fq * 8));
#pragma unroll
        for (int n = 0; n < 4; ++n) Bf[n] = *(const bf16x8*)(sb + lds_byte(wc * 64 + n * 16 + fr, ks * 32 + fq * 8));
#pragma unroll
        for (int m = 0; m < 8; ++m)
#pragma unroll
          for (int n = 0; n < 4; ++n) acc[n][m] = __builtin_amdgcn_mfma_f32_16x16x32_bf16(Bf[n], At[m], acc[n][m], 0, 0, 0);
        __builtin_amdgcn_sched_barrier(0);
      }
      WAIT_V0(); __syncthreads();
    }
#undef GLDS_STAGE
#pragma unroll
    for (int m = 0; m < 8; ++m) {
      const int row = brow + wr * 128 + m * 16 + fr;
      if (EPI == EPI_UP) {
#pragma unroll
        for (int n = 0; n < 2; ++n) {
          float a[4];
#pragma unroll
          for (int j = 0; j < 4; ++j) { const float u1 = acc[n][m][j], u3 = acc[n + 2][m][j]; a[j] = u1 / (1.f + __expf(-u1)) * u3; }
          uint2 o2; o2.x = pack2(a[0], a[1]); o2.y = pack2(a[2], a[3]);
          *(uint2*)((bf16_t*)outp + (size_t)row * ldc + pn * 128 + wc * 32 + n * 16 + 4 * fq) = o2;
        }
      } else {
#pragma unroll
        for (int n = 0; n < 4; ++n) {
          const int col = bcol + wc * 64 + n * 16 + 4 * fq;
          if (EPI == EPI_RESID) {
            float4* hp = (float4*)((float*)outp + (size_t)row * ldc + col); float4 v = *hp;
            v.x += coef * acc[n][m][0]; v.y += coef * acc[n][m][1]; v.z += coef * acc[n][m][2]; v.w += coef * acc[n][m][3]; *hp = v;
          } else {
            uint2 o2; o2.x = pack2(acc[n][m][0], acc[n][m][1]); o2.y = pack2(acc[n][m][2], acc[n][m][3]);
            *(uint2*)((bf16_t*)outp + (size_t)row * ldc + col) = o2;
          }
        }
      }
      __builtin_amdgcn_sched_barrier(0);
    }
  }
}

DI void bprep_phase(const Params& p) {
  OPAQUE_TID(tid);
  const int pi = tid & 31, tl = tid >> 5;
  const float fr = exp2f(-(float)((pi & 15) * 2) * (1.0f / 32.0f) * 13.287712379549449f);
  const float qg0 = p.ab_qg[2 * pi], qg1 = p.ab_qg[2 * pi + 1], kg0 = p.ab_kg[2 * pi], kg1 = p.ab_kg[2 * pi + 1];
  for (int t = blockIdx.x * 16 + tl; t < NTOK; t += gridDim.x * 16) {
    const int pos = (t < PROMPT_T) ? t : ((t - PROMPT_T) & (SAMPLE_T - 1));
    const float ang = (float)((pi < 16) ? (pos >> 6) : (pos & 63)) * fr;
    const float cs = __cosf(ang), sn = __sinf(ang);
    unsigned* rowp = (unsigned*)(p.big + (size_t)t * 2304);
#pragma unroll
    for (int hd = 0; hd < 10; ++hd) {
      const int col = (hd < 8) ? (1536 + hd * 64) : (2048 + (hd - 8) * 64);
      unsigned u = rowp[(col >> 1) + pi];
      float x1 = bflo(u), x2 = bfhi(u);
      float ss = x1 * x1 + x2 * x2;
#pragma unroll
      for (int o = 16; o > 0; o >>= 1) ss += __shfl_xor(ss, o);
      const float r = rsqrtf(ss * (1.0f / 64.0f) + EPS);
      x1 = x1 * r * ((hd < 8) ? qg0 : kg0); x2 = x2 * r * ((hd < 8) ? qg1 : kg1);
      rowp[(col >> 1) + pi] = pack2(x1 * cs - x2 * sn, x1 * sn + x2 * cs);
    }
  }
}

template <int MODE>
DI void naive_attn(const Params& p, const bf16_t* __restrict__ proj, int ld, int qoff, int koff, int voff, int nqh, int G, bf16_t* cat, int cat_off) {
  const int total = NTOK * nqh;
  for (int idx = blockIdx.x * 256 + threadIdx.x; idx < total; idx += gridDim.x * 256) {
    const int head = idx / NTOK, t = idx % NTOK, hk = head / G;
    const int seq_base = (t < PROMPT_T) ? 0 : (PROMPT_T + ((t - PROMPT_T) / SAMPLE_T) * SAMPLE_T);
    const int T = (t < PROMPT_T) ? PROMPT_T : SAMPLE_T;
    const int pos = t - seq_base;
    float q[64], o[64];
    { const uint4* qp = (const uint4*)(proj + (size_t)t * ld + qoff + head * 64);
#pragma unroll
      for (int c = 0; c < 8; ++c) { uint4 v = qp[c]; q[8*c] = bflo(v.x); q[8*c+1] = bfhi(v.x); q[8*c+2] = bflo(v.y); q[8*c+3] = bfhi(v.y); q[8*c+4] = bflo(v.z); q[8*c+5] = bfhi(v.z); q[8*c+6] = bflo(v.w); q[8*c+7] = bfhi(v.w); } }
#pragma unroll
    for (int d = 0; d < 64; ++d) o[d] = 0.f;
    float m = -1e30f, l = 0.f, slope = 0.f;
    if (MODE == 0) slope = exp2f(-(float)(head + 1));
    if (MODE == 2) { slope = exp2f(-0.5f * (float)(head + 1)); m = p.c_sink[head]; l = 1.f; }
    const int nkeys = (MODE == 0) ? 387 : (MODE == 1 ? T : 257);
    for (int j = 0; j < nkeys; ++j) {
      int off;
      if (MODE == 0) { const int br = j / 129, jj = j % 129 - 64; off = jj * (br == 0 ? 1 : (br == 1 ? 4 : 16)); }
      else if (MODE == 1) off = j - pos;
      else off = j - 128;
      const int kp = pos + off;
      if (kp < 0 || kp >= T) continue;
      const uint4* kptr = (const uint4*)(proj + (size_t)(seq_base + kp) * ld + koff + hk * 64);
      float s = 0.f;
#pragma unroll
      for (int c = 0; c < 8; ++c) { uint4 v = kptr[c];
        s += q[8*c] * bflo(v.x) + q[8*c+1] * bfhi(v.x) + q[8*c+2] * bflo(v.y) + q[8*c+3] * bfhi(v.y) + q[8*c+4] * bflo(v.z) + q[8*c+5] * bfhi(v.z) + q[8*c+6] * bflo(v.w) + q[8*c+7] * bfhi(v.w); }
      s *= 0.125f;
      if (MODE != 1) s -= slope * fabsf((float)off);
      const float mn = fmaxf(m, s); const float al = __expf(m - mn), pw = __expf(s - mn);
      m = mn; l = l * al + pw;
      const uint4* vptr = (const uint4*)(proj + (size_t)(seq_base + kp) * ld + voff + hk * 64);
#pragma unroll
      for (int c = 0; c < 8; ++c) { uint4 v = vptr[c];
        o[8*c] = o[8*c] * al + pw * bflo(v.x); o[8*c+1] = o[8*c+1] * al + pw * bfhi(v.x); o[8*c+2] = o[8*c+2] * al + pw * bflo(v.y); o[8*c+3] = o[8*c+3] * al + pw * bfhi(v.y);
        o[8*c+4] = o[8*c+4] * al + pw * bflo(v.z); o[8*c+5] = o[8*c+5] * al + pw * bfhi(v.z); o[8*c+6] = o[8*c+6] * al + pw * bflo(v.w); o[8*c+7] = o[8*c+7] * al + pw * bfhi(v.w); }
    }
    const float inv = 1.f / l;
    uint4* op = (uint4*)(cat + (size_t)t * DM + cat_off + head * 64);
#pragma unroll
    for (int c = 0; c < 8; ++c) { uint4 v; v.x = pack2(o[8*c] * inv, o[8*c+1] * inv); v.y = pack2(o[8*c+2] * inv, o[8*c+3] * inv); v.z = pack2(o[8*c+4] * inv, o[8*c+5] * inv); v.w = pack2(o[8*c+6] * inv, o[8*c+7] * inv); op[c] = v; }
  }
}

typedef short s16x4 __attribute__((ext_vector_type(4)));
typedef __attribute__((address_space(3))) s16x4* lds_s16x4_ptr;
DI s16x4 vtr(const char* p) { return __builtin_amdgcn_ds_read_tr16_b64_v4i16((lds_s16x4_ptr)p); }

template <int MODE>
DI void attn_unit(const bf16_t* __restrict__ proj, int ld, int seq_base, int kt0, int kt1, int koff, int voff,
                  int q0w, int qoff, int ooff, float slope2, float sink2, bf16_t* __restrict__ cat, char* lds) {
  OPAQUE_TID(tid);
  const int lane = tid & 63, wave = tid >> 6, r32 = lane & 31, hh = lane >> 5;
  constexpr float C2 = 0.125f * LOG2E;
  bf16x8 qf[4];
  { const bf16_t* qp = proj + (size_t)(seq_base + q0w + r32) * ld + qoff + hh * 8;
#pragma unroll
    for (int ks = 0; ks < 4; ++ks) qf[ks] = *(const bf16x8*)(qp + ks * 16); }
  f32x16 o0, o1;
#pragma unroll
  for (int r = 0; r < 16; ++r) { o0[r] = 0.f; o1[r] = 0.f; }
  float m = (MODE == 2) ? sink2 : -1e30f, l = 0.f;
  const int qpos = q0w + r32;
  const int skey = wave * 8 + (lane & 7), sc = lane >> 3;
  const bf16_t* kg = proj + (size_t)(seq_base + skey) * ld + koff + sc * 8;
  const bf16_t* vg = proj + (size_t)(seq_base + skey) * ld + voff + sc * 8;
  const int kw = sc * 1024 + skey * 16, vw = 16384 + (sc >> 2) * 4096 + skey * 64 + (sc & 3) * 16;
  uint4 rk0, rv0;
  { const size_t go = (size_t)kt0 * 64 * ld;
    rk0 = *(const uint4*)(kg + go); rv0 = *(const uint4*)(vg + go); }
  *(uint4*)(lds + kw) = rk0; *(uint4*)(lds + vw) = rv0;
  __syncthreads();
  const int kfo = hh * 1024 + r32 * 16;
  const int vfo = 16384 + (4 * hh + ((lane & 15) >> 2)) * 64 + ((lane >> 4) & 1) * 32 + (lane & 3) * 8;
  for (int kt = kt0; kt < kt1; ++kt) {
    const int buf = (kt - kt0) & 1;
    if (kt + 1 < kt1) { const size_t go = (size_t)(kt + 1) * 64 * ld;
      rk0 = *(const uint4*)(kg + go); rv0 = *(const uint4*)(vg + go); }
    bool active = true;
    if (MODE == 0) active = (kt * 64 + 63 >= q0w - 1024) && (kt * 64 <= q0w + 31 + 1024);
    if (active) {
      const char* kb_ = lds + buf * 8192 + kfo;
      f32x16 s0, s1;
#pragma unroll
      for (int r = 0; r < 16; ++r) { s0[r] = 0.f; s1[r] = 0.f; }
#pragma unroll
      for (int ks = 0; ks < 4; ++ks) {
        bf16x8 k0 = *(const bf16x8*)(kb_ + ks * 2048), k1 = *(const bf16x8*)(kb_ + ks * 2048 + 512);
        s0 = MFMA32(k0, qf[ks], s0); s1 = MFMA32(k1, qf[ks], s1);
      }
      const int d0 = kt * 64 + 4 * hh - qpos;
      float cw0[16], cw1[16];
      float mx = -1e30f;
#pragma unroll
      for (int r = 0; r < 16; ++r) {
        const int oa = d0 + (r & 3) + 8 * (r >> 2), ob = oa + 32;
        float va = s0[r] * C2, vb = s1[r] * C2;
        if (MODE == 0) {
          const int aa = oa < 0 ? -oa : oa, ab = ob < 0 ? -ob : ob;
          const int ca = (aa <= 64 ? 1 : 0) + (((oa & 3) == 0 && aa <= 256) ? 1 : 0) + (((oa & 15) == 0 && aa <= 1024) ? 1 : 0);
          const int cb = (ab <= 64 ? 1 : 0) + (((ob & 3) == 0 && ab <= 256) ? 1 : 0) + (((ob & 15) == 0 && ab <= 1024) ? 1 : 0);
          cw0[r] = (float)ca; cw1[r] = (float)cb;
          va = ca ? va - slope2 * (float)aa : -1e30f; vb = cb ? vb - slope2 * (float)ab : -1e30f;
        } else if (MODE == 2) {
          const int aa = oa < 0 ? -oa : oa, ab = ob < 0 ? -ob : ob;
          va = (aa <= 128) ? va - slope2 * (float)aa : -1e30f; vb = (ab <= 128) ? vb - slope2 * (float)ab : -1e30f;
        }
        s0[r] = va; s1[r] = vb; mx = fmaxf(mx, fmaxf(va, vb));
      }
      mx = fmaxf(mx, __shfl_xor(mx, 32));
      const float mn = fmaxf(m, mx), alpha = exp2f(m - mn);
      m = mn; l *= alpha;
#pragma unroll
      for (int r = 0; r < 16; ++r) { o0[r] *= alpha; o1[r] *= alpha; }
      float ls = 0.f;
#pragma unroll
      for (int r = 0; r < 16; ++r) {
        float pa = exp2f(s0[r] - mn), pb = exp2f(s1[r] - mn);
        if (MODE == 0) { pa *= cw0[r]; pb *= cw1[r]; }
        s0[r] = pa; s1[r] = pb; ls += pa + pb;
      }
      l += ls;
      bf16x8 pf[4];
#pragma unroll
      for (int ks = 0; ks < 4; ++ks) {
        unsigned w[4];
#pragma unroll
        for (int j = 0; j < 4; ++j) {
          const int r = 8 * (ks & 1) + 2 * j;
          w[j] = (ks < 2) ? pack2(s0[r], s0[r + 1]) : pack2(s1[r], s1[r + 1]);
        }
        uint4 t4; t4.x = w[0]; t4.y = w[1]; t4.z = w[2]; t4.w = w[3];
        pf[ks] = __builtin_bit_cast(bf16x8, t4);
      }
      const char* vb_ = lds + buf * 8192 + vfo;
#pragma unroll
      for (int ks = 0; ks < 4; ++ks) {
        s16x4 a0 = vtr(vb_ + ks * 1024), a1 = vtr(vb_ + ks * 1024 + 512);
        s16x4 b0 = vtr(vb_ + 4096 + ks * 1024), b1 = vtr(vb_ + 4096 + ks * 1024 + 512);
        bf16x8 v0 = __builtin_shufflevector(a0, a1, 0, 1, 2, 3, 4, 5, 6, 7);
        bf16x8 v1 = __builtin_shufflevector(b0, b1, 0, 1, 2, 3, 4, 5, 6, 7);
        o0 = MFMA32(v0, pf[ks], o0); o1 = MFMA32(v1, pf[ks], o1);
      }
    }
    if (kt + 1 < kt1) { char* wb = lds + (buf ^ 1) * 8192;
      *(uint4*)(wb + kw) = rk0; *(uint4*)(wb + vw) = rv0; }
    __syncthreads();
  }
  float lt = l + __shfl_xor(l, 32);
  if (MODE == 2) lt += exp2f(sink2 - m);
  const float inv = 1.f / lt;
  bf16_t* op = cat + (size_t)(seq_base + qpos) * DM + ooff + 4 * hh;
#pragma unroll
  for (int g = 0; g < 4; ++g) {
    uint2 a, b;
    a.x = pack2(o0[4 * g] * inv, o0[4 * g + 1] * inv); a.y = pack2(o0[4 * g + 2] * inv, o0[4 * g + 3] * inv);
    b.x = pack2(o1[4 * g] * inv, o1[4 * g + 1] * inv); b.y = pack2(o1[4 * g + 2] * inv, o1[4 * g + 3] * inv);
    *(uint2*)(op + 8 * g) = a; *(uint2*)(op + 32 + 8 * g) = b;
  }
}

DI void attn_phase_l0(const Params& p, char* lds) {
  OPAQUE_TID(tid0);
  const int wave = tid0 >> 6;
  for (int u = blockIdx.x; u < 2048; u += gridDim.x) {
    if (u < 1024) {
      int seq_base, T, kvh, qt;
      if (u < 512) { seq_base = 0; T = PROMPT_T; kvh = u >> 8; qt = u & 255; }
      else { const int v = u - 512; seq_base = PROMPT_T + (v >> 7) * SAMPLE_T; T = SAMPLE_T; kvh = (v >> 6) & 1; qt = v & 63; }
      const int head = kvh * 4 + (wave & 3);
      attn_unit<1>(p.big, 2304, seq_base, 0, T >> 6, 2048 + kvh * 64, 2176 + kvh * 64, qt * 64 + (wave >> 2) * 32, 1536 + head * 64, 512 + head * 64, 0.f, 0.f, p.xn, lds);
    } else {
      const int v = u - 1024, head = v >> 7, tok0 = (v & 127) * 256;
      const int seq_base = (tok0 < PROMPT_T) ? 0 : (PROMPT_T + ((tok0 - PROMPT_T) / SAMPLE_T) * SAMPLE_T);
      const int T = (tok0 < PROMPT_T) ? PROMPT_T : SAMPLE_T;
      const int q0b = tok0 - seq_base;
      int kt0 = (q0b - 1024) >> 6; if (kt0 < 0) kt0 = 0;
      int kt1 = ((q0b + 255 + 1024) >> 6) + 1; if (kt1 > (T >> 6)) kt1 = T >> 6;
      attn_unit<0>(p.big, 2304, seq_base, kt0, kt1, 512 + head * 64, 1024 + head * 64, q0b + wave * 32, head * 64, head * 64,
                   exp2f(-(float)(head + 1)) * LOG2E, 0.f, p.xn, lds);
    }
  }
}

DI void attn_phase_l1(const Params& p, char* lds) {
  OPAQUE_TID(tid0);
  const int wave = tid0 >> 6;
  for (int u = blockIdx.x; u < 2048; u += gridDim.x) {
    const int kvh = u >> 9, tok0 = (u & 511) * 64;
    const int seq_base = (tok0 < PROMPT_T) ? 0 : (PROMPT_T + ((tok0 - PROMPT_T) / SAMPLE_T) * SAMPLE_T);
    const int T = (tok0 < PROMPT_T) ? PROMPT_T : SAMPLE_T;
    const int q0 = tok0 - seq_base, head = kvh * 4 + (wave & 3);
    int kt0 = (q0 - 128) >> 6; if (kt0 < 0) kt0 = 0;
    int kt1 = ((q0 + 63 + 128) >> 6) + 1; if (kt1 > (T >> 6)) kt1 = T >> 6;
    attn_unit<2>(p.big, 1536, seq_base, kt0, kt1, 1024 + kvh * 64, 1280 + kvh * 64, q0 + (wave >> 2) * 32, head * 64, head * 64,
                 exp2f(-0.5f * (float)(head + 1)) * LOG2E, p.c_sink[head] * LOG2E, p.xn, lds);
  }
}

#define XB_TMO      128
#define XB_XCNT(j)  (256  + 64 * (j))
#define XB_XSUB(j)  (1280 + 64 * (j))
#define XB_XGEN(j)  (2304 + 64 * (j))
#define XB_TOP      3328
#define XB_TOPGEN   3392
#define XCD_BAR_WORDS 3456
#define XB_SPIN_CAP (1u << 22)
DI unsigned xb_ld(unsigned* p) { return __hip_atomic_load(p, __ATOMIC_RELAXED, __HIP_MEMORY_SCOPE_AGENT); }
DI unsigned xb_add(unsigned* p, unsigned v) { return __hip_atomic_fetch_add(p, v, __ATOMIC_RELAXED, __HIP_MEMORY_SCOPE_AGENT); }
DI unsigned xb_xcc_id() { return (unsigned)__builtin_amdgcn_s_getreg((3 << 11) | 20) & 0xFu; }
#define XB_SPIN(cond, bar) do { unsigned _sp = 0; while (cond) { __builtin_amdgcn_s_sleep(1); \
    if ((++_sp & 255u) == 0u) { if (xb_ld(&(bar)[XB_TMO])) break; if (_sp > XB_SPIN_CAP) { atomicAdd(&(bar)[XB_TMO], 1u); break; } } } } while (0)
struct XcdBarrier { unsigned* bar; unsigned x; volatile unsigned* st; };
DI void xcd_barrier_complete(unsigned* bar, unsigned x, unsigned& nloc, unsigned& nx) {
  const unsigned G = gridDim.x;
  unsigned sum, cnt, mine, sp = 0u;
  for (;;) {
    sum = 0u; cnt = 0u; mine = 0u;
#pragma unroll
    for (unsigned j = 0; j < 16; ++j) { const unsigned c = xb_ld(&bar[XB_XCNT(j)]); sum += c; cnt += (c > 0u) ? 1u : 0u; mine = (j == x) ? c : mine; }
    if (sum == G) break;
    __builtin_amdgcn_s_sleep(1);
    if ((++sp & 255u) == 0u) { if (xb_ld(&bar[XB_TMO])) break; if (sp > XB_SPIN_CAP) { atomicAdd(&bar[XB_TMO], 1u); break; } }
  }
  nloc = mine > 0u ? mine : 1u; nx = cnt > 0u ? cnt : 1u;
}
DI void xcd_barrier(const XcdBarrier& b) {
  asm volatile("s_waitcnt vmcnt(0)" ::: "memory");
  __syncthreads();
  if (threadIdx.x == 0) {
    unsigned* bar = b.bar;
    __builtin_amdgcn_s_waitcnt(0);
    unsigned nloc = b.st[0], nx = b.st[1];
    if (nloc == 0u) { xcd_barrier_complete(bar, b.x, nloc, nx); b.st[0] = nloc; b.st[1] = nx; }
    const unsigned old = xb_add(&bar[XB_XSUB(b.x)], 1u);
    const unsigned gen = old / nloc;
    if (old + 1u == (gen + 1u) * nloc) {
      __builtin_amdgcn_fence(__ATOMIC_RELEASE, "agent");
      asm volatile("s_waitcnt vmcnt(0)" ::: "memory");
      const unsigned og = xb_add(&bar[XB_TOP], 1u);
      const unsigned tg = og / nx;
      if (og + 1u == (tg + 1u) * nx) xb_add(&bar[XB_TOPGEN], 1u);
      else XB_SPIN(xb_ld(&bar[XB_TOPGEN]) == tg, bar);
      __builtin_amdgcn_fence(__ATOMIC_ACQUIRE, "agent");
      xb_add(&bar[XB_XGEN(b.x)], 1u);
      asm volatile("s_waitcnt vmcnt(0)" ::: "memory");
    } else {
      XB_SPIN(xb_ld(&bar[XB_XGEN(b.x)]) == gen, bar);
      __builtin_amdgcn_fence(__ATOMIC_ACQUIRE, "agent");
      asm volatile("s_waitcnt vmcnt(0)" ::: "memory");
    }
  }
  __syncthreads();
}

__global__ void __launch_bounds__(512) fwd_megakernel(Params p) {
  cg::grid_group grid = cg::this_grid();
  __shared__ __attribute__((aligned(1024))) char lds[2 * STAGE_B + 16];
  volatile unsigned* bst = (volatile unsigned*)(lds + 2 * STAGE_B);
  if (threadIdx.x < 2) bst[threadIdx.x] = 0u;
  __syncthreads();
  XcdBarrier xb; xb.bar = p.bar; xb.x = xb_xcc_id(); xb.st = bst;
  if (threadIdx.x == 0) (void)xb_add(&p.bar[XB_XCNT(xb.x)], 1u);
  convert_phase(p, 0, (float*)lds);
  norm_phase(p, 0, p.norm_g);
  grid.sync();
  for (int layer = 0; layer < 2; ++layer) {
    for (int f = 0; f < 2; ++f) {
      if (f == 1) {
        if (layer == 0) gemm_phase<EPI_BF16, DM, 2304>(p.xn, p.wts + W_IN, NTOK, p.big, 0.f, lds);
        else gemm_phase<EPI_BF16, DM, 1536>(p.xn, p.wts + W_IN, NTOK, p.big, 0.f, lds);
        xcd_barrier(xb);
        if (layer == 0) {
          bprep_phase(p);
          xcd_barrier(xb);
          attn_phase_l0(p, lds);
        } else {
          attn_phase_l1(p, lds);
        }
        xcd_barrier(xb);
        gemm_phase<EPI_RESID, DM, DM>(p.xn, p.wts + W_OUT, NTOK, p.h, 1.0f, lds);
        xcd_barrier(xb);
        norm_phase(p, 1, p.norm_g + (layer * 3 + 2) * DM);
        xcd_barrier(xb);
      }
      const int rows = NTOK / p.ffn_chunks;
      for (int c = 0; c < p.ffn_chunks; ++c) {
        gemm_phase<EPI_UP, DM, 2 * DFF>(p.xn + (size_t)c * rows * DM, p.wts + (f ? W_UPB : W_UPA), rows, p.big, 0.f, lds);
        xcd_barrier(xb);
        gemm_phase<EPI_RESID, DFF, DM>(p.big, p.wts + (f ? W_DNB : W_DNA), rows, p.h + (size_t)c * rows * DM, 0.5f, lds);
        xcd_barrier(xb);
      }
      if (f == 0) { norm_phase(p, 1, p.norm_g + (layer * 3 + 1) * DM); xcd_barrier(xb); }
    }
    if (layer == 0) { convert_phase(p, 1, (float*)lds); norm_phase(p, 1, p.norm_g + 3 * DM); xcd_barrier(xb); }
  }
  norm_phase(p, 2, p.final_g);
}

extern "C" void kernel_launch(void* const* d_in, const int* in_sizes, int n_in, void* d_out, int out_size, void* d_ws, size_t ws_size, hipStream_t stream) {
  static int grid_blocks = 0;
  if (!grid_blocks) {
    int dev = 0, cus = 0, per_cu = 0;
    hipGetDevice(&dev);
    hipDeviceGetAttribute(&cus, hipDeviceAttributeMultiprocessorCount, dev);
    hipOccupancyMaxActiveBlocksPerMultiprocessor(&per_cu, fwd_megakernel, 512, 0);
    if (per_cu > 1) per_cu = 1;
    if (per_cu < 1) per_cu = 1;
    grid_blocks = cus * per_cu;
  }
  Params p{};
  p.x_prompt = (const float*)d_in[0]; p.x_sample = (const float*)d_in[1]; p.norm_g = (const float*)d_in[2];
  p.w1 = (const float*)d_in[3]; p.w3 = (const float*)d_in[4]; p.w2 = (const float*)d_in[5];
  p.ab_w_in = (const float*)d_in[6]; p.ab_w_out = (const float*)d_in[7]; p.ab_qg = (const float*)d_in[8]; p.ab_kg = (const float*)d_in[9];
  p.c_w_in = (const float*)d_in[10]; p.c_w_out = (const float*)d_in[11]; p.c_sink = (const float*)d_in[12]; p.final_g = (const float*)d_in[13];
  p.h = (float*)d_out;
  char* ws = (char*)d_ws;
  const size_t MiB = 1024 * 1024;
  p.wts = (bf16_t*)ws;
  p.xn = (bf16_t*)(ws + 40 * MiB);
  p.big = (bf16_t*)(ws + 104 * MiB);
  p.bar = (unsigned*)(ws + 280 * MiB);
  p.ffn_chunks = (ws_size >= 280 * MiB + 65536) ? 1 : 2;
  if (p.ffn_chunks == 2) p.bar = (unsigned*)(ws + 250 * MiB);
  hipMemsetAsync(p.bar, 0, XCD_BAR_WORDS * sizeof(unsigned), stream);
  p.pad = 0;
  void* args[] = {&p};
  hipError_t e = hipLaunchCooperativeKernel((void*)fwd_megakernel, dim3(grid_blocks), dim3(512), args, 0, stream);
  if (e != hipSuccess) fprintf(stderr, "cooperative launch failed: %s (grid %d)\n", hipGetErrorString(e), grid_blocks);
}
```

```cpp
#include <hip/hip_runtime.h>
#include <hip/hip_cooperative_groups.h>
#include <cstdio>
namespace cg = cooperative_groups;

typedef unsigned short bf16_t;
typedef short bf16x8 __attribute__((ext_vector_type(8)));
typedef float f32x16 __attribute__((ext_vector_type(16)));
#define DI __device__ __forceinline__
#define OPAQUE_TID(v) int v = threadIdx.x; asm volatile("" : "+v"(v))
#define MFMA32(a, b, c) __builtin_amdgcn_mfma_f32_32x32x16_bf16((a), (b), (c), 0, 0, 0)

constexpr int NTOK = 32768, DM = 1024, DFF = 2816;
constexpr int PROMPT_T = 16384, SAMPLE_T = 4096;
constexpr float EPS = 1e-6f;
constexpr float LOG2E = 1.4426950408889634f;

constexpr size_t W_UPA = 0, W_DNA = 5767168, W_UPB = 8650752, W_DNB = 14417920, W_IN = 17301504, W_OUT = 19660800, W_TOTAL = 20709376;

struct Params {
  const float* x_prompt; const float* x_sample; const float* norm_g; const float* w1; const float* w3; const float* w2;
  const float* ab_w_in; const float* ab_w_out; const float* ab_qg; const float* ab_kg;
  const float* c_w_in; const float* c_w_out; const float* c_sink; const float* final_g;
  float* h; bf16_t* wts; bf16_t* xn; bf16_t* big; unsigned* bar;
  int ffn_chunks; int pad;
};

DI bf16_t f2bf(float x) { unsigned u = __float_as_uint(x); u += 0x7fffu + ((u >> 16) & 1u); return (bf16_t)(u >> 16); }
DI float bf2f(bf16_t v) { return __uint_as_float(((unsigned)v) << 16); }
DI float bflo(unsigned u) { return __uint_as_float(u << 16); }
DI float bfhi(unsigned u) { return __uint_as_float(u & 0xffff0000u); }
typedef __bf16 bf16x2_t __attribute__((ext_vector_type(2)));
typedef float f32x2_t __attribute__((ext_vector_type(2)));
DI unsigned pack2(float lo, float hi) { f32x2_t v = {lo, hi}; return __builtin_bit_cast(unsigned, __builtin_convertvector(v, bf16x2_t)); }
DI int crow(int reg, int h) { return (reg & 3) + 8 * (reg >> 2) + 4 * h; }

DI void convert_tile(const float* __restrict__ src, int K, int N, int kt, int nt, bf16_t* __restrict__ dst, int mode, float* lds) {
  OPAQUE_TID(tid);
#pragma unroll 4
  for (int i = 0; i < 8; ++i) { int e = tid + 512 * i; int kk = e >> 6, nn = e & 63; lds[kk * 65 + nn] = src[(size_t)(kt * 64 + kk) * N + nt * 64 + nn]; }
  __syncthreads();
#pragma unroll 4
  for (int i = 0; i < 8; ++i) {
    int e = tid + 512 * i; int nn = e >> 6, kk = e & 63; int n = nt * 64 + nn;
    int drow = (mode == 0) ? n : ((n >> 5) * 64 + (n & 31) + (mode == 2 ? 32 : 0));
    dst[(size_t)drow * K + kt * 64 + kk] = f2bf(lds[kk * 65 + nn]);
  }
  __syncthreads();
}

DI void convert_phase(const Params& p, int layer, float* lds) {
  const int n_in = (layer == 0) ? 2304 : 1536;
  const int t_up = 16 * 44, t_dn = 44 * 16, t_in = 16 * (n_in / 64), t_out = 16 * 16;
  const int total = 4 * t_up + 2 * t_dn + t_in + t_out;
  for (int u = blockIdx.x; u < total; u += gridDim.x) {
    int r = u; const float* src; bf16_t* dst; int K, N, mode;
    if (r < 6 * t_up) {
      int mtx = r / t_up; r -= mtx * t_up; int f = mtx / 3, which = mtx % 3;
      size_t base = (size_t)(layer * 2 + f) * DM * DFF;
      if (which == 0) { src = p.w1 + base; K = DM; N = DFF; mode = 1; dst = p.wts + (f ? W_UPB : W_UPA); }
      else if (which == 1) { src = p.w3 + base; K = DM; N = DFF; mode = 2; dst = p.wts + (f ? W_UPB : W_UPA); }
      else { src = p.w2 + base; K = DFF; N = DM; mode = 0; dst = p.wts + (f ? W_DNB : W_DNA); }
    } else if (r < 6 * t_up + t_in) {
      r -= 6 * t_up; src = (layer == 0) ? p.ab_w_in : p.c_w_in; K = DM; N = n_in; mode = 0; dst = p.wts + W_IN;
    } else {
      r -= 6 * t_up + t_in; src = (layer == 0) ? p.ab_w_out : p.c_w_out; K = DM; N = DM; mode = 0; dst = p.wts + W_OUT;
    }
    const int ntn = N / 64; const int kt = r / ntn, nt = r % ntn;
    convert_tile(src, K, N, kt, nt, dst, mode, lds);
  }
}

DI void norm_phase(const Params& p, int mode, const float* __restrict__ g) {
  OPAQUE_TID(tid);
  const int lane = tid & 63, wave = tid >> 6;
  float4 gv[4];
#pragma unroll
  for (int i = 0; i < 4; ++i) gv[i] = *(const float4*)(g + lane * 4 + 256 * i);
  for (int row = blockIdx.x * 8 + wave; row < NTOK; row += gridDim.x * 8) {
    const float* src = (mode == 0) ? ((row < PROMPT_T) ? p.x_prompt + (size_t)row * DM : p.x_sample + (size_t)(row - PROMPT_T) * DM) : p.h + (size_t)row * DM;
    float4 v[4]; float ss = 0.f;
#pragma unroll
    for (int i = 0; i < 4; ++i) { v[i] = *(const float4*)(src + lane * 4 + 256 * i); ss += v[i].x * v[i].x + v[i].y * v[i].y + v[i].z * v[i].z + v[i].w * v[i].w; }
#pragma unroll
    for (int o = 32; o > 0; o >>= 1) ss += __shfl_xor(ss, o);
    const float r = rsqrtf(ss * (1.0f / DM) + EPS);
#pragma unroll
    for (int i = 0; i < 4; ++i) {
      float4 y; y.x = v[i].x * r * gv[i].x; y.y = v[i].y * r * gv[i].y; y.z = v[i].z * r * gv[i].z; y.w = v[i].w * r * gv[i].w;
      if (mode == 0) *(float4*)(p.h + (size_t)row * DM + lane * 4 + 256 * i) = v[i];
      if (mode == 2) *(float4*)(p.h + (size_t)row * DM + lane * 4 + 256 * i) = y;
      else { uint2 o2; o2.x = pack2(y.x, y.y); o2.y = pack2(y.z, y.w); *(uint2*)(p.xn + (size_t)row * DM + lane * 4 + 256 * i) = o2; }
    }
  }
}

typedef float f32x4 __attribute__((ext_vector_type(4)));
constexpr int EPI_UP = 0, EPI_RESID = 1, EPI_BF16 = 2;
constexpr int TILE_B = 256 * 64 * 2, STAGE_B = 2 * TILE_B;
#define WAIT_V0() asm volatile("s_waitcnt vmcnt(0)" ::: "memory")
DI int lds_byte(int r, int c) { const int st = (r >> 4) * 2 + (c >> 5), ob = (r & 15) * 64 + (c & 31) * 2; return st * 1024 + (ob ^ (((ob >> 9) & 1) << 5)); }
DI void stage_rc(int b, int& R, int& C) { const int st = b >> 10, sb = b & 1023, swz = sb ^ (((sb >> 9) & 1) << 5); R = (st >> 1) * 16 + (swz >> 6); C = (st & 1) * 32 + ((swz & 63) >> 1); }

template <int EPI, int K, int N>
DI void gemm_phase(const bf16_t* __restrict__ A, const bf16_t* __restrict__ Bt, int M, void* outp, float coef, char* shm) {
  constexpr int lda = K, ldc = (EPI == EPI_UP) ? N / 2 : N;
  OPAQUE_TID(tid);
  const int wid = tid >> 6, lane = tid & 63, wr = wid >> 2, wc = wid & 3, fr = lane & 15, fq = lane >> 4;
  int sR0, sC0; stage_rc(wid * 1024 + lane * 16, sR0, sC0);
  const int soff = sR0 * K + sC0;
  const int nM = M / 256, nwg = nM * (N / 256);
  constexpr int nN = N / 256, nt = K / 64;
  for (int it = 0;; ++it) {
    int wgid = it * gridDim.x + blockIdx.x;
    if (wgid >= nwg) break;
    { const int q = nwg / 8, r = nwg % 8, xcd = wgid % 8, off = wgid / 8; wgid = (xcd < r ? xcd * (q + 1) : r * (q + 1) + (xcd - r) * q) + off; }
    const int nig = 8 * nN, gid = wgid / nig, fm = gid * 8, gsz = (nM - fm) < 8 ? (nM - fm) : 8;
    const int pm = fm + ((wgid % nig) % gsz), pn = (wgid % nig) / gsz, brow = pm * 256, bcol = pn * 256;
    const bf16_t* Ab = A + (size_t)brow * lda;
    const bf16_t* Bb = Bt + (size_t)bcol * K;
    f32x4 acc[4][8];
#pragma unroll
    for (int n = 0; n < 4; ++n)
#pragma unroll
      for (int m = 0; m < 8; ++m) acc[n][m] = f32x4{0.f, 0.f, 0.f, 0.f};
#define GLDS_STAGE(buf, kt) do { _Pragma("unroll") for (int i = 0; i < 4; ++i) { \
      __builtin_amdgcn_global_load_lds((const unsigned*)(Ab + soff + i * 64 * K + (kt) * 64), (unsigned*)(shm + (buf) * STAGE_B + wid * 1024 + i * 8192), 16, 0, 0); \
      __builtin_amdgcn_global_load_lds((const unsigned*)(Bb + soff + i * 64 * K + (kt) * 64), (unsigned*)(shm + (buf) * STAGE_B + TILE_B + wid * 1024 + i * 8192), 16, 0, 0); } } while (0)
    GLDS_STAGE(0, 0); WAIT_V0(); __syncthreads();
    for (int t = 0; t < nt; ++t) {
      const int cur = t & 1;
      if (t + 1 < nt) GLDS_STAGE(cur ^ 1, t + 1);
      const char* sa = shm + cur * STAGE_B; const char* sb = sa + TILE_B;
#pragma unroll
      for (int ks = 0; ks < 2; ++ks) {
        bf16x8 At[8], Bf[4];
#pragma unroll
        for (int m = 0; m < 8; ++m) At[m] = *(const bf16x8*)(sa + lds_byte(wr * 128 + m * 16 + fr, ks * 32 + fq * 8));
#pragma unroll
        for (int n = 0; n < 4; ++n) Bf[n] = *(const bf16x8*)(sb + lds_byte(wc * 64 + n * 16 + fr, ks * 32 + fq * 8));
#pragma unroll
        for (int m = 0; m < 8; ++m)
#pragma unroll
          for (int n = 0; n < 4; ++n) acc[n][m] = __builtin_amdgcn_mfma_f32_16x16x32_bf16(Bf[n], At[m], acc[n][m], 0, 0, 0);
        __builtin_amdgcn_sched_barrier(0);
      }
      WAIT_V0(); __syncthreads();
    }
#undef GLDS_STAGE
#pragma unroll
    for (int m = 0; m < 8; ++m) {
      const int row = brow + wr * 128 + m * 16 + fr;
      if (EPI == EPI_UP) {
#pragma unroll
        for (int n = 0; n < 2; ++n) {
          float a[4];
#pragma unroll
          for (int j = 0; j < 4; ++j) { const float u1 = acc[n][m][j], u3 = acc[n + 2][m][j]; a[j] = u1 / (1.f + __expf(-u1)) * u3; }
          uint2 o2; o2.x = pack2(a[0], a[1]); o2.y = pack2(a[2], a[3]);
          *(uint2*)((bf16_t*)outp + (size_t)row * ldc + pn * 128 + wc * 32 + n * 16 + 4 * fq) = o2;
        }
      } else {
#pragma unroll
        for (int n = 0; n < 4; ++n) {
          const int col = bcol + wc * 64 + n * 16 + 4 * fq;
          if (EPI == EPI_RESID) {
            float4* hp = (float4*)((float*)outp + (size_t)row * ldc + col); float4 v = *hp;
            v.x += coef * acc[n][m][0]; v.y += coef * acc[n][m][1]; v.z += coef * acc[n][m][2]; v.w += coef * acc[n][m][3]; *hp = v;
          } else {
            uint2 o2; o2.x = pack2(acc[n][m][0], acc[n][m][1]); o2.y = pack2(acc[n][m][2], acc[n][m][3]);
            *(uint2*)((bf16_t*)outp + (size_t)row * ldc + col) = o2;
          }
        }
      }
      __builtin_amdgcn_sched_barrier(0);
    }
  }
}

DI void bprep_phase(const Params& p) {
  OPAQUE_TID(tid);
  const int pi = tid & 31, tl = tid >> 5;
  const float fr = exp2f(-(float)((pi & 15) * 2) * (1.0f / 32.0f) * 13.287712379549449f);
  const float qg0 = p.ab_qg[2 * pi], qg1 = p.ab_qg[2 * pi + 1], kg0 = p.ab_kg[2 * pi], kg1 = p.ab_kg[2 * pi + 1];
  for (int t = blockIdx.x * 16 + tl; t < NTOK; t += gridDim.x * 16) {
    const int pos = (t < PROMPT_T) ? t : ((t - PROMPT_T) & (SAMPLE_T - 1));
    const float ang = (float)((pi < 16) ? (pos >> 6) : (pos & 63)) * fr;
    const float cs = __cosf(ang), sn = __sinf(ang);
    unsigned* rowp = (unsigned*)(p.big + (size_t)t * 2304);
#pragma unroll
    for (int hd = 0; hd < 10; ++hd) {
      const int col = (hd < 8) ? (1536 + hd * 64) : (2048 + (hd - 8) * 64);
      unsigned u = rowp[(col >> 1) + pi];
      float x1 = bflo(u), x2 = bfhi(u);
      float ss = x1 * x1 + x2 * x2;
#pragma unroll
      for (int o = 16; o > 0; o >>= 1) ss += __shfl_xor(ss, o);
      const float r = rsqrtf(ss * (1.0f / 64.0f) + EPS);
      x1 = x1 * r * ((hd < 8) ? qg0 : kg0); x2 = x2 * r * ((hd < 8) ? qg1 : kg1);
      rowp[(col >> 1) + pi] = pack2(x1 * cs - x2 * sn, x1 * sn + x2 * cs);
    }
  }
}

template <int MODE>
DI void naive_attn(const Params& p, const bf16_t* __restrict__ proj, int ld, int qoff, int koff, int voff, int nqh, int G, bf16_t* cat, int cat_off) {
  const int total = NTOK * nqh;
  for (int idx = blockIdx.x * 256 + threadIdx.x; idx < total; idx += gridDim.x * 256) {
    const int head = idx / NTOK, t = idx % NTOK, hk = head / G;
    const int seq_base = (t < PROMPT_T) ? 0 : (PROMPT_T + ((t - PROMPT_T) / SAMPLE_T) * SAMPLE_T);
    const int T = (t < PROMPT_T) ? PROMPT_T : SAMPLE_T;
    const int pos = t - seq_base;
    float q[64], o[64];
    { const uint4* qp = (const uint4*)(proj + (size_t)t * ld + qoff + head * 64);
#pragma unroll
      for (int c = 0; c < 8; ++c) { uint4 v = qp[c]; q[8*c] = bflo(v.x); q[8*c+1] = bfhi(v.x); q[8*c+2] = bflo(v.y); q[8*c+3] = bfhi(v.y); q[8*c+4] = bflo(v.z); q[8*c+5] = bfhi(v.z); q[8*c+6] = bflo(v.w); q[8*c+7] = bfhi(v.w); } }
#pragma unroll
    for (int d = 0; d < 64; ++d) o[d] = 0.f;
    float m = -1e30f, l = 0.f, slope = 0.f;
    if (MODE == 0) slope = exp2f(-(float)(head + 1));
    if (MODE == 2) { slope = exp2f(-0.5f * (float)(head + 1)); m = p.c_sink[head]; l = 1.f; }
    const int nkeys = (MODE == 0) ? 387 : (MODE == 1 ? T : 257);
    for (int j = 0; j < nkeys; ++j) {
      int off;
      if (MODE == 0) { const int br = j / 129, jj = j % 129 - 64; off = jj * (br == 0 ? 1 : (br == 1 ? 4 : 16)); }
      else if (MODE == 1) off = j - pos;
      else off = j - 128;
      const int kp = pos + off;
      if (kp < 0 || kp >= T) continue;
      const uint4* kptr = (const uint4*)(proj + (size_t)(seq_base + kp) * ld + koff + hk * 64);
      float s = 0.f;
#pragma unroll
      for (int c = 0; c < 8; ++c) { uint4 v = kptr[c];
        s += q[8*c] * bflo(v.x) + q[8*c+1] * bfhi(v.x) + q[8*c+2] * bflo(v.y) + q[8*c+3] * bfhi(v.y) + q[8*c+4] * bflo(v.z) + q[8*c+5] * bfhi(v.z) + q[8*c+6] * bflo(v.w) + q[8*c+7] * bfhi(v.w); }
      s *= 0.125f;
      if (MODE != 1) s -= slope * fabsf((float)off);
      const float mn = fmaxf(m, s); const float al = __expf(m - mn), pw = __expf(s - mn);
      m = mn; l = l * al + pw;
      const uint4* vptr = (const uint4*)(proj + (size_t)(seq_base + kp) * ld + voff + hk * 64);
#pragma unroll
      for (int c = 0; c < 8; ++c) { uint4 v = vptr[c];
        o[8*c] = o[8*c] * al + pw * bflo(v.x); o[8*c+1] = o[8*c+1] * al + pw * bfhi(v.x); o[8*c+2] = o[8*c+2] * al + pw * bflo(v.y); o[8*c+3] = o[8*c+3] * al + pw * bfhi(v.y);
        o[8*c+4] = o[8*c+4] * al + pw * bflo(v.z); o[8*c+5] = o[8*c+5] * al + pw * bfhi(v.z); o[8*c+6] = o[8*c+6] * al + pw * bflo(v.w); o[8*c+7] = o[8*c+7] * al + pw * bfhi(v.w); }
    }
    const float inv = 1.f / l;
    uint4* op = (uint4*)(cat + (size_t)t * DM + cat_off + head * 64);
#pragma unroll
    for (int c = 0; c < 8; ++c) { uint4 v; v.x = pack2(o[8*c] * inv, o[8*c+1] * inv); v.y = pack2(o[8*c+2] * inv, o[8*c+3] * inv); v.z = pack2(o[8*c+4] * inv, o[8*c+5] * inv); v.w = pack2(o[8*c+6] * inv, o[8*c+7] * inv); op[c] = v; }
  }
}

typedef short s16x4 __attribute__((ext_vector_type(4)));
typedef __attribute__((address_space(3))) s16x4* lds_s16x4_ptr;
DI s16x4 vtr(const char* p) { return __builtin_amdgcn_ds_read_tr16_b64_v4i16((lds_s16x4_ptr)p); }

template <int MODE, int NQ>
DI void attn_unit(const bf16_t* __restrict__ proj, int ld, int seq_base, int kt0, int kt1, int koff, int voff,
                  int q0w, int qoff, int ooff, float slope2, float sink2, bf16_t* __restrict__ cat, char* lds) {
  OPAQUE_TID(tid);
  const int lane = tid & 63, wave = tid >> 6, r32 = lane & 31, hh = lane >> 5;
  constexpr float C2 = 0.125f * LOG2E;
  bf16x8 qf[NQ][4];
#pragma unroll
  for (int nq = 0; nq < NQ; ++nq) { const bf16_t* qp = proj + (size_t)(seq_base + q0w + 32 * nq + r32) * ld + qoff + hh * 8;
#pragma unroll
    for (int ks = 0; ks < 4; ++ks) qf[nq][ks] = *(const bf16x8*)(qp + ks * 16); }
  f32x16 o[NQ][2];
  float m2[NQ], l[NQ];
#pragma unroll
  for (int nq = 0; nq < NQ; ++nq) { m2[nq] = (MODE == 2) ? sink2 : -1e30f; l[nq] = 0.f;
#pragma unroll
    for (int r = 0; r < 16; ++r) { o[nq][0][r] = 0.f; o[nq][1][r] = 0.f; } }
  const int skey = wave * 8 + (lane & 7), sc = lane >> 3;
  const bf16_t* kg = proj + (size_t)(seq_base + skey) * ld + koff + sc * 8;
  const bf16_t* vg = proj + (size_t)(seq_base + skey) * ld + voff + sc * 8;
  const int kw = sc * 1024 + skey * 16, vw = 16384 + (sc >> 2) * 4096 + skey * 64 + (sc & 3) * 16;
  uint4 rk0, rv0;
  { const size_t go = (size_t)kt0 * 64 * ld; rk0 = *(const uint4*)(kg + go); rv0 = *(const uint4*)(vg + go); }
  *(uint4*)(lds + kw) = rk0; *(uint4*)(lds + vw) = rv0;
  __syncthreads();
  const int kfo = hh * 1024 + r32 * 16;
  const int vfo = 16384 + (4 * hh + ((lane & 15) >> 2)) * 64 + ((lane >> 4) & 1) * 32 + (lane & 3) * 8;
  for (int kt = kt0; kt < kt1; ++kt) {
    const int buf = (kt - kt0) & 1;
    if (kt + 1 < kt1) { const size_t go = (size_t)(kt + 1) * 64 * ld; rk0 = *(const uint4*)(kg + go); rv0 = *(const uint4*)(vg + go); }
    bool active = true;
    if (MODE == 0) active = (kt * 64 + 63 >= q0w - 1024) && (kt * 64 <= q0w + 32 * NQ - 1 + 1024);
    if (active) {
      const char* kb_ = lds + buf * 8192 + kfo;
      f32x16 s[NQ][2];
#pragma unroll
      for (int nq = 0; nq < NQ; ++nq)
#pragma unroll
        for (int r = 0; r < 16; ++r) { s[nq][0][r] = 0.f; s[nq][1][r] = 0.f; }
#pragma unroll
      for (int ks = 0; ks < 4; ++ks) {
        const bf16x8 k0 = *(const bf16x8*)(kb_ + ks * 2048), k1 = *(const bf16x8*)(kb_ + ks * 2048 + 512);
#pragma unroll
        for (int nq = 0; nq < NQ; ++nq) { s[nq][0] = MFMA32(k0, qf[nq][ks], s[nq][0]); s[nq][1] = MFMA32(k1, qf[nq][ks], s[nq][1]); }
      }
      bf16x8 pf[NQ][4];
#pragma unroll
      for (int nq = 0; nq < NQ; ++nq) {
        f32x16& s0 = s[nq][0]; f32x16& s1 = s[nq][1];
        float mx = -1e30f;
        float cw0[(MODE == 0) ? 16 : 1], cw1[(MODE == 0) ? 16 : 1];
        if (MODE == 1) {
#pragma unroll
          for (int r = 0; r < 16; r += 2) mx = fmaxf(fmaxf(mx, fmaxf(s0[r], s0[r + 1])), fmaxf(s1[r], s1[r + 1]));
          mx *= C2;
        } else {
          const int d0 = kt * 64 + 4 * hh - (q0w + 32 * nq + r32);
#pragma unroll
          for (int r = 0; r < 16; ++r) {
            const int oa = d0 + (r & 3) + 8 * (r >> 2), ob = oa + 32;
            const int aa = oa < 0 ? -oa : oa, ab = ob < 0 ? -ob : ob;
            float va = fmaf(s0[r], C2, -slope2 * (float)aa), vb = fmaf(s1[r], C2, -slope2 * (float)ab);
            if (MODE == 0) {
              const int ca = (aa <= 64 ? 1 : 0) + (((oa & 3) == 0 && aa <= 256) ? 1 : 0) + (((oa & 15) == 0 && aa <= 1024) ? 1 : 0);
              const int cb = (ab <= 64 ? 1 : 0) + (((ob & 3) == 0 && ab <= 256) ? 1 : 0) + (((ob & 15) == 0 && ab <= 1024) ? 1 : 0);
              cw0[r] = (float)ca; cw1[r] = (float)cb;
              va = ca ? va : -1e30f; vb = cb ? vb : -1e30f;
            } else {
              va = (aa <= 128) ? va : -1e30f; vb = (ab <= 128) ? vb : -1e30f;
            }
            s0[r] = va; s1[r] = vb; mx = fmaxf(mx, fmaxf(va, vb));
          }
        }
        mx = fmaxf(mx, __shfl_xor(mx, 32));
        const float mn = fmaxf(m2[nq], mx);
        if (__any(mn > m2[nq])) {
          const float alpha = __builtin_amdgcn_exp2f(m2[nq] - mn);
          l[nq] *= alpha;
#pragma unroll
          for (int r = 0; r < 16; ++r) { o[nq][0][r] *= alpha; o[nq][1][r] *= alpha; }
        }
        m2[nq] = mn;
        float ls = 0.f;
#pragma unroll
        for (int r = 0; r < 16; ++r) {
          float pa, pb;
          if (MODE == 1) { pa = __builtin_amdgcn_exp2f(fmaf(s0[r], C2, -mn)); pb = __builtin_amdgcn_exp2f(fmaf(s1[r], C2, -mn)); }
          else { pa = __builtin_amdgcn_exp2f(s0[r] - mn); pb = __builtin_amdgcn_exp2f(s1[r] - mn); }
          if (MODE == 0) { pa *= cw0[r]; pb *= cw1[r]; }
          s0[r] = pa; s1[r] = pb; ls += pa + pb;
        }
        l[nq] += ls;
#pragma unroll
        for (int ks = 0; ks < 4; ++ks) {
          uint4 t4;
          const int rb = 8 * (ks & 1);
          if (ks < 2) { t4.x = pack2(s0[rb], s0[rb + 1]); t4.y = pack2(s0[rb + 2], s0[rb + 3]); t4.z = pack2(s0[rb + 4], s0[rb + 5]); t4.w = pack2(s0[rb + 6], s0[rb + 7]); }
          else { t4.x = pack2(s1[rb], s1[rb + 1]); t4.y = pack2(s1[rb + 2], s1[rb + 3]); t4.z = pack2(s1[rb + 4], s1[rb + 5]); t4.w = pack2(s1[rb + 6], s1[rb + 7]); }
          pf[nq][ks] = __builtin_bit_cast(bf16x8, t4);
        }
      }
      const char* vb_ = lds + buf * 8192 + vfo;
#pragma unroll
      for (int ks = 0; ks < 4; ++ks) {
        const s16x4 a0 = vtr(vb_ + ks * 1024), a1 = vtr(vb_ + ks * 1024 + 512);
        const s16x4 b0 = vtr(vb_ + 4096 + ks * 1024), b1 = vtr(vb_ + 4096 + ks * 1024 + 512);
        const bf16x8 v0 = __builtin_shufflevector(a0, a1, 0, 1, 2, 3, 4, 5, 6, 7);
        const bf16x8 v1 = __builtin_shufflevector(b0, b1, 0, 1, 2, 3, 4, 5, 6, 7);
#pragma unroll
        for (int nq = 0; nq < NQ; ++nq) { o[nq][0] = MFMA32(v0, pf[nq][ks], o[nq][0]); o[nq][1] = MFMA32(v1, pf[nq][ks], o[nq][1]); }
      }
    }
    if (kt + 1 < kt1) { char* wb = lds + (buf ^ 1) * 8192; *(uint4*)(wb + kw) = rk0; *(uint4*)(wb + vw) = rv0; }
    __syncthreads();
  }
#pragma unroll
  for (int nq = 0; nq < NQ; ++nq) {
    float lt = l[nq] + __shfl_xor(l[nq], 32);
    if (MODE == 2) lt += __builtin_amdgcn_exp2f(sink2 - m2[nq]);
    const float inv = 1.f / lt;
    bf16_t* op = cat + (size_t)(seq_base + q0w + 32 * nq + r32) * DM + ooff + 4 * hh;
#pragma unroll
    for (int g = 0; g < 4; ++g) {
      uint2 a, b;
      a.x = pack2(o[nq][0][4 * g] * inv, o[nq][0][4 * g + 1] * inv); a.y = pack2(o[nq][0][4 * g + 2] * inv, o[nq][0][4 * g + 3] * inv);
      b.x = pack2(o[nq][1][4 * g] * inv, o[nq][1][4 * g + 1] * inv); b.y = pack2(o[nq][1][4 * g + 2] * inv, o[nq][1][4 * g + 3] * inv);
      *(uint2*)(op + 8 * g) = a; *(uint2*)(op + 32 + 8 * g) = b;
    }
  }
}

DI void attn_phase_l0(const Params& p, char* lds) {
  OPAQUE_TID(tid0);
  const int wave = tid0 >> 6;
  for (int u = blockIdx.x; u < 1536; u += gridDim.x) {
    if (u < 512) {
      int seq_base, T, kvh, qt;
      if (u < 256) { seq_base = 0; T = PROMPT_T; kvh = u >> 7; qt = u & 127; }
      else { const int v = u - 256; seq_base = PROMPT_T + (v >> 6) * SAMPLE_T; T = SAMPLE_T; kvh = (v >> 5) & 1; qt = v & 31; }
      const int head = kvh * 4 + (wave & 3);
      attn_unit<1, 2>(p.big, 2304, seq_base, 0, T >> 6, 2048 + kvh * 64, 2176 + kvh * 64, qt * 128 + (wave >> 2) * 64, 1536 + head * 64, 512 + head * 64, 0.f, 0.f, p.xn, lds);
    } else {
      const int v = u - 512, head = v >> 7, tok0 = (v & 127) * 256;
      const int seq_base = (tok0 < PROMPT_T) ? 0 : (PROMPT_T + ((tok0 - PROMPT_T) / SAMPLE_T) * SAMPLE_T);
      const int T = (tok0 < PROMPT_T) ? PROMPT_T : SAMPLE_T;
      const int q0b = tok0 - seq_base;
      int kt0 = (q0b - 1024) >> 6; if (kt0 < 0) kt0 = 0;
      int kt1 = ((q0b + 255 + 1024) >> 6) + 1; if (kt1 > (T >> 6)) kt1 = T >> 6;
      attn_unit<0, 1>(p.big, 2304, seq_base, kt0, kt1, 512 + head * 64, 1024 + head * 64, q0b + wave * 32, head * 64, head * 64,
                   exp2f(-(float)(head + 1)) * LOG2E, 0.f, p.xn, lds);
    }
  }
}

DI void attn_phase_l1(const Params& p, char* lds) {
  OPAQUE_TID(tid0);
  const int wave = tid0 >> 6;
  for (int u = blockIdx.x; u < 2048; u += gridDim.x) {
    const int kvh = u >> 9, tok0 = (u & 511) * 64;
    const int seq_base = (tok0 < PROMPT_T) ? 0 : (PROMPT_T + ((tok0 - PROMPT_T) / SAMPLE_T) * SAMPLE_T);
    const int T = (tok0 < PROMPT_T) ? PROMPT_T : SAMPLE_T;
    const int q0 = tok0 - seq_base, head = kvh * 4 + (wave & 3);
    int kt0 = (q0 - 128) >> 6; if (kt0 < 0) kt0 = 0;
    int kt1 = ((q0 + 63 + 128) >> 6) + 1; if (kt1 > (T >> 6)) kt1 = T >> 6;
    attn_unit<2, 1>(p.big, 1536, seq_base, kt0, kt1, 1024 + kvh * 64, 1280 + kvh * 64, q0 + (wave >> 2) * 32, head * 64, head * 64,
                 exp2f(-0.5f * (float)(head + 1)) * LOG2E, p.c_sink[head] * LOG2E, p.xn, lds);
  }
}

#define XB_TMO      128
#define XB_XCNT(j)  (256  + 64 * (j))
#define XB_XSUB(j)  (1280 + 64 * (j))
#define XB_XGEN(j)  (2304 + 64 * (j))
#define XB_TOP      3328
#define XB_TOPGEN   3392
#define XCD_BAR_WORDS 3456
#define XB_SPIN_CAP (1u << 22)
DI unsigned xb_ld(unsigned* p) { return __hip_atomic_load(p, __ATOMIC_RELAXED, __HIP_MEMORY_SCOPE_AGENT); }
DI unsigned xb_add(unsigned* p, unsigned v) { return __hip_atomic_fetch_add(p, v, __ATOMIC_RELAXED, __HIP_MEMORY_SCOPE_AGENT); }
DI unsigned xb_xcc_id() { return (unsigned)__builtin_amdgcn_s_getreg((3 << 11) | 20) & 0xFu; }
#define XB_SPIN(cond, bar) do { unsigned _sp = 0; while (cond) { __builtin_amdgcn_s_sleep(1); \
    if ((++_sp & 255u) == 0u) { if (xb_ld(&(bar)[XB_TMO])) break; if (_sp > XB_SPIN_CAP) { atomicAdd(&(bar)[XB_TMO], 1u); break; } } } } while (0)
struct XcdBarrier { unsigned* bar; unsigned x; volatile unsigned* st; };
DI void xcd_barrier_complete(unsigned* bar, unsigned x, unsigned& nloc, unsigned& nx) {
  const unsigned G = gridDim.x;
  unsigned sum, cnt, mine, sp = 0u;
  for (;;) {
    sum = 0u; cnt = 0u; mine = 0u;
#pragma unroll
    for (unsigned j = 0; j < 16; ++j) { const unsigned c = xb_ld(&bar[XB_XCNT(j)]); sum += c; cnt += (c > 0u) ? 1u : 0u; mine = (j == x) ? c : mine; }
    if (sum == G) break;
    __builtin_amdgcn_s_sleep(1);
    if ((++sp & 255u) == 0u) { if (xb_ld(&bar[XB_TMO])) break; if (sp > XB_SPIN_CAP) { atomicAdd(&bar[XB_TMO], 1u); break; } }
  }
  nloc = mine > 0u ? mine : 1u; nx = cnt > 0u ? cnt : 1u;
}
DI void xcd_barrier(const XcdBarrier& b) {
  asm volatile("s_waitcnt vmcnt(0)" ::: "memory");
  __syncthreads();
  if (threadIdx.x == 0) {
    unsigned* bar = b.bar;
    __builtin_amdgcn_s_waitcnt(0);
    unsigned nloc = b.st[0], nx = b.st[1];
    if (nloc == 0u) { xcd_barrier_complete(bar, b.x, nloc, nx); b.st[0] = nloc; b.st[1] = nx; }
    const unsigned old = xb_add(&bar[XB_XSUB(b.x)], 1u);
    const unsigned gen = old / nloc;
    if (old + 1u == (gen + 1u) * nloc) {
      __builtin_amdgcn_fence(__ATOMIC_RELEASE, "agent");
      asm volatile("s_waitcnt vmcnt(0)" ::: "memory");
      const unsigned og = xb_add(&bar[XB_TOP], 1u);
      const unsigned tg = og / nx;
      if (og + 1u == (tg + 1u) * nx) xb_add(&bar[XB_TOPGEN], 1u);
      else XB_SPIN(xb_ld(&bar[XB_TOPGEN]) == tg, bar);
      __builtin_amdgcn_fence(__ATOMIC_ACQUIRE, "agent");
      xb_add(&bar[XB_XGEN(b.x)], 1u);
      asm volatile("s_waitcnt vmcnt(0)" ::: "memory");
    } else {
      XB_SPIN(xb_ld(&bar[XB_XGEN(b.x)]) == gen, bar);
      __builtin_amdgcn_fence(__ATOMIC_ACQUIRE, "agent");
      asm volatile("s_waitcnt vmcnt(0)" ::: "memory");
    }
  }
  __syncthreads();
}

__global__ void __launch_bounds__(512) fwd_megakernel(Params p) {
  cg::grid_group grid = cg::this_grid();
  __shared__ __attribute__((aligned(1024))) char lds[2 * STAGE_B + 16];
  volatile unsigned* bst = (volatile unsigned*)(lds + 2 * STAGE_B);
  if (threadIdx.x < 2) bst[threadIdx.x] = 0u;
  __syncthreads();
  XcdBarrier xb; xb.bar = p.bar; xb.x = xb_xcc_id(); xb.st = bst;
  if (threadIdx.x == 0) (void)xb_add(&p.bar[XB_XCNT(xb.x)], 1u);
  convert_phase(p, 0, (float*)lds);
  norm_phase(p, 0, p.norm_g);
  grid.sync();
  for (int layer = 0; layer < 2; ++layer) {
    for (int f = 0; f < 2; ++f) {
      if (f == 1) {
        if (layer == 0) gemm_phase<EPI_BF16, DM, 2304>(p.xn, p.wts + W_IN, NTOK, p.big, 0.f, lds);
        else gemm_phase<EPI_BF16, DM, 1536>(p.xn, p.wts + W_IN, NTOK, p.big, 0.f, lds);
        xcd_barrier(xb);
        if (layer == 0) {
          bprep_phase(p);
          xcd_barrier(xb);
          attn_phase_l0(p, lds);
        } else {
          attn_phase_l1(p, lds);
        }
        xcd_barrier(xb);
        gemm_phase<EPI_RESID, DM, DM>(p.xn, p.wts + W_OUT, NTOK, p.h, 1.0f, lds);
        xcd_barrier(xb);
        norm_phase(p, 1, p.norm_g + (layer * 3 + 2) * DM);
        xcd_barrier(xb);
      }
      const int rows = NTOK / p.ffn_chunks;
      for (int c = 0; c < p.ffn_chunks; ++c) {
        gemm_phase<EPI_UP, DM, 2 * DFF>(p.xn + (size_t)c * rows * DM, p.wts + (f ? W_UPB : W_UPA), rows, p.big, 0.f, lds);
        xcd_barrier(xb);
        gemm_phase<EPI_RESID, DFF, DM>(p.big, p.wts + (f ? W_DNB : W_DNA), rows, p.h + (size_t)c * rows * DM, 0.5f, lds);
        xcd_barrier(xb);
      }
      if (f == 0) { norm_phase(p, 1, p.norm_g + (layer * 3 + 1) * DM); xcd_barrier(xb); }
    }
    if (layer == 0) { convert_phase(p, 1, (float*)lds); norm_phase(p, 1, p.norm_g + 3 * DM); xcd_barrier(xb); }
  }
  norm_phase(p, 2, p.final_g);
}

extern "C" void kernel_launch(void* const* d_in, const int* in_sizes, int n_in, void* d_out, int out_size, void* d_ws, size_t ws_size, hipStream_t stream) {
  static int grid_blocks = 0;
  if (!grid_blocks) {
    int dev = 0, cus = 0, per_cu = 0;
    hipGetDevice(&dev);
    hipDeviceGetAttribute(&cus, hipDeviceAttributeMultiprocessorCount, dev);
    hipOccupancyMaxActiveBlocksPerMultiprocessor(&per_cu, fwd_megakernel, 512, 0);
    if (per_cu > 1) per_cu = 1;
    if (per_cu < 1) per_cu = 1;
    grid_blocks = cus * per_cu;
  }
  Params p{};
  p.x_prompt = (const float*)d_in[0]; p.x_sample = (const float*)d_in[1]; p.norm_g = (const float*)d_in[2];
  p.w1 = (const float*)d_in[3]; p.w3 = (const float*)d_in[4]; p.w2 = (const float*)d_in[5];
  p.ab_w_in = (const float*)d_in[6]; p.ab_w_out = (const float*)d_in[7]; p.ab_qg = (const float*)d_in[8]; p.ab_kg = (const float*)d_in[9];
  p.c_w_in = (const float*)d_in[10]; p.c_w_out = (const float*)d_in[11]; p.c_sink = (const float*)d_in[12]; p.final_g = (const float*)d_in[13];
  p.h = (float*)d_out;
  char* ws = (char*)d_ws;
  const size_t MiB = 1024 * 1024;
  p.wts = (bf16_t*)ws;
  p.xn = (bf16_t*)(ws + 40 * MiB);
  p.big = (bf16_t*)(ws + 104 * MiB);
  p.bar = (unsigned*)(ws + 280 * MiB);
  p.ffn_chunks = (ws_size >= 280 * MiB + 65536) ? 1 : 2;
  if (p.ffn_chunks == 2) p.bar = (unsigned*)(ws + 250 * MiB);
  hipMemsetAsync(p.bar, 0, XCD_BAR_WORDS * sizeof(unsigned), stream);
  p.pad = 0;
  void* args[] = {&p};
  hipError_t e = hipLaunchCooperativeKernel((void*)fwd_megakernel, dim3(grid_blocks), dim3(512), args, 0, stream);
  if (e != hipSuccess) fprintf(stderr, "cooperative launch failed: %s (grid %d)\n", hipGetErrorString(e), grid_blocks);
}
```

```cpp
#include <hip/hip_runtime.h>
#include <hip/hip_cooperative_groups.h>
#include <cstdio>
namespace cg = cooperative_groups;

typedef unsigned short bf16_t;
typedef short bf16x8 __attribute__((ext_vector_type(8)));
typedef float f32x16 __attribute__((ext_vector_type(16)));
#define DI __device__ __forceinline__
#define OPAQUE_TID(v) int v = threadIdx.x; asm volatile("" : "+v"(v))
#define MFMA32(a, b, c) __builtin_amdgcn_mfma_f32_32x32x16_bf16((a), (b), (c), 0, 0, 0)

constexpr int NTOK = 32768, DM = 1024, DFF = 2816;
constexpr int PROMPT_T = 16384, SAMPLE_T = 4096;
constexpr float EPS = 1e-6f;
constexpr float LOG2E = 1.4426950408889634f;

constexpr size_t W_UPA = 0, W_DNA = 5767168, W_UPB = 8650752, W_DNB = 14417920, W_IN = 17301504, W_OUT = 19660800, W_TOTAL = 20709376;

struct Params {
  const float* x_prompt; const float* x_sample; const float* norm_g; const float* w1; const float* w3; const float* w2;
  const float* ab_w_in; const float* ab_w_out; const float* ab_qg; const float* ab_kg;
  const float* c_w_in; const float* c_w_out; const float* c_sink; const float* final_g;
  float* h; bf16_t* wts; bf16_t* xn; bf16_t* big; unsigned* bar;
  int ffn_chunks; int pad;
};

DI bf16_t f2bf(float x) { unsigned u = __float_as_uint(x); u += 0x7fffu + ((u >> 16) & 1u); return (bf16_t)(u >> 16); }
DI float bf2f(bf16_t v) { return __uint_as_float(((unsigned)v) << 16); }
DI float bflo(unsigned u) { return __uint_as_float(u << 16); }
DI float bfhi(unsigned u) { return __uint_as_float(u & 0xffff0000u); }
typedef __bf16 bf16x2_t __attribute__((ext_vector_type(2)));
typedef float f32x2_t __attribute__((ext_vector_type(2)));
DI unsigned pack2(float lo, float hi) { f32x2_t v = {lo, hi}; return __builtin_bit_cast(unsigned, __builtin_convertvector(v, bf16x2_t)); }
DI int crow(int reg, int h) { return (reg & 3) + 8 * (reg >> 2) + 4 * h; }

DI void convert_tile(const float* __restrict__ src, int K, int N, int kt, int nt, bf16_t* __restrict__ dst, int mode, float* lds) {
  OPAQUE_TID(tid);
#pragma unroll 4
  for (int i = 0; i < 8; ++i) { int e = tid + 512 * i; int kk = e >> 6, nn = e & 63; lds[kk * 65 + nn] = src[(size_t)(kt * 64 + kk) * N + nt * 64 + nn]; }
  __syncthreads();
  { const int nn = tid >> 3, kc = tid & 7, n = nt * 64 + nn;
    const int drow = (mode == 0) ? n : ((n >> 5) * 64 + (n & 31) + (mode == 2 ? 32 : 0));
    const float* lp = lds + kc * 8 * 65 + nn;
    uint4 v; v.x = pack2(lp[0], lp[65]); v.y = pack2(lp[130], lp[195]); v.z = pack2(lp[260], lp[325]); v.w = pack2(lp[390], lp[455]);
    *(uint4*)(dst + (size_t)drow * K + kt * 64 + kc * 8) = v; }
  __syncthreads();
}

DI void convert_phase(const Params& p, int layer, float* lds) {
  const int n_in = (layer == 0) ? 2304 : 1536;
  const int t_up = 16 * 44, t_dn = 44 * 16, t_in = 16 * (n_in / 64), t_out = 16 * 16;
  const int total = 4 * t_up + 2 * t_dn + t_in + t_out;
  for (int u = blockIdx.x; u < total; u += gridDim.x) {
    int r = u; const float* src; bf16_t* dst; int K, N, mode;
    if (r < 6 * t_up) {
      int mtx = r / t_up; r -= mtx * t_up; int f = mtx / 3, which = mtx % 3;
      size_t base = (size_t)(layer * 2 + f) * DM * DFF;
      if (which == 0) { src = p.w1 + base; K = DM; N = DFF; mode = 1; dst = p.wts + (f ? W_UPB : W_UPA); }
      else if (which == 1) { src = p.w3 + base; K = DM; N = DFF; mode = 2; dst = p.wts + (f ? W_UPB : W_UPA); }
      else { src = p.w2 + base; K = DFF; N = DM; mode = 0; dst = p.wts + (f ? W_DNB : W_DNA); }
    } else if (r < 6 * t_up + t_in) {
      r -= 6 * t_up; src = (layer == 0) ? p.ab_w_in : p.c_w_in; K = DM; N = n_in; mode = 0; dst = p.wts + W_IN;
    } else {
      r -= 6 * t_up + t_in; src = (layer == 0) ? p.ab_w_out : p.c_w_out; K = DM; N = DM; mode = 0; dst = p.wts + W_OUT;
    }
    const int ntn = N / 64; const int kt = r / ntn, nt = r % ntn;
    convert_tile(src, K, N, kt, nt, dst, mode, lds);
  }
}

DI void norm_phase(const Params& p, int mode, const float* __restrict__ g) {
  OPAQUE_TID(tid);
  const int lane = tid & 63, wave = tid >> 6;
  float4 gv[4];
#pragma unroll
  for (int i = 0; i < 4; ++i) gv[i] = *(const float4*)(g + lane * 4 + 256 * i);
  for (int row = blockIdx.x * 8 + wave; row < NTOK; row += gridDim.x * 8) {
    const float* src = (mode == 0) ? ((row < PROMPT_T) ? p.x_prompt + (size_t)row * DM : p.x_sample + (size_t)(row - PROMPT_T) * DM) : p.h + (size_t)row * DM;
    float4 v[4]; float ss = 0.f;
#pragma unroll
    for (int i = 0; i < 4; ++i) { v[i] = *(const float4*)(src + lane * 4 + 256 * i); ss += v[i].x * v[i].x + v[i].y * v[i].y + v[i].z * v[i].z + v[i].w * v[i].w; }
#pragma unroll
    for (int o = 32; o > 0; o >>= 1) ss += __shfl_xor(ss, o);
    const float r = rsqrtf(ss * (1.0f / DM) + EPS);
#pragma unroll
    for (int i = 0; i < 4; ++i) {
      float4 y; y.x = v[i].x * r * gv[i].x; y.y = v[i].y * r * gv[i].y; y.z = v[i].z * r * gv[i].z; y.w = v[i].w * r * gv[i].w;
      if (mode == 0) *(float4*)(p.h + (size_t)row * DM + lane * 4 + 256 * i) = v[i];
      if (mode == 2) *(float4*)(p.h + (size_t)row * DM + lane * 4 + 256 * i) = y;
      else { uint2 o2; o2.x = pack2(y.x, y.y); o2.y = pack2(y.z, y.w); *(uint2*)(p.xn + (size_t)row * DM + lane * 4 + 256 * i) = o2; }
    }
  }
}

typedef float f32x4 __attribute__((ext_vector_type(4)));
constexpr int EPI_UP = 0, EPI_RESID = 1, EPI_BF16 = 2;
constexpr int TILE_B = 256 * 64 * 2, STAGE_B = 2 * TILE_B;
#define WAIT_V0() asm volatile("s_waitcnt vmcnt(0)" ::: "memory")
DI int lds_byte(int r, int c) { const int st = (r >> 4) * 2 + (c >> 5), ob = (r & 15) * 64 + (c & 31) * 2; return st * 1024 + (ob ^ (((ob >> 9) & 1) << 5)); }
DI void stage_rc(int b, int& R, int& C) { const int st = b >> 10, sb = b & 1023, swz = sb ^ (((sb >> 9) & 1) << 5); R = (st >> 1) * 16 + (swz >> 6); C = (st & 1) * 32 + ((swz & 63) >> 1); }

template <int EPI, int K, int N>
DI void gemm_phase(const bf16_t* __restrict__ A, const bf16_t* __restrict__ Bt, int M, void* outp, float coef, char* shm) {
  constexpr int lda = K, ldc = (EPI == EPI_UP) ? N / 2 : N;
  OPAQUE_TID(tid);
  const int wid = tid >> 6, lane = tid & 63, wr = wid >> 2, wc = wid & 3, fr = lane & 15, fq = lane >> 4;
  int sR0, sC0; stage_rc(wid * 1024 + lane * 16, sR0, sC0);
  const int soff = sR0 * K + sC0;
  const int nM = M / 256, nwg = nM * (N / 256);
  constexpr int nN = N / 256, nt = K / 64;
#define TILE_MAP(wg_, pm_, pn_) do { int w_ = (wg_); { const int q = nwg / 8, r = nwg % 8, xcd = w_ % 8, off = w_ / 8; w_ = (xcd < r ? xcd * (q + 1) : r * (q + 1) + (xcd - r) * q) + off; } \
    const int nig = 8 * nN, gid = w_ / nig, fm = gid * 8, gsz = (nM - fm) < 8 ? (nM - fm) : 8; pm_ = fm + ((w_ % nig) % gsz); pn_ = (w_ % nig) / gsz; } while (0)
#define GLDS_STAGE(buf, kt) do { _Pragma("unroll") for (int i = 0; i < 4; ++i) { \
      __builtin_amdgcn_global_load_lds((const unsigned*)(Ab + soff + i * 64 * K + (kt) * 64), (unsigned*)(shm + (buf) * STAGE_B + wid * 1024 + i * 8192), 16, 0, 0); \
      __builtin_amdgcn_global_load_lds((const unsigned*)(Bb + soff + i * 64 * K + (kt) * 64), (unsigned*)(shm + (buf) * STAGE_B + TILE_B + wid * 1024 + i * 8192), 16, 0, 0); } } while (0)
  int pm = 0, pn = 0;
  const bf16_t* Ab = A; const bf16_t* Bb = Bt;
  if ((int)blockIdx.x < nwg) { TILE_MAP(blockIdx.x, pm, pn); Ab = A + (size_t)pm * 256 * lda; Bb = Bt + (size_t)pn * 256 * K; GLDS_STAGE(0, 0); }
  for (int it = 0;; ++it) {
    const int wg0 = it * gridDim.x + blockIdx.x;
    if (wg0 >= nwg) break;
    const int brow = pm * 256, bcol = pn * 256, pn_cur = pn;
    f32x4 acc[4][8];
    if (EPI == EPI_RESID) {
      const float ic = 1.f / coef;
#pragma unroll
      for (int m = 0; m < 8; ++m)
#pragma unroll
        for (int n = 0; n < 4; ++n) {
          const float4 v = *(const float4*)((const float*)outp + (size_t)(brow + wr * 128 + m * 16 + fr) * ldc + bcol + wc * 64 + n * 16 + 4 * fq);
          acc[n][m] = f32x4{v.x * ic, v.y * ic, v.z * ic, v.w * ic};
        }
    } else {
#pragma unroll
      for (int n = 0; n < 4; ++n)
#pragma unroll
        for (int m = 0; m < 8; ++m) acc[n][m] = f32x4{0.f, 0.f, 0.f, 0.f};
    }
    WAIT_V0(); __syncthreads();
    for (int t = 0; t < nt; ++t) {
      const int cur = t & 1;
      if (t + 1 < nt) GLDS_STAGE(cur ^ 1, t + 1);
      const char* sa = shm + cur * STAGE_B; const char* sb = sa + TILE_B;
#pragma unroll
      for (int ks = 0; ks < 2; ++ks) {
        bf16x8 At[8], Bf[4];
#pragma unroll
        for (int m = 0; m < 8; ++m) At[m] = *(const bf16x8*)(sa + lds_byte(wr * 128 + m * 16 + fr, ks * 32 + fq * 8));
#pragma unroll
        for (int n = 0; n < 4; ++n) Bf[n] = *(const bf16x8*)(sb + lds_byte(wc * 64 + n * 16 + fr, ks * 32 + fq * 8));
#pragma unroll
        for (int m = 0; m < 8; ++m)
#pragma unroll
          for (int n = 0; n < 4; ++n) acc[n][m] = __builtin_amdgcn_mfma_f32_16x16x32_bf16(Bf[n], At[m], acc[n][m], 0, 0, 0);
        __builtin_amdgcn_sched_barrier(0);
      }
      WAIT_V0(); __syncthreads();
    }
    { const int wg1 = wg0 + gridDim.x;
      if (wg1 < nwg) { TILE_MAP(wg1, pm, pn); Ab = A + (size_t)pm * 256 * lda; Bb = Bt + (size_t)pn * 256 * K; GLDS_STAGE(0, 0); } }
#pragma unroll
    for (int m = 0; m < 8; ++m) {
      const int row = brow + wr * 128 + m * 16 + fr;
      if (EPI == EPI_UP) {
#pragma unroll
        for (int n = 0; n < 2; ++n) {
          float a[4];
#pragma unroll
          for (int j = 0; j < 4; ++j) { const float u1 = acc[n][m][j], u3 = acc[n + 2][m][j]; a[j] = u1 * u3 * __builtin_amdgcn_rcpf(1.f + __builtin_amdgcn_exp2f(-LOG2E * u1)); }
          uint2 o2; o2.x = pack2(a[0], a[1]); o2.y = pack2(a[2], a[3]);
          *(uint2*)((bf16_t*)outp + (size_t)row * ldc + pn_cur * 128 + wc * 32 + n * 16 + 4 * fq) = o2;
        }
      } else {
#pragma unroll
        for (int n = 0; n < 4; ++n) {
          const int col = bcol + wc * 64 + n * 16 + 4 * fq;
          if (EPI == EPI_RESID) {
            float4 v; v.x = coef * acc[n][m][0]; v.y = coef * acc[n][m][1]; v.z = coef * acc[n][m][2]; v.w = coef * acc[n][m][3];
            *(float4*)((float*)outp + (size_t)row * ldc + col) = v;
          } else {
            uint2 o2; o2.x = pack2(acc[n][m][0], acc[n][m][1]); o2.y = pack2(acc[n][m][2], acc[n][m][3]);
            *(uint2*)((bf16_t*)outp + (size_t)row * ldc + col) = o2;
          }
        }
      }
      __builtin_amdgcn_sched_barrier(0);
    }
  }
#undef GLDS_STAGE
#undef TILE_MAP
}

DI void bprep_phase(const Params& p) {
  OPAQUE_TID(tid);
  const int pi = tid & 31, tl = tid >> 5;
  const float fr = exp2f(-(float)((pi & 15) * 2) * (1.0f / 32.0f) * 13.287712379549449f);
  const float qg0 = p.ab_qg[2 * pi], qg1 = p.ab_qg[2 * pi + 1], kg0 = p.ab_kg[2 * pi], kg1 = p.ab_kg[2 * pi + 1];
  for (int t = blockIdx.x * 16 + tl; t < NTOK; t += gridDim.x * 16) {
    const int pos = (t < PROMPT_T) ? t : ((t - PROMPT_T) & (SAMPLE_T - 1));
    const float ang = (float)((pi < 16) ? (pos >> 6) : (pos & 63)) * fr;
    const float cs = __cosf(ang), sn = __sinf(ang);
    unsigned* rowp = (unsigned*)(p.big + (size_t)t * 2304);
#pragma unroll
    for (int hd = 0; hd < 10; ++hd) {
      const int col = (hd < 8) ? (1536 + hd * 64) : (2048 + (hd - 8) * 64);
      unsigned u = rowp[(col >> 1) + pi];
      float x1 = bflo(u), x2 = bfhi(u);
      float ss = x1 * x1 + x2 * x2;
#pragma unroll
      for (int o = 16; o > 0; o >>= 1) ss += __shfl_xor(ss, o);
      const float r = rsqrtf(ss * (1.0f / 64.0f) + EPS);
      x1 = x1 * r * ((hd < 8) ? qg0 : kg0); x2 = x2 * r * ((hd < 8) ? qg1 : kg1);
      rowp[(col >> 1) + pi] = pack2(x1 * cs - x2 * sn, x1 * sn + x2 * cs);
    }
  }
}

template <int MODE>
DI void naive_attn(const Params& p, const bf16_t* __restrict__ proj, int ld, int qoff, int koff, int voff, int nqh, int G, bf16_t* cat, int cat_off) {
  const int total = NTOK * nqh;
  for (int idx = blockIdx.x * 256 + threadIdx.x; idx < total; idx += gridDim.x * 256) {
    const int head = idx / NTOK, t = idx % NTOK, hk = head / G;
    const int seq_base = (t < PROMPT_T) ? 0 : (PROMPT_T + ((t - PROMPT_T) / SAMPLE_T) * SAMPLE_T);
    const int T = (t < PROMPT_T) ? PROMPT_T : SAMPLE_T;
    const int pos = t - seq_base;
    float q[64], o[64];
    { const uint4* qp = (const uint4*)(proj + (size_t)t * ld + qoff + head * 64);
#pragma unroll
      for (int c = 0; c < 8; ++c) { uint4 v = qp[c]; q[8*c] = bflo(v.x); q[8*c+1] = bfhi(v.x); q[8*c+2] = bflo(v.y); q[8*c+3] = bfhi(v.y); q[8*c+4] = bflo(v.z); q[8*c+5] = bfhi(v.z); q[8*c+6] = bflo(v.w); q[8*c+7] = bfhi(v.w); } }
#pragma unroll
    for (int d = 0; d < 64; ++d) o[d] = 0.f;
    float m = -1e30f, l = 0.f, slope = 0.f;
    if (MODE == 0) slope = exp2f(-(float)(head + 1));
    if (MODE == 2) { slope = exp2f(-0.5f * (float)(head + 1)); m = p.c_sink[head]; l = 1.f; }
    const int nkeys = (MODE == 0) ? 387 : (MODE == 1 ? T : 257);
    for (int j = 0; j < nkeys; ++j) {
      int off;
      if (MODE == 0) { const int br = j / 129, jj = j % 129 - 64; off = jj * (br == 0 ? 1 : (br == 1 ? 4 : 16)); }
      else if (MODE == 1) off = j - pos;
      else off = j - 128;
      const int kp = pos + off;
      if (kp < 0 || kp >= T) continue;
      const uint4* kptr = (const uint4*)(proj + (size_t)(seq_base + kp) * ld + koff + hk * 64);
      float s = 0.f;
#pragma unroll
      for (int c = 0; c < 8; ++c) { uint4 v = kptr[c];
        s += q[8*c] * bflo(v.x) + q[8*c+1] * bfhi(v.x) + q[8*c+2] * bflo(v.y) + q[8*c+3] * bfhi(v.y) + q[8*c+4] * bflo(v.z) + q[8*c+5] * bfhi(v.z) + q[8*c+6] * bflo(v.w) + q[8*c+7] * bfhi(v.w); }
      s *= 0.125f;
      if (MODE != 1) s -= slope * fabsf((float)off);
      const float mn = fmaxf(m, s); const float al = __expf(m - mn), pw = __expf(s - mn);
      m = mn; l = l * al + pw;
      const uint4* vptr = (const uint4*)(proj + (size_t)(seq_base + kp) * ld + voff + hk * 64);
#pragma unroll
      for (int c = 0; c < 8; ++c) { uint4 v = vptr[c];
        o[8*c] = o[8*c] * al + pw * bflo(v.x); o[8*c+1] = o[8*c+1] * al + pw * bfhi(v.x); o[8*c+2] = o[8*c+2] * al + pw * bflo(v.y); o[8*c+3] = o[8*c+3] * al + pw * bfhi(v.y);
        o[8*c+4] = o[8*c+4] * al + pw * bflo(v.z); o[8*c+5] = o[8*c+5] * al + pw * bfhi(v.z); o[8*c+6] = o[8*c+6] * al + pw * bflo(v.w); o[8*c+7] = o[8*c+7] * al + pw * bfhi(v.w); }
    }
    const float inv = 1.f / l;
    uint4* op = (uint4*)(cat + (size_t)t * DM + cat_off + head * 64);
#pragma unroll
    for (int c = 0; c < 8; ++c) { uint4 v; v.x = pack2(o[8*c] * inv, o[8*c+1] * inv); v.y = pack2(o[8*c+2] * inv, o[8*c+3] * inv); v.z = pack2(o[8*c+4] * inv, o[8*c+5] * inv); v.w = pack2(o[8*c+6] * inv, o[8*c+7] * inv); op[c] = v; }
  }
}

typedef short s16x4 __attribute__((ext_vector_type(4)));
typedef __attribute__((address_space(3))) s16x4* lds_s16x4_ptr;
DI s16x4 vtr(const char* p) { return __builtin_amdgcn_ds_read_tr16_b64_v4i16((lds_s16x4_ptr)p); }

template <int MODE, int NQ>
DI void attn_unit(const bf16_t* __restrict__ proj, int ld, int seq_base, int kt0, int kt1, int koff, int voff,
                  int q0w, int qoff, int ooff, float slope2, float sink2, bf16_t* __restrict__ cat, char* lds) {
  OPAQUE_TID(tid);
  const int lane = tid & 63, wave = tid >> 6, r32 = lane & 31, hh = lane >> 5;
  constexpr float C2 = 0.125f * LOG2E;
  bf16x8 qf[NQ][4];
#pragma unroll
  for (int nq = 0; nq < NQ; ++nq) { const bf16_t* qp = proj + (size_t)(seq_base + q0w + 32 * nq + r32) * ld + qoff + hh * 8;
#pragma unroll
    for (int ks = 0; ks < 4; ++ks) qf[nq][ks] = *(const bf16x8*)(qp + ks * 16); }
  f32x16 o[NQ][2];
  float m2[NQ], l[NQ];
#pragma unroll
  for (int nq = 0; nq < NQ; ++nq) { m2[nq] = (MODE == 2) ? sink2 : -1e30f; l[nq] = 0.f;
#pragma unroll
    for (int r = 0; r < 16; ++r) { o[nq][0][r] = 0.f; o[nq][1][r] = 0.f; } }
  const int skey = wave * 8 + (lane & 7), sc = lane >> 3;
  const bf16_t* kg = proj + (size_t)(seq_base + skey) * ld + koff + sc * 8;
  const bf16_t* vg = proj + (size_t)(seq_base + skey) * ld + voff + sc * 8;
  const int kw = sc * 1024 + skey * 16, vw = 16384 + (sc >> 2) * 4096 + skey * 64 + (sc & 3) * 16;
  uint4 rk0, rv0;
  { const size_t go = (size_t)kt0 * 64 * ld; rk0 = *(const uint4*)(kg + go); rv0 = *(const uint4*)(vg + go); }
  *(uint4*)(lds + kw) = rk0; *(uint4*)(lds + vw) = rv0;
  __syncthreads();
  const int kfo = hh * 1024 + r32 * 16;
  const int vfo = 16384 + (4 * hh + ((lane & 15) >> 2)) * 64 + ((lane >> 4) & 1) * 32 + (lane & 3) * 8;
  for (int kt = kt0; kt < kt1; ++kt) {
    const int buf = (kt - kt0) & 1;
    if (kt + 1 < kt1) { const size_t go = (size_t)(kt + 1) * 64 * ld; rk0 = *(const uint4*)(kg + go); rv0 = *(const uint4*)(vg + go); }
    bool active = true;
    if (MODE == 0) active = (kt * 64 + 63 >= q0w - 1024) && (kt * 64 <= q0w + 32 * NQ - 1 + 1024);
    const bool far = (MODE == 0) && ((kt * 64 > q0w + 32 * NQ - 1 + 256) || (kt * 64 + 63 < q0w - 256));
    if (active) {
      const char* kb_ = lds + buf * 8192 + kfo;
      f32x16 s[NQ][2];
#pragma unroll
      for (int nq = 0; nq < NQ; ++nq)
#pragma unroll
        for (int r = 0; r < 16; ++r) { s[nq][0][r] = 0.f; s[nq][1][r] = 0.f; }
#pragma unroll
      for (int ks = 0; ks < 4; ++ks) {
        const bf16x8 k0 = *(const bf16x8*)(kb_ + ks * 2048), k1 = *(const bf16x8*)(kb_ + ks * 2048 + 512);
#pragma unroll
        for (int nq = 0; nq < NQ; ++nq) { s[nq][0] = MFMA32(k0, qf[nq][ks], s[nq][0]); s[nq][1] = MFMA32(k1, qf[nq][ks], s[nq][1]); }
      }
      bf16x8 pf[NQ][4];
#pragma unroll
      for (int nq = 0; nq < NQ; ++nq) {
        f32x16& s0 = s[nq][0]; f32x16& s1 = s[nq][1];
        float mx = -1e30f;
        float cw0[(MODE == 0) ? 16 : 1], cw1[(MODE == 0) ? 16 : 1];
        if (MODE == 1) {
#pragma unroll
          for (int r = 0; r < 16; r += 2) mx = fmaxf(fmaxf(mx, fmaxf(s0[r], s0[r + 1])), fmaxf(s1[r], s1[r + 1]));
          mx *= C2;
        } else {
          const int d0 = kt * 64 + 4 * hh - (q0w + 32 * nq + r32);
#pragma unroll
          for (int r = 0; r < 16; ++r) {
            const int oa = d0 + (r & 3) + 8 * (r >> 2), ob = oa + 32;
            const int aa = oa < 0 ? -oa : oa, ab = ob < 0 ? -ob : ob;
            float va = fmaf(s0[r], C2, -slope2 * (float)aa), vb = fmaf(s1[r], C2, -slope2 * (float)ab);
            if (MODE == 0) {
              if (far) {
                va = ((oa & 15) == 0 && aa <= 1024) ? va : -1e30f; vb = ((oa & 15) == 0 && ab <= 1024) ? vb : -1e30f;
              } else {
                const int ca = (aa <= 64 ? 1 : 0) + (((oa & 3) == 0 && aa <= 256) ? 1 : 0) + (((oa & 15) == 0 && aa <= 1024) ? 1 : 0);
                const int cb = (ab <= 64 ? 1 : 0) + (((ob & 3) == 0 && ab <= 256) ? 1 : 0) + (((ob & 15) == 0 && ab <= 1024) ? 1 : 0);
                cw0[r] = (float)ca; cw1[r] = (float)cb;
                va = ca ? va : -1e30f; vb = cb ? vb : -1e30f;
              }
            } else {
              va = (aa <= 128) ? va : -1e30f; vb = (ab <= 128) ? vb : -1e30f;
            }
            s0[r] = va; s1[r] = vb; mx = fmaxf(mx, fmaxf(va, vb));
          }
        }
        mx = fmaxf(mx, __shfl_xor(mx, 32));
        const float mn = fmaxf(m2[nq], mx);
        if (__any(mn > m2[nq])) {
          const float alpha = __builtin_amdgcn_exp2f(m2[nq] - mn);
          l[nq] *= alpha;
#pragma unroll
          for (int r = 0; r < 16; ++r) { o[nq][0][r] *= alpha; o[nq][1][r] *= alpha; }
        }
        m2[nq] = mn;
        float ls = 0.f;
#pragma unroll
        for (int r = 0; r < 16; ++r) {
          float pa, pb;
          if (MODE == 1) { pa = __builtin_amdgcn_exp2f(fmaf(s0[r], C2, -mn)); pb = __builtin_amdgcn_exp2f(fmaf(s1[r], C2, -mn)); }
          else { pa = __builtin_amdgcn_exp2f(s0[r] - mn); pb = __builtin_amdgcn_exp2f(s1[r] - mn); }
          if (MODE == 0 && !far) { pa *= cw0[r]; pb *= cw1[r]; }
          s0[r] = pa; s1[r] = pb; ls += pa + pb;
        }
        l[nq] += ls;
#pragma unroll
        for (int ks = 0; ks < 4; ++ks) {
          uint4 t4;
          const int rb = 8 * (ks & 1);
          if (ks < 2) { t4.x = pack2(s0[rb], s0[rb + 1]); t4.y = pack2(s0[rb + 2], s0[rb + 3]); t4.z = pack2(s0[rb + 4], s0[rb + 5]); t4.w = pack2(s0[rb + 6], s0[rb + 7]); }
          else { t4.x = pack2(s1[rb], s1[rb + 1]); t4.y = pack2(s1[rb + 2], s1[rb + 3]); t4.z = pack2(s1[rb + 4], s1[rb + 5]); t4.w = pack2(s1[rb + 6], s1[rb + 7]); }
          pf[nq][ks] = __builtin_bit_cast(bf16x8, t4);
        }
      }
      const char* vb_ = lds + buf * 8192 + vfo;
#pragma unroll
      for (int ks = 0; ks < 4; ++ks) {
        const s16x4 a0 = vtr(vb_ + ks * 1024), a1 = vtr(vb_ + ks * 1024 + 512);
        const s16x4 b0 = vtr(vb_ + 4096 + ks * 1024), b1 = vtr(vb_ + 4096 + ks * 1024 + 512);
        const bf16x8 v0 = __builtin_shufflevector(a0, a1, 0, 1, 2, 3, 4, 5, 6, 7);
        const bf16x8 v1 = __builtin_shufflevector(b0, b1, 0, 1, 2, 3, 4, 5, 6, 7);
#pragma unroll
        for (int nq = 0; nq < NQ; ++nq) { o[nq][0] = MFMA32(v0, pf[nq][ks], o[nq][0]); o[nq][1] = MFMA32(v1, pf[nq][ks], o[nq][1]); }
      }
    }
    if (kt + 1 < kt1) { char* wb = lds + (buf ^ 1) * 8192; *(uint4*)(wb + kw) = rk0; *(uint4*)(wb + vw) = rv0; }
    __syncthreads();
  }
#pragma unroll
  for (int nq = 0; nq < NQ; ++nq) {
    float lt = l[nq] + __shfl_xor(l[nq], 32);
    if (MODE == 2) lt += __builtin_amdgcn_exp2f(sink2 - m2[nq]);
    const float inv = 1.f / lt;
    bf16_t* op = cat + (size_t)(seq_base + q0w + 32 * nq + r32) * DM + ooff + 4 * hh;
#pragma unroll
    for (int g = 0; g < 4; ++g) {
      uint2 a, b;
      a.x = pack2(o[nq][0][4 * g] * inv, o[nq][0][4 * g + 1] * inv); a.y = pack2(o[nq][0][4 * g + 2] * inv, o[nq][0][4 * g + 3] * inv);
      b.x = pack2(o[nq][1][4 * g] * inv, o[nq][1][4 * g + 1] * inv); b.y = pack2(o[nq][1][4 * g + 2] * inv, o[nq][1][4 * g + 3] * inv);
      *(uint2*)(op + 8 * g) = a; *(uint2*)(op + 32 + 8 * g) = b;
    }
  }
}

DI void attn_phase_l0(const Params& p, char* lds) {
  OPAQUE_TID(tid0);
  const int wave = tid0 >> 6;
  for (int u = blockIdx.x; u < 1536; u += gridDim.x) {
    if (u < 512) {
      int seq_base, T, kvh, qt;
      if (u < 256) { seq_base = 0; T = PROMPT_T; kvh = u >> 7; qt = u & 127; }
      else { const int v = u - 256; seq_base = PROMPT_T + (v >> 6) * SAMPLE_T; T = SAMPLE_T; kvh = (v >> 5) & 1; qt = v & 31; }
      const int head = kvh * 4 + (wave & 3);
      attn_unit<1, 2>(p.big, 2304, seq_base, 0, T >> 6, 2048 + kvh * 64, 2176 + kvh * 64, qt * 128 + (wave >> 2) * 64, 1536 + head * 64, 512 + head * 64, 0.f, 0.f, p.xn, lds);
    } else {
      const int v = u - 512, head = v >> 7, tok0 = (v & 127) * 256;
      const int seq_base = (tok0 < PROMPT_T) ? 0 : (PROMPT_T + ((tok0 - PROMPT_T) / SAMPLE_T) * SAMPLE_T);
      const int T = (tok0 < PROMPT_T) ? PROMPT_T : SAMPLE_T;
      const int q0b = tok0 - seq_base;
      int kt0 = (q0b - 1024) >> 6; if (kt0 < 0) kt0 = 0;
      int kt1 = ((q0b + 255 + 1024) >> 6) + 1; if (kt1 > (T >> 6)) kt1 = T >> 6;
      attn_unit<0, 1>(p.big, 2304, seq_base, kt0, kt1, 512 + head * 64, 1024 + head * 64, q0b + wave * 32, head * 64, head * 64,
                   exp2f(-(float)(head + 1)) * LOG2E, 0.f, p.xn, lds);
    }
  }
}

DI void attn_phase_l1(const Params& p, char* lds) {
  OPAQUE_TID(tid0);
  const int wave = tid0 >> 6;
  for (int u = blockIdx.x; u < 2048; u += gridDim.x) {
    const int kvh = u >> 9, tok0 = (u & 511) * 64;
    const int seq_base = (tok0 < PROMPT_T) ? 0 : (PROMPT_T + ((tok0 - PROMPT_T) / SAMPLE_T) * SAMPLE_T);
    const int T = (tok0 < PROMPT_T) ? PROMPT_T : SAMPLE_T;
    const int q0 = tok0 - seq_base, head = kvh * 4 + (wave & 3);
    int kt0 = (q0 - 128) >> 6; if (kt0 < 0) kt0 = 0;
    int kt1 = ((q0 + 63 + 128) >> 6) + 1; if (kt1 > (T >> 6)) kt1 = T >> 6;
    attn_unit<2, 1>(p.big, 1536, seq_base, kt0, kt1, 1024 + kvh * 64, 1280 + kvh * 64, q0 + (wave >> 2) * 32, head * 64, head * 64,
                 exp2f(-0.5f * (float)(head + 1)) * LOG2E, p.c_sink[head] * LOG2E, p.xn, lds);
  }
}

#define XB_TMO      128
#define XB_XCNT(j)  (256  + 64 * (j))
#define XB_XSUB(j)  (1280 + 64 * (j))
#define XB_XGEN(j)  (2304 + 64 * (j))
#define XB_TOP      3328
#define XB_TOPGEN   3392
#define XCD_BAR_WORDS 3456
#define XB_SPIN_CAP (1u << 22)
DI unsigned xb_ld(unsigned* p) { return __hip_atomic_load(p, __ATOMIC_RELAXED, __HIP_MEMORY_SCOPE_AGENT); }
DI unsigned xb_add(unsigned* p, unsigned v) { return __hip_atomic_fetch_add(p, v, __ATOMIC_RELAXED, __HIP_MEMORY_SCOPE_AGENT); }
DI unsigned xb_xcc_id() { return (unsigned)__builtin_amdgcn_s_getreg((3 << 11) | 20) & 0xFu; }
#define XB_SPIN(cond, bar) do { unsigned _sp = 0; while (cond) { __builtin_amdgcn_s_sleep(1); \
    if ((++_sp & 255u) == 0u) { if (xb_ld(&(bar)[XB_TMO])) break; if (_sp > XB_SPIN_CAP) { atomicAdd(&(bar)[XB_TMO], 1u); break; } } } } while (0)
struct XcdBarrier { unsigned* bar; unsigned x; volatile unsigned* st; };
DI void xcd_barrier_complete(unsigned* bar, unsigned x, unsigned& nloc, unsigned& nx) {
  const unsigned G = gridDim.x;
  unsigned sum, cnt, mine, sp = 0u;
  for (;;) {
    sum = 0u; cnt = 0u; mine = 0u;
#pragma unroll
    for (unsigned j = 0; j < 16; ++j) { const unsigned c = xb_ld(&bar[XB_XCNT(j)]); sum += c; cnt += (c > 0u) ? 1u : 0u; mine = (j == x) ? c : mine; }
    if (sum == G) break;
    __builtin_amdgcn_s_sleep(1);
    if ((++sp & 255u) == 0u) { if (xb_ld(&bar[XB_TMO])) break; if (sp > XB_SPIN_CAP) { atomicAdd(&bar[XB_TMO], 1u); break; } }
  }
  nloc = mine > 0u ? mine : 1u; nx = cnt > 0u ? cnt : 1u;
}
DI void xcd_barrier(const XcdBarrier& b) {
  asm volatile("s_waitcnt vmcnt(0)" ::: "memory");
  __syncthreads();
  if (threadIdx.x == 0) {
    unsigned* bar = b.bar;
    __builtin_amdgcn_s_waitcnt(0);
    unsigned nloc = b.st[0], nx = b.st[1];
    if (nloc == 0u) { xcd_barrier_complete(bar, b.x, nloc, nx); b.st[0] = nloc; b.st[1] = nx; }
    const unsigned old = xb_add(&bar[XB_XSUB(b.x)], 1u);
    const unsigned gen = old / nloc;
    if (old + 1u == (gen + 1u) * nloc) {
      __builtin_amdgcn_fence(__ATOMIC_RELEASE, "agent");
      asm volatile("s_waitcnt vmcnt(0)" ::: "memory");
      const unsigned og = xb_add(&bar[XB_TOP], 1u);
      const unsigned tg = og / nx;
      if (og + 1u == (tg + 1u) * nx) xb_add(&bar[XB_TOPGEN], 1u);
      else XB_SPIN(xb_ld(&bar[XB_TOPGEN]) == tg, bar);
      __builtin_amdgcn_fence(__ATOMIC_ACQUIRE, "agent");
      xb_add(&bar[XB_XGEN(b.x)], 1u);
      asm volatile("s_waitcnt vmcnt(0)" ::: "memory");
    } else {
      XB_SPIN(xb_ld(&bar[XB_XGEN(b.x)]) == gen, bar);
      __builtin_amdgcn_fence(__ATOMIC_ACQUIRE, "agent");
      asm volatile("s_waitcnt vmcnt(0)" ::: "memory");
    }
  }
  __syncthreads();
}

__global__ void __launch_bounds__(512) fwd_megakernel(Params p) {
  cg::grid_group grid = cg::this_grid();
  __shared__ __attribute__((aligned(1024))) char lds[2 * STAGE_B + 16];
  volatile unsigned* bst = (volatile unsigned*)(lds + 2 * STAGE_B);
  if (threadIdx.x < 2) bst[threadIdx.x] = 0u;
  __syncthreads();
  XcdBarrier xb; xb.bar = p.bar; xb.x = xb_xcc_id(); xb.st = bst;
  if (threadIdx.x == 0) (void)xb_add(&p.bar[XB_XCNT(xb.x)], 1u);
  convert_phase(p, 0, (float*)lds);
  norm_phase(p, 0, p.norm_g);
  grid.sync();
  for (int layer = 0; layer < 2; ++layer) {
    for (int f = 0; f < 2; ++f) {
      if (f == 1) {
        if (layer == 0) gemm_phase<EPI_BF16, DM, 2304>(p.xn, p.wts + W_IN, NTOK, p.big, 0.f, lds);
        else gemm_phase<EPI_BF16, DM, 1536>(p.xn, p.wts + W_IN, NTOK, p.big, 0.f, lds);
        xcd_barrier(xb);
        if (layer == 0) {
          bprep_phase(p);
          xcd_barrier(xb);
          attn_phase_l0(p, lds);
        } else {
          attn_phase_l1(p, lds);
        }
        xcd_barrier(xb);
        gemm_phase<EPI_RESID, DM, DM>(p.xn, p.wts + W_OUT, NTOK, p.h, 1.0f, lds);
        xcd_barrier(xb);
        norm_phase(p, 1, p.norm_g + (layer * 3 + 2) * DM);
        xcd_barrier(xb);
      }
      const int rows = NTOK / p.ffn_chunks;
      for (int c = 0; c < p.ffn_chunks; ++c) {
        gemm_phase<EPI_UP, DM, 2 * DFF>(p.xn + (size_t)c * rows * DM, p.wts + (f ? W_UPB : W_UPA), rows, p.big, 0.f, lds);
        xcd_barrier(xb);
        gemm_phase<EPI_RESID, DFF, DM>(p.big, p.wts + (f ? W_DNB : W_DNA), rows, p.h + (size_t)c * rows * DM, 0.5f, lds);
        xcd_barrier(xb);
      }
      if (f == 0) { norm_phase(p, 1, p.norm_g + (layer * 3 + 1) * DM); xcd_barrier(xb); }
    }
    if (layer == 0) { convert_phase(p, 1, (float*)lds); norm_phase(p, 1, p.norm_g + 3 * DM); xcd_barrier(xb); }
  }
  norm_phase(p, 2, p.final_g);
}

extern "C" void kernel_launch(void* const* d_in, const int* in_sizes, int n_in, void* d_out, int out_size, void* d_ws, size_t ws_size, hipStream_t stream) {
  static int grid_blocks = 0;
  if (!grid_blocks) {
    int dev = 0, cus = 0, per_cu = 0;
    hipGetDevice(&dev);
    hipDeviceGetAttribute(&cus, hipDeviceAttributeMultiprocessorCount, dev);
    hipOccupancyMaxActiveBlocksPerMultiprocessor(&per_cu, fwd_megakernel, 512, 0);
    if (per_cu > 1) per_cu = 1;
    if (per_cu < 1) per_cu = 1;
    grid_blocks = cus * per_cu;
  }
  Params p{};
  p.x_prompt = (const float*)d_in[0]; p.x_sample = (const float*)d_in[1]; p.norm_g = (const float*)d_in[2];
  p.w1 = (const float*)d_in[3]; p.w3 = (const float*)d_in[4]; p.w2 = (const float*)d_in[5];
  p.ab_w_in = (const float*)d_in[6]; p.ab_w_out = (const float*)d_in[7]; p.ab_qg = (const float*)d_in[8]; p.ab_kg = (const float*)d_in[9];
  p.c_w_in = (const float*)d_in[10]; p.c_w_out = (const float*)d_in[11]; p.c_sink = (const float*)d_in[12]; p.final_g = (const float*)d_in[13];
  p.h = (float*)d_out;
  char* ws = (char*)d_ws;
  const size_t MiB = 1024 * 1024;
  p.wts = (bf16_t*)ws;
  p.xn = (bf16_t*)(ws + 40 * MiB);
  p.big = (bf16_t*)(ws + 104 * MiB);
  p.bar = (unsigned*)(ws + 280 * MiB);
  p.ffn_chunks = (ws_size >= 280 * MiB + 65536) ? 1 : 2;
  if (p.ffn_chunks == 2) p.bar = (unsigned*)(ws + 250 * MiB);
  hipMemsetAsync(p.bar, 0, XCD_BAR_WORDS * sizeof(unsigned), stream);
  p.pad = 0;
  void* args[] = {&p};
  hipError_t e = hipLaunchCooperativeKernel((void*)fwd_megakernel, dim3(grid_blocks), dim3(512), args, 0, stream);
  if (e != hipSuccess) fprintf(stderr, "cooperative launch failed: %s (grid %d)\n", hipGetErrorString(e), grid_blocks);
}
```

```cpp
#include <hip/hip_runtime.h>
#include <hip/hip_cooperative_groups.h>
#include <cstdio>
namespace cg = cooperative_groups;

typedef unsigned short bf16_t;
typedef short bf16x8 __attribute__((ext_vector_type(8)));
typedef float f32x16 __attribute__((ext_vector_type(16)));
#define DI __device__ __forceinline__
#define OPAQUE_TID(v) int v = threadIdx.x; asm volatile("" : "+v"(v))
#define MFMA32(a, b, c) __builtin_amdgcn_mfma_f32_32x32x16_bf16((a), (b), (c), 0, 0, 0)

constexpr int NTOK = 32768, DM = 1024, DFF = 2816;
constexpr int PROMPT_T = 16384, SAMPLE_T = 4096;
constexpr float EPS = 1e-6f;
constexpr float LOG2E = 1.4426950408889634f;

constexpr size_t W_UPA = 0, W_DNA = 5767168, W_UPB = 8650752, W_DNB = 14417920, W_IN = 17301504, W_OUT = 19660800, W_TOTAL = 20709376;

struct Params {
  const float* x_prompt; const float* x_sample; const float* norm_g; const float* w1; const float* w3; const float* w2;
  const float* ab_w_in; const float* ab_w_out; const float* ab_qg; const float* ab_kg;
  const float* c_w_in; const float* c_w_out; const float* c_sink; const float* final_g;
  float* h; bf16_t* wts; bf16_t* xn; bf16_t* big; unsigned* bar;
  int ffn_chunks; int pad;
};

DI bf16_t f2bf(float x) { unsigned u = __float_as_uint(x); u += 0x7fffu + ((u >> 16) & 1u); return (bf16_t)(u >> 16); }
DI float bf2f(bf16_t v) { return __uint_as_float(((unsigned)v) << 16); }
DI float bflo(unsigned u) { return __uint_as_float(u << 16); }
DI float bfhi(unsigned u) { return __uint_as_float(u & 0xffff0000u); }
typedef __bf16 bf16x2_t __attribute__((ext_vector_type(2)));
typedef float f32x2_t __attribute__((ext_vector_type(2)));
DI unsigned pack2(float lo, float hi) { f32x2_t v = {lo, hi}; return __builtin_bit_cast(unsigned, __builtin_convertvector(v, bf16x2_t)); }
DI int crow(int reg, int h) { return (reg & 3) + 8 * (reg >> 2) + 4 * h; }

DI void convert_tile(const float* __restrict__ src, int K, int N, int kt, int nt, bf16_t* __restrict__ dst, int mode, float* lds) {
  OPAQUE_TID(tid);
#pragma unroll 4
  for (int i = 0; i < 8; ++i) { int e = tid + 512 * i; int kk = e >> 6, nn = e & 63; lds[kk * 65 + nn] = src[(size_t)(kt * 64 + kk) * N + nt * 64 + nn]; }
  __syncthreads();
  { const int nn = tid >> 3, kc = tid & 7, n = nt * 64 + nn;
    const int drow = (mode == 0) ? n : ((n >> 7) * 256 + (n & 127) + (mode == 2 ? 128 : 0));
    const float* lp = lds + kc * 8 * 65 + nn;
    uint4 v; v.x = pack2(lp[0], lp[65]); v.y = pack2(lp[130], lp[195]); v.z = pack2(lp[260], lp[325]); v.w = pack2(lp[390], lp[455]);
    *(uint4*)(dst + (size_t)drow * K + kt * 64 + kc * 8) = v; }
  __syncthreads();
}

DI void convert_phase(const Params& p, int layer, float* lds) {
  const int n_in = (layer == 0) ? 2304 : 1536;
  const int t_up = 16 * 44, t_dn = 44 * 16, t_in = 16 * (n_in / 64), t_out = 16 * 16;
  const int total = 4 * t_up + 2 * t_dn + t_in + t_out;
  for (int u = blockIdx.x; u < total; u += gridDim.x) {
    int r = u; const float* src; bf16_t* dst; int K, N, mode;
    if (r < 6 * t_up) {
      int mtx = r / t_up; r -= mtx * t_up; int f = mtx / 3, which = mtx % 3;
      size_t base = (size_t)(layer * 2 + f) * DM * DFF;
      if (which == 0) { src = p.w1 + base; K = DM; N = DFF; mode = 1; dst = p.wts + (f ? W_UPB : W_UPA); }
      else if (which == 1) { src = p.w3 + base; K = DM; N = DFF; mode = 2; dst = p.wts + (f ? W_UPB : W_UPA); }
      else { src = p.w2 + base; K = DFF; N = DM; mode = 0; dst = p.wts + (f ? W_DNB : W_DNA); }
    } else if (r < 6 * t_up + t_in) {
      r -= 6 * t_up; src = (layer == 0) ? p.ab_w_in : p.c_w_in; K = DM; N = n_in; mode = 0; dst = p.wts + W_IN;
    } else {
      r -= 6 * t_up + t_in; src = (layer == 0) ? p.ab_w_out : p.c_w_out; K = DM; N = DM; mode = 0; dst = p.wts + W_OUT;
    }
    const int ntn = N / 64; const int kt = r / ntn, nt = r % ntn;
    convert_tile(src, K, N, kt, nt, dst, mode, lds);
  }
}

DI void norm_phase(const Params& p, int mode, const float* __restrict__ g) {
  OPAQUE_TID(tid);
  const int lane = tid & 63, wave = tid >> 6;
  float4 gv[4];
#pragma unroll
  for (int i = 0; i < 4; ++i) gv[i] = *(const float4*)(g + lane * 4 + 256 * i);
  for (int row = blockIdx.x * 8 + wave; row < NTOK; row += gridDim.x * 8) {
    const float* src = (mode == 0) ? ((row < PROMPT_T) ? p.x_prompt + (size_t)row * DM : p.x_sample + (size_t)(row - PROMPT_T) * DM) : p.h + (size_t)row * DM;
    float4 v[4]; float ss = 0.f;
#pragma unroll
    for (int i = 0; i < 4; ++i) { v[i] = *(const float4*)(src + lane * 4 + 256 * i); ss += v[i].x * v[i].x + v[i].y * v[i].y + v[i].z * v[i].z + v[i].w * v[i].w; }
#pragma unroll
    for (int o = 32; o > 0; o >>= 1) ss += __shfl_xor(ss, o);
    const float r = rsqrtf(ss * (1.0f / DM) + EPS);
#pragma unroll
    for (int i = 0; i < 4; ++i) {
      float4 y; y.x = v[i].x * r * gv[i].x; y.y = v[i].y * r * gv[i].y; y.z = v[i].z * r * gv[i].z; y.w = v[i].w * r * gv[i].w;
      if (mode == 0) *(float4*)(p.h + (size_t)row * DM + lane * 4 + 256 * i) = v[i];
      if (mode == 2) *(float4*)(p.h + (size_t)row * DM + lane * 4 + 256 * i) = y;
      else { uint2 o2; o2.x = pack2(y.x, y.y); o2.y = pack2(y.z, y.w); *(uint2*)(p.xn + (size_t)row * DM + lane * 4 + 256 * i) = o2; }
    }
  }
}

typedef float f32x4 __attribute__((ext_vector_type(4)));
typedef unsigned u32x4 __attribute__((ext_vector_type(4)));
#define PG8_LAS __attribute__((address_space(3)))
constexpr int BM = 256, BK = 64, HALF = 128, HTB = HALF * BK * 2, STAGE_B = 4 * HTB, NXCD = 8, WGM = 8;
DI int lds_byte(int r, int c) { const int st = (r >> 4) * 2 + (c >> 5), rr = r & 15, cc = c & 31, ob = rr * 64 + cc * 2; return st * 1024 + (ob ^ (((ob >> 9) & 1) << 5)); }
DI void stage_rc(int b, int& R, int& C) { const int st = b / 1024, sb = b % 1024, swz = sb ^ (((sb >> 9) & 1) << 5); R = (st >> 1) * 16 + swz / 64; C = (st & 1) * 32 + (swz % 64) / 2; }
DI int perm32(int rho) { const int n = rho >> 4, i = rho & 15; return 8 * (i >> 2) + 4 * n + (i & 3); }
struct Unit { int pm, pn; };
struct StaticOrder {
  int nM, nN, nwg, G, c;
  DI void init(int M, int N, int G_, int c_) { nM = M / BM; nN = N / BM; nwg = nM * nN; G = G_; c = c_; }
  DI bool next(int i, Unit& u) const {
    const long L = (long)i * G + c; if (L >= nwg) return false;
    int wgid = (int)L; { const int q = nwg / NXCD, r = nwg % NXCD, xcd = wgid % NXCD, off = wgid / NXCD; wgid = (xcd < r ? xcd * (q + 1) : r * (q + 1) + (xcd - r) * q) + off; }
    const int nig = WGM * nN, gid = wgid / nig, fm = gid * WGM, gsz = (nM - fm) < WGM ? (nM - fm) : WGM;
    u.pm = fm + ((wgid % nig) % gsz); u.pn = (wgid % nig) / gsz; return true;
  }
};
struct EpiProj {
  static constexpr bool PERM = true;
  bf16_t* O; int ldc;
  DI void init(f32x4 (&acc)[2][2][4][2], const Unit&, int, int, int, int) const {
#pragma unroll
    for (int a = 0; a < 2; ++a)
#pragma unroll
      for (int b = 0; b < 2; ++b)
#pragma unroll
        for (int m = 0; m < 4; ++m)
#pragma unroll
          for (int n = 0; n < 2; ++n) acc[a][b][m][n] = (f32x4){0.f, 0.f, 0.f, 0.f};
  }
  DI void operator()(const f32x4 (&acc)[2][2][4][2], const Unit& u, int wr, int wc, int fr, int fq) const {
    const int row0 = u.pm * BM + wr * 64 + fr, col0 = u.pn * BM + wc * 32 + 8 * fq;
#pragma unroll
    for (int ai = 0; ai < 2; ++ai)
#pragma unroll
      for (int m = 0; m < 4; ++m) { bf16_t* rowp = O + (size_t)(row0 + ai * HALF + m * 16) * ldc + col0;
#pragma unroll
        for (int bj = 0; bj < 2; ++bj) { const f32x4 v0 = acc[ai][bj][m][0], v1 = acc[ai][bj][m][1];
          u32x4 w; w.x = pack2(v0[0], v0[1]); w.y = pack2(v0[2], v0[3]); w.z = pack2(v1[0], v1[1]); w.w = pack2(v1[2], v1[3]);
          *(u32x4*)(rowp + bj * HALF) = w; } }
  }
};
struct EpiUp {
  static constexpr bool PERM = true;
  bf16_t* O;
  DI void init(f32x4 (&acc)[2][2][4][2], const Unit&, int, int, int, int) const {
#pragma unroll
    for (int a = 0; a < 2; ++a)
#pragma unroll
      for (int b = 0; b < 2; ++b)
#pragma unroll
        for (int m = 0; m < 4; ++m)
#pragma unroll
          for (int n = 0; n < 2; ++n) acc[a][b][m][n] = (f32x4){0.f, 0.f, 0.f, 0.f};
  }
  DI void operator()(const f32x4 (&acc)[2][2][4][2], const Unit& u, int wr, int wc, int fr, int fq) const {
    const int row0 = u.pm * BM + wr * 64 + fr, col0 = u.pn * HALF + wc * 32 + 8 * fq;
#pragma unroll
    for (int ai = 0; ai < 2; ++ai)
#pragma unroll
      for (int m = 0; m < 4; ++m) {
        float a[8];
#pragma unroll
        for (int n = 0; n < 2; ++n)
#pragma unroll
          for (int j = 0; j < 4; ++j) { const float u1 = acc[ai][0][m][n][j], u3 = acc[ai][1][m][n][j]; a[4 * n + j] = u1 * u3 * __builtin_amdgcn_rcpf(1.f + __builtin_amdgcn_exp2f(-LOG2E * u1)); }
        u32x4 w; w.x = pack2(a[0], a[1]); w.y = pack2(a[2], a[3]); w.z = pack2(a[4], a[5]); w.w = pack2(a[6], a[7]);
        *(u32x4*)(O + (size_t)(row0 + ai * HALF + m * 16) * DFF + col0) = w; }
  }
};
struct EpiResid {
  static constexpr bool PERM = false;
  float* C; float coef;
  DI void init(f32x4 (&acc)[2][2][4][2], const Unit& u, int wr, int wc, int fr, int fq) const {
    const int row0 = u.pm * BM + wr * 64 + fr, col0 = u.pn * BM + wc * 32 + 4 * fq; const float ic = 1.f / coef;
#pragma unroll
    for (int ai = 0; ai < 2; ++ai)
#pragma unroll
      for (int m = 0; m < 4; ++m) { const float* rowp = C + (size_t)(row0 + ai * HALF + m * 16) * DM + col0;
#pragma unroll
        for (int bj = 0; bj < 2; ++bj)
#pragma unroll
          for (int n = 0; n < 2; ++n) acc[ai][bj][m][n] = *(const f32x4*)(rowp + bj * HALF + n * 16) * ic; }
  }
  DI void operator()(const f32x4 (&acc)[2][2][4][2], const Unit& u, int wr, int wc, int fr, int fq) const {
    const int row0 = u.pm * BM + wr * 64 + fr, col0 = u.pn * BM + wc * 32 + 4 * fq;
#pragma unroll
    for (int ai = 0; ai < 2; ++ai)
#pragma unroll
      for (int m = 0; m < 4; ++m) { float* rowp = C + (size_t)(row0 + ai * HALF + m * 16) * DM + col0;
#pragma unroll
        for (int bj = 0; bj < 2; ++bj)
#pragma unroll
          for (int n = 0; n < 2; ++n) *(f32x4*)(rowp + bj * HALF + n * 16) = acc[ai][bj][m][n] * coef; }
  }
};

template <class Epi>
DI void gemm_phase(const bf16_t* __restrict__ gA, const bf16_t* __restrict__ gBt, int M, int N, int K, const Epi& E, char* lds_generic) {
  PG8_LAS unsigned char* lds = (PG8_LAS unsigned char*)lds_generic;
  OPAQUE_TID(tid);
  const int wid = __builtin_amdgcn_readfirstlane(tid >> 6), lane = tid & 63, wr = wid >> 2, wc = wid & 3, fr = lane & 15, fq = lane >> 4;
  const int nt = K / BK;
  StaticOrder S; S.init(M, N, gridDim.x, blockIdx.x);
  unsigned voffA[2], voffB[2];
#pragma unroll
  for (int i = 0; i < 2; ++i) { int R, C; stage_rc(tid * 16 + i * 8192, R, C); const int Rb = Epi::PERM ? ((R & ~31) + perm32(R & 31)) : R;
    voffA[i] = (unsigned)(R * K + C) * 2u; voffB[i] = (unsigned)(Rb * K + C) * 2u; }
  const size_t kstep = (size_t)(BK * 2);
  const size_t hstep = (size_t)HALF * K * 2;
  const size_t tstep = 2 * hstep;
  const unsigned ldsw = (unsigned)wid * 1024u;
  const int aoff = lds_byte(wr * 64 + fr, fq * 8), boff = lds_byte(wc * 32 + fr, fq * 8);
#define PG8_SA(b, h) (((b) * 2 + (h)) * HTB)
#define PG8_SB(b, h) ((4 + (b) * 2 + (h)) * HTB)
#define PG8_STAGE(bufoff, gbase, voff) do { _Pragma("unroll") for (int _i = 0; _i < 2; ++_i) \
    __builtin_amdgcn_global_load_lds((const unsigned*)((const char*)(gbase) + (voff)[_i]), (PG8_LAS unsigned*)(lds + (bufoff) + ldsw + _i * 8192), 16, 0, 0); } while (0)
#define PG8_LDA(dst, b, h) do { _Pragma("unroll") for (int m = 0; m < 4; ++m) _Pragma("unroll") for (int k = 0; k < 2; ++k) dst[m][k] = *(const PG8_LAS bf16x8*)(lds + PG8_SA(b, h) + aoff + m * 2048 + k * 1024); } while (0)
#define PG8_LDB(dst, b, h) do { _Pragma("unroll") for (int n = 0; n < 2; ++n) _Pragma("unroll") for (int k = 0; k < 2; ++k) dst[n][k] = *(const PG8_LAS bf16x8*)(lds + PG8_SB(b, h) + boff + n * 2048 + k * 1024); } while (0)
#define PG8_MMA(ai, bj, At, Bt) do { __builtin_amdgcn_s_setprio(1); _Pragma("unroll") for (int m = 0; m < 4; ++m) _Pragma("unroll") for (int n = 0; n < 2; ++n) _Pragma("unroll") for (int k = 0; k < 2; ++k) \
    acc[ai][bj][m][n] = __builtin_amdgcn_mfma_f32_16x16x32_bf16(Bt[n][k], At[m][k], acc[ai][bj][m][n], 0, 0, 0); __builtin_amdgcn_s_setprio(0); } while (0)
#define PG8_WAIT_V(n) asm volatile("s_waitcnt vmcnt(" #n ")" ::: "memory")
#define PG8_WAIT_L(n) asm volatile("s_waitcnt lgkmcnt(" #n ")" ::: "memory")
#define PG8_BAR __builtin_amdgcn_s_barrier()
#define PG8_SCHED __builtin_amdgcn_sched_barrier(0)
  Unit cur, nxt; int ui = 0;
  if (!S.next(0, cur)) return;
  f32x4 acc[2][2][4][2];
  E.init(acc, cur, wr, wc, fr, fq);
  bf16x8 At[4][2], B0[2][2], B1[2][2];
  const char* cA = (const char*)gA + (size_t)cur.pm * tstep; const char* cB = (const char*)gBt + (size_t)cur.pn * tstep;
  PG8_STAGE(PG8_SB(0, 0), cB, voffB); PG8_STAGE(PG8_SA(0, 0), cA, voffA); PG8_STAGE(PG8_SB(0, 1), cB + hstep, voffB); PG8_STAGE(PG8_SA(0, 1), cA + hstep, voffA);
  if (wr == 1) PG8_BAR;
  PG8_WAIT_V(4); PG8_BAR;
  PG8_STAGE(PG8_SB(1, 0), cB + kstep, voffB); PG8_STAGE(PG8_SA(1, 0), cA + kstep, voffA); PG8_STAGE(PG8_SB(1, 1), cB + hstep + kstep, voffB);
  PG8_WAIT_V(6); PG8_BAR;
  for (;;) {
    const bool has_next = S.next(ui + 1, nxt);
    const char* nA = has_next ? (const char*)gA + (size_t)nxt.pm * tstep : cA; const char* nB = has_next ? (const char*)gBt + (size_t)nxt.pn * tstep : cB;
    for (int t = 0; t < nt; t += 2) {
      const bool last = (t == nt - 2);
      const char* a1 = cA + (size_t)(t + 1) * kstep;
      const char* a2 = last ? nA : cA + (size_t)(t + 2) * kstep; const char* b2 = last ? nB : cB + (size_t)(t + 2) * kstep;
      const char* a3 = a2 + kstep; const char* b3 = b2 + kstep;
      PG8_LDB(B0, 0, 0); PG8_SCHED; PG8_LDA(At, 0, 0); PG8_STAGE(PG8_SA(1, 1), a1 + hstep, voffA);
      PG8_WAIT_L(8); PG8_BAR; PG8_WAIT_L(0); PG8_MMA(0, 0, At, B0); PG8_BAR; PG8_SCHED;
      PG8_LDB(B1, 0, 1); PG8_STAGE(PG8_SB(0, 0), b2, voffB);
      PG8_BAR; PG8_WAIT_L(0); PG8_MMA(0, 1, At, B1); PG8_BAR;
      PG8_LDA(At, 0, 1); PG8_STAGE(PG8_SA(0, 0), a2, voffA);
      PG8_BAR; PG8_WAIT_L(0); PG8_MMA(1, 0, At, B0); PG8_BAR; PG8_SCHED;
      PG8_STAGE(PG8_SB(0, 1), b2 + hstep, voffB);
      PG8_WAIT_V(6); PG8_BAR; PG8_MMA(1, 1, At, B1); PG8_BAR;
      PG8_LDB(B0, 1, 0); PG8_SCHED; PG8_LDA(At, 1, 0); PG8_STAGE(PG8_SA(0, 1), a2 + hstep, voffA);
      PG8_WAIT_L(8); PG8_BAR; PG8_WAIT_L(0); PG8_MMA(0, 0, At, B0); PG8_BAR; PG8_SCHED;
      PG8_LDB(B1, 1, 1); PG8_STAGE(PG8_SB(1, 0), b3, voffB);
      PG8_BAR; PG8_WAIT_L(0); PG8_MMA(0, 1, At, B1); PG8_BAR;
      PG8_LDA(At, 1, 1); PG8_STAGE(PG8_SA(1, 0), a3, voffA);
      PG8_BAR; PG8_WAIT_L(0); PG8_MMA(1, 0, At, B0); PG8_BAR; PG8_SCHED;
      PG8_STAGE(PG8_SB(1, 1), b3 + hstep, voffB);
      PG8_WAIT_V(6); PG8_BAR; PG8_MMA(1, 1, At, B1); PG8_BAR;
    }
    E(acc, cur, wr, wc, fr, fq);
    if (!has_next) break;
    E.init(acc, nxt, wr, wc, fr, fq);
    cur = nxt; cA = nA; cB = nB; ++ui;
  }
  PG8_WAIT_V(0);
  if (wr == 0) PG8_BAR;
  PG8_BAR;
#undef PG8_SA
#undef PG8_SB
#undef PG8_STAGE
#undef PG8_LDA
#undef PG8_LDB
#undef PG8_MMA
#undef PG8_WAIT_V
#undef PG8_WAIT_L
#undef PG8_BAR
#undef PG8_SCHED
}

DI void bprep_phase(const Params& p) {
  OPAQUE_TID(tid);
  const int pi = tid & 31, tl = tid >> 5;
  const float fr = exp2f(-(float)((pi & 15) * 2) * (1.0f / 32.0f) * 13.287712379549449f);
  const float qg0 = p.ab_qg[2 * pi], qg1 = p.ab_qg[2 * pi + 1], kg0 = p.ab_kg[2 * pi], kg1 = p.ab_kg[2 * pi + 1];
  for (int t = blockIdx.x * 16 + tl; t < NTOK; t += gridDim.x * 16) {
    const int pos = (t < PROMPT_T) ? t : ((t - PROMPT_T) & (SAMPLE_T - 1));
    const float ang = (float)((pi < 16) ? (pos >> 6) : (pos & 63)) * fr;
    const float cs = __cosf(ang), sn = __sinf(ang);
    unsigned* rowp = (unsigned*)(p.big + (size_t)t * 2304);
#pragma unroll
    for (int hd = 0; hd < 10; ++hd) {
      const int col = (hd < 8) ? (1536 + hd * 64) : (2048 + (hd - 8) * 64);
      unsigned u = rowp[(col >> 1) + pi];
      float x1 = bflo(u), x2 = bfhi(u);
      float ss = x1 * x1 + x2 * x2;
#pragma unroll
      for (int o = 16; o > 0; o >>= 1) ss += __shfl_xor(ss, o);
      const float r = rsqrtf(ss * (1.0f / 64.0f) + EPS);
      x1 = x1 * r * ((hd < 8) ? qg0 : kg0); x2 = x2 * r * ((hd < 8) ? qg1 : kg1);
      rowp[(col >> 1) + pi] = pack2(x1 * cs - x2 * sn, x1 * sn + x2 * cs);
    }
  }
}

template <int MODE>
DI void naive_attn(const Params& p, const bf16_t* __restrict__ proj, int ld, int qoff, int koff, int voff, int nqh, int G, bf16_t* cat, int cat_off) {
  const int total = NTOK * nqh;
  for (int idx = blockIdx.x * 256 + threadIdx.x; idx < total; idx += gridDim.x * 256) {
    const int head = idx / NTOK, t = idx % NTOK, hk = head / G;
    const int seq_base = (t < PROMPT_T) ? 0 : (PROMPT_T + ((t - PROMPT_T) / SAMPLE_T) * SAMPLE_T);
    const int T = (t < PROMPT_T) ? PROMPT_T : SAMPLE_T;
    const int pos = t - seq_base;
    float q[64], o[64];
    { const uint4* qp = (const uint4*)(proj + (size_t)t * ld + qoff + head * 64);
#pragma unroll
      for (int c = 0; c < 8; ++c) { uint4 v = qp[c]; q[8*c] = bflo(v.x); q[8*c+1] = bfhi(v.x); q[8*c+2] = bflo(v.y); q[8*c+3] = bfhi(v.y); q[8*c+4] = bflo(v.z); q[8*c+5] = bfhi(v.z); q[8*c+6] = bflo(v.w); q[8*c+7] = bfhi(v.w); } }
#pragma unroll
    for (int d = 0; d < 64; ++d) o[d] = 0.f;
    float m = -1e30f, l = 0.f, slope = 0.f;
    if (MODE == 0) slope = exp2f(-(float)(head + 1));
    if (MODE == 2) { slope = exp2f(-0.5f * (float)(head + 1)); m = p.c_sink[head]; l = 1.f; }
    const int nkeys = (MODE == 0) ? 387 : (MODE == 1 ? T : 257);
    for (int j = 0; j < nkeys; ++j) {
      int off;
      if (MODE == 0) { const int br = j / 129, jj = j % 129 - 64; off = jj * (br == 0 ? 1 : (br == 1 ? 4 : 16)); }
      else if (MODE == 1) off = j - pos;
      else off = j - 128;
      const int kp = pos + off;
      if (kp < 0 || kp >= T) continue;
      const uint4* kptr = (const uint4*)(proj + (size_t)(seq_base + kp) * ld + koff + hk * 64);
      float s = 0.f;
#pragma unroll
      for (int c = 0; c < 8; ++c) { uint4 v = kptr[c];
        s += q[8*c] * bflo(v.x) + q[8*c+1] * bfhi(v.x) + q[8*c+2] * bflo(v.y) + q[8*c+3] * bfhi(v.y) + q[8*c+4] * bflo(v.z) + q[8*c+5] * bfhi(v.z) + q[8*c+6] * bflo(v.w) + q[8*c+7] * bfhi(v.w); }
      s *= 0.125f;
      if (MODE != 1) s -= slope * fabsf((float)off);
      const float mn = fmaxf(m, s); const float al = __expf(m - mn), pw = __expf(s - mn);
      m = mn; l = l * al + pw;
      const uint4* vptr = (const uint4*)(proj + (size_t)(seq_base + kp) * ld + voff + hk * 64);
#pragma unroll
      for (int c = 0; c < 8; ++c) { uint4 v = vptr[c];
        o[8*c] = o[8*c] * al + pw * bflo(v.x); o[8*c+1] = o[8*c+1] * al + pw * bfhi(v.x); o[8*c+2] = o[8*c+2] * al + pw * bflo(v.y); o[8*c+3] = o[8*c+3] * al + pw * bfhi(v.y);
        o[8*c+4] = o[8*c+4] * al + pw * bflo(v.z); o[8*c+5] = o[8*c+5] * al + pw * bfhi(v.z); o[8*c+6] = o[8*c+6] * al + pw * bflo(v.w); o[8*c+7] = o[8*c+7] * al + pw * bfhi(v.w); }
    }
    const float inv = 1.f / l;
    uint4* op = (uint4*)(cat + (size_t)t * DM + cat_off + head * 64);
#pragma unroll
    for (int c = 0; c < 8; ++c) { uint4 v; v.x = pack2(o[8*c] * inv, o[8*c+1] * inv); v.y = pack2(o[8*c+2] * inv, o[8*c+3] * inv); v.z = pack2(o[8*c+4] * inv, o[8*c+5] * inv); v.w = pack2(o[8*c+6] * inv, o[8*c+7] * inv); op[c] = v; }
  }
}

typedef short s16x4 __attribute__((ext_vector_type(4)));
typedef __attribute__((address_space(3))) s16x4* lds_s16x4_ptr;
DI s16x4 vtr(const char* p) { return __builtin_amdgcn_ds_read_tr16_b64_v4i16((lds_s16x4_ptr)p); }

template <int MODE, int NQ>
DI void attn_unit(const bf16_t* __restrict__ proj, int ld, int seq_base, int kt0, int kt1, int koff, int voff,
                  int q0w, int qoff, int ooff, float slope2, float sink2, bf16_t* __restrict__ cat, char* lds) {
  OPAQUE_TID(tid);
  const int lane = tid & 63, wave = tid >> 6, r32 = lane & 31, hh = lane >> 5;
  constexpr float C2 = 0.125f * LOG2E;
  bf16x8 qf[NQ][4];
#pragma unroll
  for (int nq = 0; nq < NQ; ++nq) { const bf16_t* qp = proj + (size_t)(seq_base + q0w + 32 * nq + r32) * ld + qoff + hh * 8;
#pragma unroll
    for (int ks = 0; ks < 4; ++ks) qf[nq][ks] = *(const bf16x8*)(qp + ks * 16); }
  f32x16 o[NQ][2];
  float m2[NQ], l[NQ];
#pragma unroll
  for (int nq = 0; nq < NQ; ++nq) { m2[nq] = (MODE == 2) ? sink2 : -1e30f; l[nq] = 0.f;
#pragma unroll
    for (int r = 0; r < 16; ++r) { o[nq][0][r] = 0.f; o[nq][1][r] = 0.f; } }
  const int skey = wave * 8 + (lane & 7), sc = lane >> 3;
  const bf16_t* kg = proj + (size_t)(seq_base + skey) * ld + koff + sc * 8;
  const bf16_t* vg = proj + (size_t)(seq_base + skey) * ld + voff + sc * 8;
  const int kw = sc * 1024 + skey * 16, vw = 16384 + (sc >> 2) * 4096 + skey * 64 + (sc & 3) * 16;
  uint4 rk0, rv0;
  { const size_t go = (size_t)kt0 * 64 * ld; rk0 = *(const uint4*)(kg + go); rv0 = *(const uint4*)(vg + go); }
  *(uint4*)(lds + kw) = rk0; *(uint4*)(lds + vw) = rv0;
  __syncthreads();
  const int kfo = hh * 1024 + r32 * 16;
  const int vfo = 16384 + (4 * hh + ((lane & 15) >> 2)) * 64 + ((lane >> 4) & 1) * 32 + (lane & 3) * 8;
  for (int kt = kt0; kt < kt1; ++kt) {
    const int buf = (kt - kt0) & 1;
    if (kt + 1 < kt1) { const size_t go = (size_t)(kt + 1) * 64 * ld; rk0 = *(const uint4*)(kg + go); rv0 = *(const uint4*)(vg + go); }
    bool active = true;
    if (MODE == 0) active = (kt * 64 + 63 >= q0w - 1024) && (kt * 64 <= q0w + 32 * NQ - 1 + 1024);
    const bool far = (MODE == 0) && ((kt * 64 > q0w + 32 * NQ - 1 + 256) || (kt * 64 + 63 < q0w - 256));
    if (active) {
      const char* kb_ = lds + buf * 8192 + kfo;
      f32x16 s[NQ][2];
#pragma unroll
      for (int nq = 0; nq < NQ; ++nq)
#pragma unroll
        for (int r = 0; r < 16; ++r) { s[nq][0][r] = 0.f; s[nq][1][r] = 0.f; }
#pragma unroll
      for (int ks = 0; ks < 4; ++ks) {
        const bf16x8 k0 = *(const bf16x8*)(kb_ + ks * 2048), k1 = *(const bf16x8*)(kb_ + ks * 2048 + 512);
#pragma unroll
        for (int nq = 0; nq < NQ; ++nq) { s[nq][0] = MFMA32(k0, qf[nq][ks], s[nq][0]); s[nq][1] = MFMA32(k1, qf[nq][ks], s[nq][1]); }
      }
      bf16x8 pf[NQ][4];
#pragma unroll
      for (int nq = 0; nq < NQ; ++nq) {
        f32x16& s0 = s[nq][0]; f32x16& s1 = s[nq][1];
        float mx = -1e30f;
        float cw0[(MODE == 0) ? 16 : 1], cw1[(MODE == 0) ? 16 : 1];
        if (MODE == 1) {
#pragma unroll
          for (int r = 0; r < 16; r += 2) mx = fmaxf(fmaxf(mx, fmaxf(s0[r], s0[r + 1])), fmaxf(s1[r], s1[r + 1]));
          mx *= C2;
        } else {
          const int d0 = kt * 64 + 4 * hh - (q0w + 32 * nq + r32);
#pragma unroll
          for (int r = 0; r < 16; ++r) {
            const int oa = d0 + (r & 3) + 8 * (r >> 2), ob = oa + 32;
            const int aa = oa < 0 ? -oa : oa, ab = ob < 0 ? -ob : ob;
            float va = fmaf(s0[r], C2, -slope2 * (float)aa), vb = fmaf(s1[r], C2, -slope2 * (float)ab);
            if (MODE == 0) {
              if (far) {
                va = ((oa & 15) == 0 && aa <= 1024) ? va : -1e30f; vb = ((oa & 15) == 0 && ab <= 1024) ? vb : -1e30f;
              } else {
                const int ca = (aa <= 64 ? 1 : 0) + (((oa & 3) == 0 && aa <= 256) ? 1 : 0) + (((oa & 15) == 0 && aa <= 1024) ? 1 : 0);
                const int cb = (ab <= 64 ? 1 : 0) + (((ob & 3) == 0 && ab <= 256) ? 1 : 0) + (((ob & 15) == 0 && ab <= 1024) ? 1 : 0);
                cw0[r] = (float)ca; cw1[r] = (float)cb;
                va = ca ? va : -1e30f; vb = cb ? vb : -1e30f;
              }
            } else {
              va = (aa <= 128) ? va : -1e30f; vb = (ab <= 128) ? vb : -1e30f;
            }
            s0[r] = va; s1[r] = vb; mx = fmaxf(mx, fmaxf(va, vb));
          }
        }
        mx = fmaxf(mx, __shfl_xor(mx, 32));
        const float mn = fmaxf(m2[nq], mx);
        if (__any(mn > m2[nq])) {
          const float alpha = __builtin_amdgcn_exp2f(m2[nq] - mn);
          l[nq] *= alpha;
#pragma unroll
          for (int r = 0; r < 16; ++r) { o[nq][0][r] *= alpha; o[nq][1][r] *= alpha; }
        }
        m2[nq] = mn;
        float ls = 0.f;
#pragma unroll
        for (int r = 0; r < 16; ++r) {
          float pa, pb;
          if (MODE == 1) { pa = __builtin_amdgcn_exp2f(fmaf(s0[r], C2, -mn)); pb = __builtin_amdgcn_exp2f(fmaf(s1[r], C2, -mn)); }
          else { pa = __builtin_amdgcn_exp2f(s0[r] - mn); pb = __builtin_amdgcn_exp2f(s1[r] - mn); }
          if (MODE == 0 && !far) { pa *= cw0[r]; pb *= cw1[r]; }
          s0[r] = pa; s1[r] = pb; ls += pa + pb;
        }
        l[nq] += ls;
#pragma unroll
        for (int ks = 0; ks < 4; ++ks) {
          uint4 t4;
          const int rb = 8 * (ks & 1);
          if (ks < 2) { t4.x = pack2(s0[rb], s0[rb + 1]); t4.y = pack2(s0[rb + 2], s0[rb + 3]); t4.z = pack2(s0[rb + 4], s0[rb + 5]); t4.w = pack2(s0[rb + 6], s0[rb + 7]); }
          else { t4.x = pack2(s1[rb], s1[rb + 1]); t4.y = pack2(s1[rb + 2], s1[rb + 3]); t4.z = pack2(s1[rb + 4], s1[rb + 5]); t4.w = pack2(s1[rb + 6], s1[rb + 7]); }
          pf[nq][ks] = __builtin_bit_cast(bf16x8, t4);
        }
      }
      const char* vb_ = lds + buf * 8192 + vfo;
#pragma unroll
      for (int ks = 0; ks < 4; ++ks) {
        const s16x4 a0 = vtr(vb_ + ks * 1024), a1 = vtr(vb_ + ks * 1024 + 512);
        const s16x4 b0 = vtr(vb_ + 4096 + ks * 1024), b1 = vtr(vb_ + 4096 + ks * 1024 + 512);
        const bf16x8 v0 = __builtin_shufflevector(a0, a1, 0, 1, 2, 3, 4, 5, 6, 7);
        const bf16x8 v1 = __builtin_shufflevector(b0, b1, 0, 1, 2, 3, 4, 5, 6, 7);
#pragma unroll
        for (int nq = 0; nq < NQ; ++nq) { o[nq][0] = MFMA32(v0, pf[nq][ks], o[nq][0]); o[nq][1] = MFMA32(v1, pf[nq][ks], o[nq][1]); }
      }
    }
    if (kt + 1 < kt1) { char* wb = lds + (buf ^ 1) * 8192; *(uint4*)(wb + kw) = rk0; *(uint4*)(wb + vw) = rv0; }
    __syncthreads();
  }
#pragma unroll
  for (int nq = 0; nq < NQ; ++nq) {
    float lt = l[nq] + __shfl_xor(l[nq], 32);
    if (MODE == 2) lt += __builtin_amdgcn_exp2f(sink2 - m2[nq]);
    const float inv = 1.f / lt;
    bf16_t* op = cat + (size_t)(seq_base + q0w + 32 * nq + r32) * DM + ooff + 4 * hh;
#pragma unroll
    for (int g = 0; g < 4; ++g) {
      uint2 a, b;
      a.x = pack2(o[nq][0][4 * g] * inv, o[nq][0][4 * g + 1] * inv); a.y = pack2(o[nq][0][4 * g + 2] * inv, o[nq][0][4 * g + 3] * inv);
      b.x = pack2(o[nq][1][4 * g] * inv, o[nq][1][4 * g + 1] * inv); b.y = pack2(o[nq][1][4 * g + 2] * inv, o[nq][1][4 * g + 3] * inv);
      *(uint2*)(op + 8 * g) = a; *(uint2*)(op + 32 + 8 * g) = b;
    }
  }
}

DI void attn_phase_l0(const Params& p, char* lds) {
  OPAQUE_TID(tid0);
  const int wave = tid0 >> 6;
  for (int u = blockIdx.x; u < 1536; u += gridDim.x) {
    if (u < 512) {
      int seq_base, T, kvh, qt;
      if (u < 256) { seq_base = 0; T = PROMPT_T; kvh = u >> 7; qt = u & 127; }
      else { const int v = u - 256; seq_base = PROMPT_T + (v >> 6) * SAMPLE_T; T = SAMPLE_T; kvh = (v >> 5) & 1; qt = v & 31; }
      const int head = kvh * 4 + (wave & 3);
      attn_unit<1, 2>(p.big, 2304, seq_base, 0, T >> 6, 2048 + kvh * 64, 2176 + kvh * 64, qt * 128 + (wave >> 2) * 64, 1536 + head * 64, 512 + head * 64, 0.f, 0.f, p.xn, lds);
    } else {
      const int v = u - 512, head = v >> 7, tok0 = (v & 127) * 256;
      const int seq_base = (tok0 < PROMPT_T) ? 0 : (PROMPT_T + ((tok0 - PROMPT_T) / SAMPLE_T) * SAMPLE_T);
      const int T = (tok0 < PROMPT_T) ? PROMPT_T : SAMPLE_T;
      const int q0b = tok0 - seq_base;
      int kt0 = (q0b - 1024) >> 6; if (kt0 < 0) kt0 = 0;
      int kt1 = ((q0b + 255 + 1024) >> 6) + 1; if (kt1 > (T >> 6)) kt1 = T >> 6;
      attn_unit<0, 1>(p.big, 2304, seq_base, kt0, kt1, 512 + head * 64, 1024 + head * 64, q0b + wave * 32, head * 64, head * 64,
                   exp2f(-(float)(head + 1)) * LOG2E, 0.f, p.xn, lds);
    }
  }
}

DI void attn_phase_l1(const Params& p, char* lds) {
  OPAQUE_TID(tid0);
  const int wave = tid0 >> 6;
  for (int u = blockIdx.x; u < 2048; u += gridDim.x) {
    const int kvh = u >> 9, tok0 = (u & 511) * 64;
    const int seq_base = (tok0 < PROMPT_T) ? 0 : (PROMPT_T + ((tok0 - PROMPT_T) / SAMPLE_T) * SAMPLE_T);
    const int T = (tok0 < PROMPT_T) ? PROMPT_T : SAMPLE_T;
    const int q0 = tok0 - seq_base, head = kvh * 4 + (wave & 3);
    int kt0 = (q0 - 128) >> 6; if (kt0 < 0) kt0 = 0;
    int kt1 = ((q0 + 63 + 128) >> 6) + 1; if (kt1 > (T >> 6)) kt1 = T >> 6;
    attn_unit<2, 1>(p.big, 1536, seq_base, kt0, kt1, 1024 + kvh * 64, 1280 + kvh * 64, q0 + (wave >> 2) * 32, head * 64, head * 64,
                 exp2f(-0.5f * (float)(head + 1)) * LOG2E, p.c_sink[head] * LOG2E, p.xn, lds);
  }
}

#define XB_TMO      128
#define XB_XCNT(j)  (256  + 64 * (j))
#define XB_XSUB(j)  (1280 + 64 * (j))
#define XB_XGEN(j)  (2304 + 64 * (j))
#define XB_TOP      3328
#define XB_TOPGEN   3392
#define XCD_BAR_WORDS 3456
#define XB_SPIN_CAP (1u << 22)
DI unsigned xb_ld(unsigned* p) { return __hip_atomic_load(p, __ATOMIC_RELAXED, __HIP_MEMORY_SCOPE_AGENT); }
DI unsigned xb_add(unsigned* p, unsigned v) { return __hip_atomic_fetch_add(p, v, __ATOMIC_RELAXED, __HIP_MEMORY_SCOPE_AGENT); }
DI unsigned xb_xcc_id() { return (unsigned)__builtin_amdgcn_s_getreg((3 << 11) | 20) & 0xFu; }
#define XB_SPIN(cond, bar) do { unsigned _sp = 0; while (cond) { __builtin_amdgcn_s_sleep(1); \
    if ((++_sp & 255u) == 0u) { if (xb_ld(&(bar)[XB_TMO])) break; if (_sp > XB_SPIN_CAP) { atomicAdd(&(bar)[XB_TMO], 1u); break; } } } } while (0)
struct XcdBarrier { unsigned* bar; unsigned x; volatile unsigned* st; };
DI void xcd_barrier_complete(unsigned* bar, unsigned x, unsigned& nloc, unsigned& nx) {
  const unsigned G = gridDim.x;
  unsigned sum, cnt, mine, sp = 0u;
  for (;;) {
    sum = 0u; cnt = 0u; mine = 0u;
#pragma unroll
    for (unsigned j = 0; j < 16; ++j) { const unsigned c = xb_ld(&bar[XB_XCNT(j)]); sum += c; cnt += (c > 0u) ? 1u : 0u; mine = (j == x) ? c : mine; }
    if (sum == G) break;
    __builtin_amdgcn_s_sleep(1);
    if ((++sp & 255u) == 0u) { if (xb_ld(&bar[XB_TMO])) break; if (sp > XB_SPIN_CAP) { atomicAdd(&bar[XB_TMO], 1u); break; } }
  }
  nloc = mine > 0u ? mine : 1u; nx = cnt > 0u ? cnt : 1u;
}
DI void xcd_barrier(const XcdBarrier& b) {
  asm volatile("s_waitcnt vmcnt(0)" ::: "memory");
  __syncthreads();
  if (threadIdx.x == 0) {
    unsigned* bar = b.bar;
    __builtin_amdgcn_s_waitcnt(0);
    unsigned nloc = b.st[0], nx = b.st[1];
    if (nloc == 0u) { xcd_barrier_complete(bar, b.x, nloc, nx); b.st[0] = nloc; b.st[1] = nx; }
    const unsigned old = xb_add(&bar[XB_XSUB(b.x)], 1u);
    const unsigned gen = old / nloc;
    if (old + 1u == (gen + 1u) * nloc) {
      __builtin_amdgcn_fence(__ATOMIC_RELEASE, "agent");
      asm volatile("s_waitcnt vmcnt(0)" ::: "memory");
      const unsigned og = xb_add(&bar[XB_TOP], 1u);
      const unsigned tg = og / nx;
      if (og + 1u == (tg + 1u) * nx) xb_add(&bar[XB_TOPGEN], 1u);
      else XB_SPIN(xb_ld(&bar[XB_TOPGEN]) == tg, bar);
      __builtin_amdgcn_fence(__ATOMIC_ACQUIRE, "agent");
      xb_add(&bar[XB_XGEN(b.x)], 1u);
      asm volatile("s_waitcnt vmcnt(0)" ::: "memory");
    } else {
      XB_SPIN(xb_ld(&bar[XB_XGEN(b.x)]) == gen, bar);
      __builtin_amdgcn_fence(__ATOMIC_ACQUIRE, "agent");
      asm volatile("s_waitcnt vmcnt(0)" ::: "memory");
    }
  }
  __syncthreads();
}

__global__ void __launch_bounds__(512) fwd_megakernel(Params p) {
  cg::grid_group grid = cg::this_grid();
  __shared__ __attribute__((aligned(1024))) char lds[2 * STAGE_B + 16];
  volatile unsigned* bst = (volatile unsigned*)(lds + 2 * STAGE_B);
  if (threadIdx.x < 2) bst[threadIdx.x] = 0u;
  __syncthreads();
  XcdBarrier xb; xb.bar = p.bar; xb.x = xb_xcc_id(); xb.st = bst;
  if (threadIdx.x == 0) (void)xb_add(&p.bar[XB_XCNT(xb.x)], 1u);
  convert_phase(p, 0, (float*)lds);
  norm_phase(p, 0, p.norm_g);
  grid.sync();
  for (int layer = 0; layer < 2; ++layer) {
    for (int f = 0; f < 2; ++f) {
      if (f == 1) {
        if (layer == 0) gemm_phase(p.xn, p.wts + W_IN, NTOK, 2304, DM, EpiProj{p.big, 2304}, lds);
        else gemm_phase(p.xn, p.wts + W_IN, NTOK, 1536, DM, EpiProj{p.big, 1536}, lds);
        xcd_barrier(xb);
        if (layer == 0) {
          bprep_phase(p);
          xcd_barrier(xb);
          attn_phase_l0(p, lds);
        } else {
          attn_phase_l1(p, lds);
        }
        xcd_barrier(xb);
        gemm_phase(p.xn, p.wts + W_OUT, NTOK, DM, DM, EpiResid{p.h, 1.0f}, lds);
        xcd_barrier(xb);
        norm_phase(p, 1, p.norm_g + (layer * 3 + 2) * DM);
        xcd_barrier(xb);
      }
      const int rows = NTOK / p.ffn_chunks;
      for (int c = 0; c < p.ffn_chunks; ++c) {
        gemm_phase(p.xn + (size_t)c * rows * DM, p.wts + (f ? W_UPB : W_UPA), rows, 2 * DFF, DM, EpiUp{p.big}, lds);
        xcd_barrier(xb);
        gemm_phase(p.big, p.wts + (f ? W_DNB : W_DNA), rows, DM, DFF, EpiResid{p.h + (size_t)c * rows * DM, 0.5f}, lds);
        xcd_barrier(xb);
      }
      if (f == 0) { norm_phase(p, 1, p.norm_g + (layer * 3 + 1) * DM); xcd_barrier(xb); }
    }
    if (layer == 0) { convert_phase(p, 1, (float*)lds); norm_phase(p, 1, p.norm_g + 3 * DM); xcd_barrier(xb); }
  }
  norm_phase(p, 2, p.final_g);
}

extern "C" void kernel_launch(void* const* d_in, const int* in_sizes, int n_in, void* d_out, int out_size, void* d_ws, size_t ws_size, hipStream_t stream) {
  static int grid_blocks = 0;
  if (!grid_blocks) {
    int dev = 0, cus = 0, per_cu = 0;
    hipGetDevice(&dev);
    hipDeviceGetAttribute(&cus, hipDeviceAttributeMultiprocessorCount, dev);
    hipOccupancyMaxActiveBlocksPerMultiprocessor(&per_cu, fwd_megakernel, 512, 0);
    if (per_cu > 1) per_cu = 1;
    if (per_cu < 1) per_cu = 1;
    grid_blocks = cus * per_cu;
  }
  Params p{};
  p.x_prompt = (const float*)d_in[0]; p.x_sample = (const float*)d_in[1]; p.norm_g = (const float*)d_in[2];
  p.w1 = (const float*)d_in[3]; p.w3 = (const float*)d_in[4]; p.w2 = (const float*)d_in[5];
  p.ab_w_in = (const float*)d_in[6]; p.ab_w_out = (const float*)d_in[7]; p.ab_qg = (const float*)d_in[8]; p.ab_kg = (const float*)d_in[9];
  p.c_w_in = (const float*)d_in[10]; p.c_w_out = (const float*)d_in[11]; p.c_sink = (const float*)d_in[12]; p.final_g = (const float*)d_in[13];
  p.h = (float*)d_out;
  char* ws = (char*)d_ws;
  const size_t MiB = 1024 * 1024;
  p.wts = (bf16_t*)ws;
  p.xn = (bf16_t*)(ws + 40 * MiB);
  p.big = (bf16_t*)(ws + 104 * MiB);
  p.bar = (unsigned*)(ws + 280 * MiB);
  p.ffn_chunks = (ws_size >= 280 * MiB + 65536) ? 1 : 2;
  if (p.ffn_chunks == 2) p.bar = (unsigned*)(ws + 250 * MiB);
  hipMemsetAsync(p.bar, 0, XCD_BAR_WORDS * sizeof(unsigned), stream);
  p.pad = 0;
  void* args[] = {&p};
  hipError_t e = hipLaunchCooperativeKernel((void*)fwd_megakernel, dim3(grid_blocks), dim3(512), args, 0, stream);
  if (e != hipSuccess) fprintf(stderr, "cooperative launch failed: %s (grid %d)\n", hipGetErrorString(e), grid_blocks);
}
```

```cpp
#include <hip/hip_runtime.h>
#include <hip/hip_cooperative_groups.h>
#include <cstdio>
namespace cg = cooperative_groups;

typedef unsigned short bf16_t;
typedef short bf16x8 __attribute__((ext_vector_type(8)));
typedef float f32x16 __attribute__((ext_vector_type(16)));
#define DI __device__ __forceinline__
#define OPAQUE_TID(v) int v = threadIdx.x; asm volatile("" : "+v"(v))
#define MFMA32(a, b, c) __builtin_amdgcn_mfma_f32_32x32x16_bf16((a), (b), (c), 0, 0, 0)

constexpr int NTOK = 32768, DM = 1024, DFF = 2816;
constexpr int PROMPT_T = 16384, SAMPLE_T = 4096;
constexpr float EPS = 1e-6f;
constexpr float LOG2E = 1.4426950408889634f;

constexpr size_t W_UPA = 0, W_DNA = 5767168, W_UPB = 8650752, W_DNB = 14417920, W_IN = 17301504, W_OUT = 19660800, W_TOTAL = 20709376;

struct Params {
  const float* x_prompt; const float* x_sample; const float* norm_g; const float* w1; const float* w3; const float* w2;
  const float* ab_w_in; const float* ab_w_out; const float* ab_qg; const float* ab_kg;
  const float* c_w_in; const float* c_w_out; const float* c_sink; const float* final_g;
  float* h; bf16_t* wts; bf16_t* xn; bf16_t* big; unsigned* bar;
  int ffn_chunks; int pad;
};

DI bf16_t f2bf(float x) { unsigned u = __float_as_uint(x); u += 0x7fffu + ((u >> 16) & 1u); return (bf16_t)(u >> 16); }
DI float bf2f(bf16_t v) { return __uint_as_float(((unsigned)v) << 16); }
DI float bflo(unsigned u) { return __uint_as_float(u << 16); }
DI float bfhi(unsigned u) { return __uint_as_float(u & 0xffff0000u); }
typedef __bf16 bf16x2_t __attribute__((ext_vector_type(2)));
typedef float f32x2_t __attribute__((ext_vector_type(2)));
DI unsigned pack2(float lo, float hi) { f32x2_t v = {lo, hi}; return __builtin_bit_cast(unsigned, __builtin_convertvector(v, bf16x2_t)); }
DI int crow(int reg, int h) { return (reg & 3) + 8 * (reg >> 2) + 4 * h; }

DI void convert_tile(const float* __restrict__ src, int K, int N, int kt, int nt, bf16_t* __restrict__ dst, int mode, float* lds) {
  OPAQUE_TID(tid);
#pragma unroll 4
  for (int i = 0; i < 8; ++i) { int e = tid + 512 * i; int kk = e >> 6, nn = e & 63; lds[kk * 65 + nn] = src[(size_t)(kt * 64 + kk) * N + nt * 64 + nn]; }
  __syncthreads();
  { const int nn = tid >> 3, kc = tid & 7, n = nt * 64 + nn;
    const int drow = (mode == 0) ? n : ((n >> 7) * 256 + (n & 127) + (mode == 2 ? 128 : 0));
    const float* lp = lds + kc * 8 * 65 + nn;
    uint4 v; v.x = pack2(lp[0], lp[65]); v.y = pack2(lp[130], lp[195]); v.z = pack2(lp[260], lp[325]); v.w = pack2(lp[390], lp[455]);
    *(uint4*)(dst + (size_t)drow * K + kt * 64 + kc * 8) = v; }
  __syncthreads();
}

DI void convert_phase(const Params& p, int layer, float* lds) {
  const int n_in = (layer == 0) ? 2304 : 1536;
  const int t_up = 16 * 44, t_dn = 44 * 16, t_in = 16 * (n_in / 64), t_out = 16 * 16;
  const int total = 4 * t_up + 2 * t_dn + t_in + t_out;
  for (int u = blockIdx.x; u < total; u += gridDim.x) {
    int r = u; const float* src; bf16_t* dst; int K, N, mode;
    if (r < 6 * t_up) {
      int mtx = r / t_up; r -= mtx * t_up; int f = mtx / 3, which = mtx % 3;
      size_t base = (size_t)(layer * 2 + f) * DM * DFF;
      if (which == 0) { src = p.w1 + base; K = DM; N = DFF; mode = 1; dst = p.wts + (f ? W_UPB : W_UPA); }
      else if (which == 1) { src = p.w3 + base; K = DM; N = DFF; mode = 2; dst = p.wts + (f ? W_UPB : W_UPA); }
      else { src = p.w2 + base; K = DFF; N = DM; mode = 0; dst = p.wts + (f ? W_DNB : W_DNA); }
    } else if (r < 6 * t_up + t_in) {
      r -= 6 * t_up; src = (layer == 0) ? p.ab_w_in : p.c_w_in; K = DM; N = n_in; mode = 0; dst = p.wts + W_IN;
    } else {
      r -= 6 * t_up + t_in; src = (layer == 0) ? p.ab_w_out : p.c_w_out; K = DM; N = DM; mode = 0; dst = p.wts + W_OUT;
    }
    const int ntn = N / 64; const int kt = r / ntn, nt = r % ntn;
    convert_tile(src, K, N, kt, nt, dst, mode, lds);
  }
}

DI void norm_phase(const Params& p, int mode, const float* __restrict__ g) {
  OPAQUE_TID(tid);
  const int lane = tid & 63, wave = tid >> 6;
  float4 gv[4];
#pragma unroll
  for (int i = 0; i < 4; ++i) gv[i] = *(const float4*)(g + lane * 4 + 256 * i);
  for (int row = blockIdx.x * 8 + wave; row < NTOK; row += gridDim.x * 8) {
    const float* src = (mode == 0) ? ((row < PROMPT_T) ? p.x_prompt + (size_t)row * DM : p.x_sample + (size_t)(row - PROMPT_T) * DM) : p.h + (size_t)row * DM;
    float4 v[4]; float ss = 0.f;
#pragma unroll
    for (int i = 0; i < 4; ++i) { v[i] = *(const float4*)(src + lane * 4 + 256 * i); ss += v[i].x * v[i].x + v[i].y * v[i].y + v[i].z * v[i].z + v[i].w * v[i].w; }
#pragma unroll
    for (int o = 32; o > 0; o >>= 1) ss += __shfl_xor(ss, o);
    const float r = rsqrtf(ss * (1.0f / DM) + EPS);
#pragma unroll
    for (int i = 0; i < 4; ++i) {
      float4 y; y.x = v[i].x * r * gv[i].x; y.y = v[i].y * r * gv[i].y; y.z = v[i].z * r * gv[i].z; y.w = v[i].w * r * gv[i].w;
      if (mode == 0) *(float4*)(p.h + (size_t)row * DM + lane * 4 + 256 * i) = v[i];
      if (mode == 2) *(float4*)(p.h + (size_t)row * DM + lane * 4 + 256 * i) = y;
      else { uint2 o2; o2.x = pack2(y.x, y.y); o2.y = pack2(y.z, y.w); *(uint2*)(p.xn + (size_t)row * DM + lane * 4 + 256 * i) = o2; }
    }
  }
}

typedef float f32x4 __attribute__((ext_vector_type(4)));
typedef unsigned u32x4 __attribute__((ext_vector_type(4)));
#define PG8_LAS __attribute__((address_space(3)))
constexpr int BM = 256, BK = 64, HALF = 128, HTB = HALF * BK * 2, STAGE_B = 4 * HTB, NXCD = 8, WGM = 8;
DI int lds_byte(int r, int c) { const int st = (r >> 4) * 2 + (c >> 5), rr = r & 15, cc = c & 31, ob = rr * 64 + cc * 2; return st * 1024 + (ob ^ (((ob >> 9) & 1) << 5)); }
DI void stage_rc(int b, int& R, int& C) { const int st = b / 1024, sb = b % 1024, swz = sb ^ (((sb >> 9) & 1) << 5); R = (st >> 1) * 16 + swz / 64; C = (st & 1) * 32 + (swz % 64) / 2; }
DI int perm32(int rho) { const int n = rho >> 4, i = rho & 15; return 8 * (i >> 2) + 4 * n + (i & 3); }
struct Unit { int pm, pn; };
struct StaticOrder {
  int nM, nN, nwg, G, c;
  DI void init(int M, int N, int G_, int c_) { nM = M / BM; nN = N / BM; nwg = nM * nN; G = G_; c = c_; }
  DI bool next(int i, Unit& u) const {
    const long L = (long)i * G + c; if (L >= nwg) return false;
    int wgid = (int)L; { const int q = nwg / NXCD, r = nwg % NXCD, xcd = wgid % NXCD, off = wgid / NXCD; wgid = (xcd < r ? xcd * (q + 1) : r * (q + 1) + (xcd - r) * q) + off; }
    const int nig = WGM * nN, gid = wgid / nig, fm = gid * WGM, gsz = (nM - fm) < WGM ? (nM - fm) : WGM;
    u.pm = fm + ((wgid % nig) % gsz); u.pn = (wgid % nig) / gsz; return true;
  }
};
struct EpiProj {
  static constexpr bool PERM = true;
  bf16_t* O; int ldc;
  DI void init(f32x4 (&acc)[2][2][4][2], const Unit&, int, int, int, int) const {
#pragma unroll
    for (int a = 0; a < 2; ++a)
#pragma unroll
      for (int b = 0; b < 2; ++b)
#pragma unroll
        for (int m = 0; m < 4; ++m)
#pragma unroll
          for (int n = 0; n < 2; ++n) acc[a][b][m][n] = (f32x4){0.f, 0.f, 0.f, 0.f};
  }
  DI void operator()(const f32x4 (&acc)[2][2][4][2], const Unit& u, int wr, int wc, int fr, int fq) const {
    const int row0 = u.pm * BM + wr * 64 + fr, col0 = u.pn * BM + wc * 32 + 8 * fq;
#pragma unroll
    for (int ai = 0; ai < 2; ++ai)
#pragma unroll
      for (int m = 0; m < 4; ++m) { bf16_t* rowp = O + (size_t)(row0 + ai * HALF + m * 16) * ldc + col0;
#pragma unroll
        for (int bj = 0; bj < 2; ++bj) { const f32x4 v0 = acc[ai][bj][m][0], v1 = acc[ai][bj][m][1];
          u32x4 w; w.x = pack2(v0[0], v0[1]); w.y = pack2(v0[2], v0[3]); w.z = pack2(v1[0], v1[1]); w.w = pack2(v1[2], v1[3]);
          *(u32x4*)(rowp + bj * HALF) = w; } }
  }
};
struct EpiUp {
  static constexpr bool PERM = true;
  bf16_t* O;
  DI void init(f32x4 (&acc)[2][2][4][2], const Unit&, int, int, int, int) const {
#pragma unroll
    for (int a = 0; a < 2; ++a)
#pragma unroll
      for (int b = 0; b < 2; ++b)
#pragma unroll
        for (int m = 0; m < 4; ++m)
#pragma unroll
          for (int n = 0; n < 2; ++n) acc[a][b][m][n] = (f32x4){0.f, 0.f, 0.f, 0.f};
  }
  DI void operator()(const f32x4 (&acc)[2][2][4][2], const Unit& u, int wr, int wc, int fr, int fq) const {
    const int row0 = u.pm * BM + wr * 64 + fr, col0 = u.pn * HALF + wc * 32 + 8 * fq;
#pragma unroll
    for (int ai = 0; ai < 2; ++ai)
#pragma unroll
      for (int m = 0; m < 4; ++m) {
        float a[8];
#pragma unroll
        for (int n = 0; n < 2; ++n)
#pragma unroll
          for (int j = 0; j < 4; ++j) { const float u1 = acc[ai][0][m][n][j], u3 = acc[ai][1][m][n][j]; a[4 * n + j] = u1 * u3 * __builtin_amdgcn_rcpf(1.f + __builtin_amdgcn_exp2f(-LOG2E * u1)); }
        u32x4 w; w.x = pack2(a[0], a[1]); w.y = pack2(a[2], a[3]); w.z = pack2(a[4], a[5]); w.w = pack2(a[6], a[7]);
        *(u32x4*)(O + (size_t)(row0 + ai * HALF + m * 16) * DFF + col0) = w; }
  }
};
struct EpiResid {
  static constexpr bool PERM = false;
  float* C; float coef;
  DI void init(f32x4 (&acc)[2][2][4][2], const Unit& u, int wr, int wc, int fr, int fq) const {
    const int row0 = u.pm * BM + wr * 64 + fr, col0 = u.pn * BM + wc * 32 + 4 * fq; const float ic = 1.f / coef;
#pragma unroll
    for (int ai = 0; ai < 2; ++ai)
#pragma unroll
      for (int m = 0; m < 4; ++m) { const float* rowp = C + (size_t)(row0 + ai * HALF + m * 16) * DM + col0;
#pragma unroll
        for (int bj = 0; bj < 2; ++bj)
#pragma unroll
          for (int n = 0; n < 2; ++n) acc[ai][bj][m][n] = *(const f32x4*)(rowp + bj * HALF + n * 16) * ic; }
  }
  DI void operator()(const f32x4 (&acc)[2][2][4][2], const Unit& u, int wr, int wc, int fr, int fq) const {
    const int row0 = u.pm * BM + wr * 64 + fr, col0 = u.pn * BM + wc * 32 + 4 * fq;
#pragma unroll
    for (int ai = 0; ai < 2; ++ai)
#pragma unroll
      for (int m = 0; m < 4; ++m) { float* rowp = C + (size_t)(row0 + ai * HALF + m * 16) * DM + col0;
#pragma unroll
        for (int bj = 0; bj < 2; ++bj)
#pragma unroll
          for (int n = 0; n < 2; ++n) *(f32x4*)(rowp + bj * HALF + n * 16) = acc[ai][bj][m][n] * coef; }
  }
};

template <class Epi>
DI void gemm_phase(const bf16_t* __restrict__ gA, const bf16_t* __restrict__ gBt, int M, int N, int K, const Epi& E, char* lds_generic) {
  PG8_LAS unsigned char* lds = (PG8_LAS unsigned char*)lds_generic;
  OPAQUE_TID(tid);
  const int wid = __builtin_amdgcn_readfirstlane(tid >> 6), lane = tid & 63, wr = wid >> 2, wc = wid & 3, fr = lane & 15, fq = lane >> 4;
  const int nt = K / BK;
  StaticOrder S; S.init(M, N, gridDim.x, blockIdx.x);
  unsigned voffA[2], voffB[2];
#pragma unroll
  for (int i = 0; i < 2; ++i) { int R, C; stage_rc(tid * 16 + i * 8192, R, C); const int Rb = Epi::PERM ? ((R & ~31) + perm32(R & 31)) : R;
    voffA[i] = (unsigned)(R * K + C) * 2u; voffB[i] = (unsigned)(Rb * K + C) * 2u; }
  const size_t kstep = (size_t)(BK * 2);
  const size_t hstep = (size_t)HALF * K * 2;
  const size_t tstep = 2 * hstep;
  const unsigned ldsw = (unsigned)wid * 1024u;
  const int aoff = lds_byte(wr * 64 + fr, fq * 8), boff = lds_byte(wc * 32 + fr, fq * 8);
#define PG8_SA(b, h) (((b) * 2 + (h)) * HTB)
#define PG8_SB(b, h) ((4 + (b) * 2 + (h)) * HTB)
#define PG8_STAGE(bufoff, gbase, voff) do { _Pragma("unroll") for (int _i = 0; _i < 2; ++_i) \
    __builtin_amdgcn_global_load_lds((const unsigned*)((const char*)(gbase) + (voff)[_i]), (PG8_LAS unsigned*)(lds + (bufoff) + ldsw + _i * 8192), 16, 0, 0); } while (0)
#define PG8_LDA(dst, b, h) do { _Pragma("unroll") for (int m = 0; m < 4; ++m) _Pragma("unroll") for (int k = 0; k < 2; ++k) dst[m][k] = *(const PG8_LAS bf16x8*)(lds + PG8_SA(b, h) + aoff + m * 2048 + k * 1024); } while (0)
#define PG8_LDB(dst, b, h) do { _Pragma("unroll") for (int n = 0; n < 2; ++n) _Pragma("unroll") for (int k = 0; k < 2; ++k) dst[n][k] = *(const PG8_LAS bf16x8*)(lds + PG8_SB(b, h) + boff + n * 2048 + k * 1024); } while (0)
#define PG8_MMA(ai, bj, At, Bt) do { __builtin_amdgcn_s_setprio(1); _Pragma("unroll") for (int m = 0; m < 4; ++m) _Pragma("unroll") for (int n = 0; n < 2; ++n) _Pragma("unroll") for (int k = 0; k < 2; ++k) \
    acc[ai][bj][m][n] = __builtin_amdgcn_mfma_f32_16x16x32_bf16(Bt[n][k], At[m][k], acc[ai][bj][m][n], 0, 0, 0); __builtin_amdgcn_s_setprio(0); } while (0)
#define PG8_WAIT_V(n) asm volatile("s_waitcnt vmcnt(" #n ")" ::: "memory")
#define PG8_WAIT_L(n) asm volatile("s_waitcnt lgkmcnt(" #n ")" ::: "memory")
#define PG8_BAR __builtin_amdgcn_s_barrier()
#define PG8_SCHED __builtin_amdgcn_sched_barrier(0)
  Unit cur, nxt; int ui = 0;
  if (!S.next(0, cur)) return;
  f32x4 acc[2][2][4][2];
  E.init(acc, cur, wr, wc, fr, fq);
  bf16x8 At[4][2], B0[2][2], B1[2][2];
  const char* cA = (const char*)gA + (size_t)cur.pm * tstep; const char* cB = (const char*)gBt + (size_t)cur.pn * tstep;
  PG8_STAGE(PG8_SB(0, 0), cB, voffB); PG8_STAGE(PG8_SA(0, 0), cA, voffA); PG8_STAGE(PG8_SB(0, 1), cB + hstep, voffB); PG8_STAGE(PG8_SA(0, 1), cA + hstep, voffA);
  if (wr == 1) PG8_BAR;
  PG8_WAIT_V(4); PG8_BAR;
  PG8_STAGE(PG8_SB(1, 0), cB + kstep, voffB); PG8_STAGE(PG8_SA(1, 0), cA + kstep, voffA); PG8_STAGE(PG8_SB(1, 1), cB + hstep + kstep, voffB);
  PG8_WAIT_V(6); PG8_BAR;
  for (;;) {
    const bool has_next = S.next(ui + 1, nxt);
    const char* nA = has_next ? (const char*)gA + (size_t)nxt.pm * tstep : cA; const char* nB = has_next ? (const char*)gBt + (size_t)nxt.pn * tstep : cB;
    for (int t = 0; t < nt; t += 2) {
      const bool last = (t == nt - 2);
      const char* a1 = cA + (size_t)(t + 1) * kstep;
      const char* a2 = last ? nA : cA + (size_t)(t + 2) * kstep; const char* b2 = last ? nB : cB + (size_t)(t + 2) * kstep;
      const char* a3 = a2 + kstep; const char* b3 = b2 + kstep;
      PG8_LDB(B0, 0, 0); PG8_SCHED; PG8_LDA(At, 0, 0); PG8_STAGE(PG8_SA(1, 1), a1 + hstep, voffA);
      PG8_WAIT_L(8); PG8_BAR; PG8_WAIT_L(0); PG8_MMA(0, 0, At, B0); PG8_BAR; PG8_SCHED;
      PG8_LDB(B1, 0, 1); PG8_STAGE(PG8_SB(0, 0), b2, voffB);
      PG8_BAR; PG8_WAIT_L(0); PG8_MMA(0, 1, At, B1); PG8_BAR;
      PG8_LDA(At, 0, 1); PG8_STAGE(PG8_SA(0, 0), a2, voffA);
      PG8_BAR; PG8_WAIT_L(0); PG8_MMA(1, 0, At, B0); PG8_BAR; PG8_SCHED;
      PG8_STAGE(PG8_SB(0, 1), b2 + hstep, voffB);
      PG8_WAIT_V(6); PG8_BAR; PG8_MMA(1, 1, At, B1); PG8_BAR;
      PG8_LDB(B0, 1, 0); PG8_SCHED; PG8_LDA(At, 1, 0); PG8_STAGE(PG8_SA(0, 1), a2 + hstep, voffA);
      PG8_WAIT_L(8); PG8_BAR; PG8_WAIT_L(0); PG8_MMA(0, 0, At, B0); PG8_BAR; PG8_SCHED;
      PG8_LDB(B1, 1, 1); PG8_STAGE(PG8_SB(1, 0), b3, voffB);
      PG8_BAR; PG8_WAIT_L(0); PG8_MMA(0, 1, At, B1); PG8_BAR;
      PG8_LDA(At, 1, 1); PG8_STAGE(PG8_SA(1, 0), a3, voffA);
      PG8_BAR; PG8_WAIT_L(0); PG8_MMA(1, 0, At, B0); PG8_BAR; PG8_SCHED;
      PG8_STAGE(PG8_SB(1, 1), b3 + hstep, voffB);
      PG8_WAIT_V(6); PG8_BAR; PG8_MMA(1, 1, At, B1); PG8_BAR;
    }
    E(acc, cur, wr, wc, fr, fq);
    if (!has_next) break;
    E.init(acc, nxt, wr, wc, fr, fq);
    cur = nxt; cA = nA; cB = nB; ++ui;
  }
  PG8_WAIT_V(0);
  if (wr == 0) PG8_BAR;
  PG8_BAR;
#undef PG8_SA
#undef PG8_SB
#undef PG8_STAGE
#undef PG8_LDA
#undef PG8_LDB
#undef PG8_MMA
#undef PG8_WAIT_V
#undef PG8_WAIT_L
#undef PG8_BAR
#undef PG8_SCHED
}

DI void bprep_phase(const Params& p) {
  OPAQUE_TID(tid);
  const int pi = tid & 31, tl = tid >> 5;
  const float fr = exp2f(-(float)((pi & 15) * 2) * (1.0f / 32.0f) * 13.287712379549449f);
  const float qg0 = p.ab_qg[2 * pi], qg1 = p.ab_qg[2 * pi + 1], kg0 = p.ab_kg[2 * pi], kg1 = p.ab_kg[2 * pi + 1];
  for (int t = blockIdx.x * 16 + tl; t < NTOK; t += gridDim.x * 16) {
    const int pos = (t < PROMPT_T) ? t : ((t - PROMPT_T) & (SAMPLE_T - 1));
    const float ang = (float)((pi < 16) ? (pos >> 6) : (pos & 63)) * fr;
    const float cs = __cosf(ang), sn = __sinf(ang);
    unsigned* rowp = (unsigned*)(p.big + (size_t)t * 2304);
#pragma unroll
    for (int hd = 0; hd < 10; ++hd) {
      const int col = (hd < 8) ? (1536 + hd * 64) : (2048 + (hd - 8) * 64);
      unsigned u = rowp[(col >> 1) + pi];
      float x1 = bflo(u), x2 = bfhi(u);
      float ss = x1 * x1 + x2 * x2;
#pragma unroll
      for (int o = 16; o > 0; o >>= 1) ss += __shfl_xor(ss, o);
      const float r = rsqrtf(ss * (1.0f / 64.0f) + EPS);
      x1 = x1 * r * ((hd < 8) ? qg0 : kg0); x2 = x2 * r * ((hd < 8) ? qg1 : kg1);
      rowp[(col >> 1) + pi] = pack2(x1 * cs - x2 * sn, x1 * sn + x2 * cs);
    }
  }
}

template <int MODE>
DI void naive_attn(const Params& p, const bf16_t* __restrict__ proj, int ld, int qoff, int koff, int voff, int nqh, int G, bf16_t* cat, int cat_off) {
  const int total = NTOK * nqh;
  for (int idx = blockIdx.x * 256 + threadIdx.x; idx < total; idx += gridDim.x * 256) {
    const int head = idx / NTOK, t = idx % NTOK, hk = head / G;
    const int seq_base = (t < PROMPT_T) ? 0 : (PROMPT_T + ((t - PROMPT_T) / SAMPLE_T) * SAMPLE_T);
    const int T = (t < PROMPT_T) ? PROMPT_T : SAMPLE_T;
    const int pos = t - seq_base;
    float q[64], o[64];
    { const uint4* qp = (const uint4*)(proj + (size_t)t * ld + qoff + head * 64);
#pragma unroll
      for (int c = 0; c < 8; ++c) { uint4 v = qp[c]; q[8*c] = bflo(v.x); q[8*c+1] = bfhi(v.x); q[8*c+2] = bflo(v.y); q[8*c+3] = bfhi(v.y); q[8*c+4] = bflo(v.z); q[8*c+5] = bfhi(v.z); q[8*c+6] = bflo(v.w); q[8*c+7] = bfhi(v.w); } }
#pragma unroll
    for (int d = 0; d < 64; ++d) o[d] = 0.f;
    float m = -1e30f, l = 0.f, slope = 0.f;
    if (MODE == 0) slope = exp2f(-(float)(head + 1));
    if (MODE == 2) { slope = exp2f(-0.5f * (float)(head + 1)); m = p.c_sink[head]; l = 1.f; }
    const int nkeys = (MODE == 0) ? 387 : (MODE == 1 ? T : 257);
    for (int j = 0; j < nkeys; ++j) {
      int off;
      if (MODE == 0) { const int br = j / 129, jj = j % 129 - 64; off = jj * (br == 0 ? 1 : (br == 1 ? 4 : 16)); }
      else if (MODE == 1) off = j - pos;
      else off = j - 128;
      const int kp = pos + off;
      if (kp < 0 || kp >= T) continue;
      const uint4* kptr = (const uint4*)(proj + (size_t)(seq_base + kp) * ld + koff + hk * 64);
      float s = 0.f;
#pragma unroll
      for (int c = 0; c < 8; ++c) { uint4 v = kptr[c];
        s += q[8*c] * bflo(v.x) + q[8*c+1] * bfhi(v.x) + q[8*c+2] * bflo(v.y) + q[8*c+3] * bfhi(v.y) + q[8*c+4] * bflo(v.z) + q[8*c+5] * bfhi(v.z) + q[8*c+6] * bflo(v.w) + q[8*c+7] * bfhi(v.w); }
      s *= 0.125f;
      if (MODE != 1) s -= slope * fabsf((float)off);
      const float mn = fmaxf(m, s); const float al = __expf(m - mn), pw = __expf(s - mn);
      m = mn; l = l * al + pw;
      const uint4* vptr = (const uint4*)(proj + (size_t)(seq_base + kp) * ld + voff + hk * 64);
#pragma unroll
      for (int c = 0; c < 8; ++c) { uint4 v = vptr[c];
        o[8*c] = o[8*c] * al + pw * bflo(v.x); o[8*c+1] = o[8*c+1] * al + pw * bfhi(v.x); o[8*c+2] = o[8*c+2] * al + pw * bflo(v.y); o[8*c+3] = o[8*c+3] * al + pw * bfhi(v.y);
        o[8*c+4] = o[8*c+4] * al + pw * bflo(v.z); o[8*c+5] = o[8*c+5] * al + pw * bfhi(v.z); o[8*c+6] = o[8*c+6] * al + pw * bflo(v.w); o[8*c+7] = o[8*c+7] * al + pw * bfhi(v.w); }
    }
    const float inv = 1.f / l;
    uint4* op = (uint4*)(cat + (size_t)t * DM + cat_off + head * 64);
#pragma unroll
    for (int c = 0; c < 8; ++c) { uint4 v; v.x = pack2(o[8*c] * inv, o[8*c+1] * inv); v.y = pack2(o[8*c+2] * inv, o[8*c+3] * inv); v.z = pack2(o[8*c+4] * inv, o[8*c+5] * inv); v.w = pack2(o[8*c+6] * inv, o[8*c+7] * inv); op[c] = v; }
  }
}

typedef short s16x4 __attribute__((ext_vector_type(4)));
typedef __attribute__((address_space(3))) s16x4* lds_s16x4_ptr;
DI s16x4 vtr(const char* p) { return __builtin_amdgcn_ds_read_tr16_b64_v4i16((lds_s16x4_ptr)p); }

template <int MODE, int NQ>
DI void attn_unit(const bf16_t* __restrict__ proj, int ld, int seq_base, int kt0, int kt1, int koff, int voff,
                  int q0w, int qoff, int ooff, float slope2, float sink2, bf16_t* __restrict__ cat, char* lds) {
  OPAQUE_TID(tid);
  const int lane = tid & 63, wave = tid >> 6, r32 = lane & 31, hh = lane >> 5;
  constexpr float C2 = 0.125f * LOG2E;
  constexpr int NS = 6;
  bf16x8 qf[NQ][4];
#pragma unroll
  for (int nq = 0; nq < NQ; ++nq) { const bf16_t* qp = proj + (size_t)(seq_base + q0w + 32 * nq + r32) * ld + qoff + hh * 8;
#pragma unroll
    for (int ks = 0; ks < 4; ++ks) qf[nq][ks] = *(const bf16x8*)(qp + ks * 16); }
  f32x16 o[NQ][2];
  float m2[NQ], l[NQ];
#pragma unroll
  for (int nq = 0; nq < NQ; ++nq) { m2[nq] = (MODE == 2) ? sink2 : -1e30f; l[nq] = 0.f;
#pragma unroll
    for (int r = 0; r < 16; ++r) { o[nq][0][r] = 0.f; o[nq][1][r] = 0.f; } }
  PG8_LAS unsigned char* L = (PG8_LAS unsigned char*)lds;
  const bf16_t* kg = proj + (size_t)(seq_base + lane) * ld + koff + wave * 8;
  const bf16_t* vg = proj + (size_t)(seq_base + (wave & 3) * 16 + (lane >> 2)) * ld + voff + ((wave >> 2) * 4 + (lane & 3)) * 8;
  const unsigned sdst = (unsigned)__builtin_amdgcn_readfirstlane(wave * 1024);
#define ATT_ISSUE(tile, slot) do { const size_t go_ = (size_t)(tile) * 64 * ld; \
    __builtin_amdgcn_global_load_lds((const unsigned*)(kg + go_), (PG8_LAS unsigned*)(L + (slot) * 16384 + sdst), 16, 0, 0); \
    __builtin_amdgcn_global_load_lds((const unsigned*)(vg + go_), (PG8_LAS unsigned*)(L + (slot) * 16384 + 8192 + sdst), 16, 0, 0); } while (0)
  const int ktl = kt1 - 1;
  constexpr int TAB_OFF = 6 * 16384, TAB_N = 2560, TAB_ZERO = 1280;
  if (MODE == 0) {
    float* tab = (float*)(lds + TAB_OFF);
    for (int e = tid; e < TAB_N; e += 512) {
      const int oo = e - TAB_ZERO, aa = oo < 0 ? -oo : oo;
      const int c = (aa <= 64 ? 1 : 0) + (((oo & 3) == 0 && aa <= 256) ? 1 : 0) + (((oo & 15) == 0 && aa <= 1024) ? 1 : 0);
      tab[e] = c ? (-slope2 * (float)aa + (c == 1 ? 0.f : (c == 2 ? 1.f : 1.5849625007f))) : -1e30f;
    }
  }
  ATT_ISSUE(kt0, 0); ATT_ISSUE((kt0 + 1 < ktl ? kt0 + 1 : ktl), 1); ATT_ISSUE((kt0 + 2 < ktl ? kt0 + 2 : ktl), 2); ATT_ISSUE((kt0 + 3 < ktl ? kt0 + 3 : ktl), 3);
  asm volatile("s_waitcnt vmcnt(6) lgkmcnt(0)\n\ts_barrier" ::: "memory");
  const int kfo = hh * 1024 + r32 * 16;
  const int vfo = 8192 + (4 * hh + ((lane & 15) >> 2)) * 64 + ((lane >> 4) & 1) * 32 + (lane & 3) * 8;
  const bool g2 = wave >= 4;
  f32x16 s[NQ][2];
  bf16x8 pf[NQ][4];
  auto tile_active = [&](int kt) -> bool { return (MODE != 0) || ((kt * 64 + 63 >= q0w - 1024) && (kt * 64 <= q0w + 32 * NQ - 1 + 1024)); };
  auto QK = [&](int slot) {
    const char* kb_ = lds + slot * 16384 + kfo;
#pragma unroll
    for (int nq = 0; nq < NQ; ++nq)
#pragma unroll
      for (int r = 0; r < 16; ++r) { s[nq][0][r] = 0.f; s[nq][1][r] = 0.f; }
#pragma unroll
    for (int ks = 0; ks < 4; ++ks) {
      const bf16x8 k0 = *(const bf16x8*)(kb_ + ks * 2048), k1 = *(const bf16x8*)(kb_ + ks * 2048 + 512);
#pragma unroll
      for (int nq = 0; nq < NQ; ++nq) { s[nq][0] = MFMA32(k0, qf[nq][ks], s[nq][0]); s[nq][1] = MFMA32(k1, qf[nq][ks], s[nq][1]); }
    }
  };
  auto SM = [&](int kt) {
#pragma unroll
    for (int nq = 0; nq < NQ; ++nq) {
      f32x16& s0 = s[nq][0]; f32x16& s1 = s[nq][1];
      float mx = -1e30f;
      if (MODE == 1) {
#pragma unroll
        for (int r = 0; r < 16; r += 2) mx = fmaxf(fmaxf(mx, fmaxf(s0[r], s0[r + 1])), fmaxf(s1[r], s1[r + 1]));
        mx *= C2;
      } else if (MODE == 0) {
        const float* tb = (const float*)(lds + TAB_OFF) + (kt * 64 + 4 * hh - (q0w + 32 * nq + r32) + TAB_ZERO);
#pragma unroll
        for (int r = 0; r < 16; ++r) {
          const float va = fmaf(s0[r], C2, tb[(r & 3) + 8 * (r >> 2)]), vb = fmaf(s1[r], C2, tb[(r & 3) + 8 * (r >> 2) + 32]);
          s0[r] = va; s1[r] = vb; mx = fmaxf(mx, fmaxf(va, vb));
        }
      } else {
        const int d0 = kt * 64 + 4 * hh - (q0w + 32 * nq + r32);
#pragma unroll
        for (int r = 0; r < 16; ++r) {
          const int oa = d0 + (r & 3) + 8 * (r >> 2), ob = oa + 32;
          const int aa = oa < 0 ? -oa : oa, ab = ob < 0 ? -ob : ob;
          float va = fmaf(s0[r], C2, -slope2 * (float)aa), vb = fmaf(s1[r], C2, -slope2 * (float)ab);
          va = (aa <= 128) ? va : -1e30f; vb = (ab <= 128) ? vb : -1e30f;
          s0[r] = va; s1[r] = vb; mx = fmaxf(mx, fmaxf(va, vb));
        }
      }
      mx = fmaxf(mx, __shfl_xor(mx, 32));
      const float mn = fmaxf(m2[nq], mx);
      if (__any(mn > m2[nq])) {
        const float alpha = __builtin_amdgcn_exp2f(m2[nq] - mn);
        l[nq] *= alpha;
#pragma unroll
        for (int r = 0; r < 16; ++r) { o[nq][0][r] *= alpha; o[nq][1][r] *= alpha; }
      }
      m2[nq] = mn;
      float ls = 0.f;
#pragma unroll
      for (int r = 0; r < 16; ++r) {
        float pa, pb;
        if (MODE == 1) { pa = __builtin_amdgcn_exp2f(fmaf(s0[r], C2, -mn)); pb = __builtin_amdgcn_exp2f(fmaf(s1[r], C2, -mn)); }
        else { pa = __builtin_amdgcn_exp2f(s0[r] - mn); pb = __builtin_amdgcn_exp2f(s1[r] - mn); }
        s0[r] = pa; s1[r] = pb; ls += pa + pb;
      }
      l[nq] += ls;
#pragma unroll
      for (int ks = 0; ks < 4; ++ks) {
        uint4 t4;
        const int rb = 8 * (ks & 1);
        if (ks < 2) { t4.x = pack2(s0[rb], s0[rb + 1]); t4.y = pack2(s0[rb + 2], s0[rb + 3]); t4.z = pack2(s0[rb + 4], s0[rb + 5]); t4.w = pack2(s0[rb + 6], s0[rb + 7]); }
        else { t4.x = pack2(s1[rb], s1[rb + 1]); t4.y = pack2(s1[rb + 2], s1[rb + 3]); t4.z = pack2(s1[rb + 4], s1[rb + 5]); t4.w = pack2(s1[rb + 6], s1[rb + 7]); }
        pf[nq][ks] = __builtin_bit_cast(bf16x8, t4);
      }
    }
  };
  auto PV = [&](int slot) {
    const char* vb_ = lds + slot * 16384 + vfo;
#pragma unroll
    for (int ks = 0; ks < 4; ++ks) {
      const s16x4 a0 = vtr(vb_ + ks * 1024), a1 = vtr(vb_ + ks * 1024 + 512);
      const s16x4 b0 = vtr(vb_ + 4096 + ks * 1024), b1 = vtr(vb_ + 4096 + ks * 1024 + 512);
      const bf16x8 v0 = __builtin_shufflevector(a0, a1, 0, 1, 2, 3, 4, 5, 6, 7);
      const bf16x8 v1 = __builtin_shufflevector(b0, b1, 0, 1, 2, 3, 4, 5, 6, 7);
#pragma unroll
      for (int nq = 0; nq < NQ; ++nq) { o[nq][0] = MFMA32(v0, pf[nq][ks], o[nq][0]); o[nq][1] = MFMA32(v1, pf[nq][ks], o[nq][1]); }
    }
  };
  int slot = 0, sp = 0;
  for (int kt = kt0; kt < kt1; ++kt) {
    { const int tn = (kt + 4 < ktl) ? kt + 4 : ktl; int s4 = slot + 4; if (s4 >= NS) s4 -= NS; ATT_ISSUE(tn, s4); }
    const bool act = tile_active(kt);
    if (!g2) {
      if (act) { QK(slot); SM(kt); PV(slot); }
    } else {
      if (kt > kt0 && tile_active(kt - 1)) PV(sp);
      if (act) { QK(slot); SM(kt); }
    }
    asm volatile("s_waitcnt vmcnt(6) lgkmcnt(0)\n\ts_barrier" ::: "memory");
    sp = slot; slot = (slot + 1 == NS) ? 0 : slot + 1;
  }
  if (g2 && tile_active(ktl)) PV(sp);
  asm volatile("s_waitcnt vmcnt(0)\n\ts_barrier" ::: "memory");
#undef ATT_ISSUE
#pragma unroll
  for (int nq = 0; nq < NQ; ++nq) {
    float lt = l[nq] + __shfl_xor(l[nq], 32);
    if (MODE == 2) lt += __builtin_amdgcn_exp2f(sink2 - m2[nq]);
    const float inv = 1.f / lt;
    bf16_t* op = cat + (size_t)(seq_base + q0w + 32 * nq + r32) * DM + ooff + 4 * hh;
#pragma unroll
    for (int g = 0; g < 4; ++g) {
      uint2 a, b;
      a.x = pack2(o[nq][0][4 * g] * inv, o[nq][0][4 * g + 1] * inv); a.y = pack2(o[nq][0][4 * g + 2] * inv, o[nq][0][4 * g + 3] * inv);
      b.x = pack2(o[nq][1][4 * g] * inv, o[nq][1][4 * g + 1] * inv); b.y = pack2(o[nq][1][4 * g + 2] * inv, o[nq][1][4 * g + 3] * inv);
      *(uint2*)(op + 8 * g) = a; *(uint2*)(op + 32 + 8 * g) = b;
    }
  }
}

DI void attn_phase_l0(const Params& p, char* lds) {
  OPAQUE_TID(tid0);
  const int wave = tid0 >> 6;
  for (int u = blockIdx.x; u < 1536; u += gridDim.x) {
    if (u < 512) {
      int seq_base, T, kvh, qt;
      if (u < 256) { seq_base = 0; T = PROMPT_T; kvh = u >> 7; qt = u & 127; }
      else { const int v = u - 256; seq_base = PROMPT_T + (v >> 6) * SAMPLE_T; T = SAMPLE_T; kvh = (v >> 5) & 1; qt = v & 31; }
      const int head = kvh * 4 + (wave & 3);
      attn_unit<1, 2>(p.big, 2304, seq_base, 0, T >> 6, 2048 + kvh * 64, 2176 + kvh * 64, qt * 128 + (wave >> 2) * 64, 1536 + head * 64, 512 + head * 64, 0.f, 0.f, p.xn, lds);
    } else {
      const int v = u - 512, head = v >> 7, tok0 = (v & 127) * 256;
      const int seq_base = (tok0 < PROMPT_T) ? 0 : (PROMPT_T + ((tok0 - PROMPT_T) / SAMPLE_T) * SAMPLE_T);
      const int T = (tok0 < PROMPT_T) ? PROMPT_T : SAMPLE_T;
      const int q0b = tok0 - seq_base;
      int kt0 = (q0b - 1024) >> 6; if (kt0 < 0) kt0 = 0;
      int kt1 = ((q0b + 255 + 1024) >> 6) + 1; if (kt1 > (T >> 6)) kt1 = T >> 6;
      attn_unit<0, 1>(p.big, 2304, seq_base, kt0, kt1, 512 + head * 64, 1024 + head * 64, q0b + wave * 32, head * 64, head * 64,
                   exp2f(-(float)(head + 1)) * LOG2E, 0.f, p.xn, lds);
    }
  }
}

DI void attn_phase_l1(const Params& p, char* lds) {
  OPAQUE_TID(tid0);
  const int wave = tid0 >> 6;
  for (int u = blockIdx.x; u < 2048; u += gridDim.x) {
    const int kvh = u >> 9, tok0 = (u & 511) * 64;
    const int seq_base = (tok0 < PROMPT_T) ? 0 : (PROMPT_T + ((tok0 - PROMPT_T) / SAMPLE_T) * SAMPLE_T);
    const int T = (tok0 < PROMPT_T) ? PROMPT_T : SAMPLE_T;
    const int q0 = tok0 - seq_base, head = kvh * 4 + (wave & 3);
    int kt0 = (q0 - 128) >> 6; if (kt0 < 0) kt0 = 0;
    int kt1 = ((q0 + 63 + 128) >> 6) + 1; if (kt1 > (T >> 6)) kt1 = T >> 6;
    attn_unit<2, 1>(p.big, 1536, seq_base, kt0, kt1, 1024 + kvh * 64, 1280 + kvh * 64, q0 + (wave >> 2) * 32, head * 64, head * 64,
                 exp2f(-0.5f * (float)(head + 1)) * LOG2E, p.c_sink[head] * LOG2E, p.xn, lds);
  }
}

#define XB_TMO      128
#define XB_XCNT(j)  (256  + 64 * (j))
#define XB_XSUB(j)  (1280 + 64 * (j))
#define XB_XGEN(j)  (2304 + 64 * (j))
#define XB_TOP      3328
#define XB_TOPGEN   3392
#define XCD_BAR_WORDS 3456
#define XB_SPIN_CAP (1u << 22)
DI unsigned xb_ld(unsigned* p) { return __hip_atomic_load(p, __ATOMIC_RELAXED, __HIP_MEMORY_SCOPE_AGENT); }
DI unsigned xb_add(unsigned* p, unsigned v) { return __hip_atomic_fetch_add(p, v, __ATOMIC_RELAXED, __HIP_MEMORY_SCOPE_AGENT); }
DI unsigned xb_xcc_id() { return (unsigned)__builtin_amdgcn_s_getreg((3 << 11) | 20) & 0xFu; }
#define XB_SPIN(cond, bar) do { unsigned _sp = 0; while (cond) { __builtin_amdgcn_s_sleep(1); \
    if ((++_sp & 255u) == 0u) { if (xb_ld(&(bar)[XB_TMO])) break; if (_sp > XB_SPIN_CAP) { atomicAdd(&(bar)[XB_TMO], 1u); break; } } } } while (0)
struct XcdBarrier { unsigned* bar; unsigned x; volatile unsigned* st; };
DI void xcd_barrier_complete(unsigned* bar, unsigned x, unsigned& nloc, unsigned& nx) {
  const unsigned G = gridDim.x;
  unsigned sum, cnt, mine, sp = 0u;
  for (;;) {
    sum = 0u; cnt = 0u; mine = 0u;
#pragma unroll
    for (unsigned j = 0; j < 16; ++j) { const unsigned c = xb_ld(&bar[XB_XCNT(j)]); sum += c; cnt += (c > 0u) ? 1u : 0u; mine = (j == x) ? c : mine; }
    if (sum == G) break;
    __builtin_amdgcn_s_sleep(1);
    if ((++sp & 255u) == 0u) { if (xb_ld(&bar[XB_TMO])) break; if (sp > XB_SPIN_CAP) { atomicAdd(&bar[XB_TMO], 1u); break; } }
  }
  nloc = mine > 0u ? mine : 1u; nx = cnt > 0u ? cnt : 1u;
}
DI void xcd_barrier(const XcdBarrier& b) {
  asm volatile("s_waitcnt vmcnt(0)" ::: "memory");
  __syncthreads();
  if (threadIdx.x == 0) {
    unsigned* bar = b.bar;
    __builtin_amdgcn_s_waitcnt(0);
    unsigned nloc = b.st[0], nx = b.st[1];
    if (nloc == 0u) { xcd_barrier_complete(bar, b.x, nloc, nx); b.st[0] = nloc; b.st[1] = nx; }
    const unsigned old = xb_add(&bar[XB_XSUB(b.x)], 1u);
    const unsigned gen = old / nloc;
    if (old + 1u == (gen + 1u) * nloc) {
      __builtin_amdgcn_fence(__ATOMIC_RELEASE, "agent");
      asm volatile("s_waitcnt vmcnt(0)" ::: "memory");
      const unsigned og = xb_add(&bar[XB_TOP], 1u);
      const unsigned tg = og / nx;
      if (og + 1u == (tg + 1u) * nx) xb_add(&bar[XB_TOPGEN], 1u);
      else XB_SPIN(xb_ld(&bar[XB_TOPGEN]) == tg, bar);
      __builtin_amdgcn_fence(__ATOMIC_ACQUIRE, "agent");
      xb_add(&bar[XB_XGEN(b.x)], 1u);
      asm volatile("s_waitcnt vmcnt(0)" ::: "memory");
    } else {
      XB_SPIN(xb_ld(&bar[XB_XGEN(b.x)]) == gen, bar);
      __builtin_amdgcn_fence(__ATOMIC_ACQUIRE, "agent");
      asm volatile("s_waitcnt vmcnt(0)" ::: "memory");
    }
  }
  __syncthreads();
}

__global__ void __launch_bounds__(512) fwd_megakernel(Params p) {
  cg::grid_group grid = cg::this_grid();
  __shared__ __attribute__((aligned(1024))) char lds[2 * STAGE_B + 16];
  volatile unsigned* bst = (volatile unsigned*)(lds + 2 * STAGE_B);
  if (threadIdx.x < 2) bst[threadIdx.x] = 0u;
  __syncthreads();
  XcdBarrier xb; xb.bar = p.bar; xb.x = xb_xcc_id(); xb.st = bst;
  if (threadIdx.x == 0) (void)xb_add(&p.bar[XB_XCNT(xb.x)], 1u);
  convert_phase(p, 0, (float*)lds);
  norm_phase(p, 0, p.norm_g);
  grid.sync();
  for (int layer = 0; layer < 2; ++layer) {
    for (int f = 0; f < 2; ++f) {
      if (f == 1) {
        if (layer == 0) gemm_phase(p.xn, p.wts + W_IN, NTOK, 2304, DM, EpiProj{p.big, 2304}, lds);
        else gemm_phase(p.xn, p.wts + W_IN, NTOK, 1536, DM, EpiProj{p.big, 1536}, lds);
        xcd_barrier(xb);
        if (layer == 0) {
          bprep_phase(p);
          xcd_barrier(xb);
          attn_phase_l0(p, lds);
        } else {
          attn_phase_l1(p, lds);
        }
        xcd_barrier(xb);
        gemm_phase(p.xn, p.wts + W_OUT, NTOK, DM, DM, EpiResid{p.h, 1.0f}, lds);
        xcd_barrier(xb);
        norm_phase(p, 1, p.norm_g + (layer * 3 + 2) * DM);
        xcd_barrier(xb);
      }
      const int rows = NTOK / p.ffn_chunks;
      for (int c = 0; c < p.ffn_chunks; ++c) {
        gemm_phase(p.xn + (size_t)c * rows * DM, p.wts + (f ? W_UPB : W_UPA), rows, 2 * DFF, DM, EpiUp{p.big}, lds);
        xcd_barrier(xb);
        gemm_phase(p.big, p.wts + (f ? W_DNB : W_DNA), rows, DM, DFF, EpiResid{p.h + (size_t)c * rows * DM, 0.5f}, lds);
        xcd_barrier(xb);
      }
      if (f == 0) { norm_phase(p, 1, p.norm_g + (layer * 3 + 1) * DM); xcd_barrier(xb); }
    }
    if (layer == 0) { convert_phase(p, 1, (float*)lds); norm_phase(p, 1, p.norm_g + 3 * DM); xcd_barrier(xb); }
  }
  norm_phase(p, 2, p.final_g);
}

extern "C" void kernel_launch(void* const* d_in, const int* in_sizes, int n_in, void* d_out, int out_size, void* d_ws, size_t ws_size, hipStream_t stream) {
  static int grid_blocks = 0;
  if (!grid_blocks) {
    int dev = 0, cus = 0, per_cu = 0;
    hipGetDevice(&dev);
    hipDeviceGetAttribute(&cus, hipDeviceAttributeMultiprocessorCount, dev);
    hipOccupancyMaxActiveBlocksPerMultiprocessor(&per_cu, fwd_megakernel, 512, 0);
    if (per_cu > 1) per_cu = 1;
    if (per_cu < 1) per_cu = 1;
    grid_blocks = cus * per_cu;
  }
  Params p{};
  p.x_prompt = (const float*)d_in[0]; p.x_sample = (const float*)d_in[1]; p.norm_g = (const float*)d_in[2];
  p.w1 = (const float*)d_in[3]; p.w3 = (const float*)d_in[4]; p.w2 = (const float*)d_in[5];
  p.ab_w_in = (const float*)d_in[6]; p.ab_w_out = (const float*)d_in[7]; p.ab_qg = (const float*)d_in[8]; p.ab_kg = (const float*)d_in[9];
  p.c_w_in = (const float*)d_in[10]; p.c_w_out = (const float*)d_in[11]; p.c_sink = (const float*)d_in[12]; p.final_g = (const float*)d_in[13];
  p.h = (float*)d_out;
  char* ws = (char*)d_ws;
  const size_t MiB = 1024 * 1024;
  p.wts = (bf16_t*)ws;
  p.xn = (bf16_t*)(ws + 40 * MiB);
  p.big = (bf16_t*)(ws + 104 * MiB);
  p.bar = (unsigned*)(ws + 280 * MiB);
  p.ffn_chunks = (ws_size >= 280 * MiB + 65536) ? 1 : 2;
  if (p.ffn_chunks == 2) p.bar = (unsigned*)(ws + 250 * MiB);
  hipMemsetAsync(p.bar, 0, XCD_BAR_WORDS * sizeof(unsigned), stream);
  p.pad = 0;
  void* args[] = {&p};
  hipError_t e = hipLaunchCooperativeKernel((void*)fwd_megakernel, dim3(grid_blocks), dim3(512), args, 0, stream);
  if (e != hipSuccess) fprintf(stderr, "cooperative launch failed: %s (grid %d)\n", hipGetErrorString(e), grid_blocks);
}
```

```cpp
#include <hip/hip_runtime.h>
#include <hip/hip_cooperative_groups.h>
#include <cstdio>
namespace cg = cooperative_groups;

typedef unsigned short bf16_t;
typedef short bf16x8 __attribute__((ext_vector_type(8)));
typedef float f32x16 __attribute__((ext_vector_type(16)));
#define DI __device__ __forceinline__
#define OPAQUE_TID(v) int v = threadIdx.x; asm volatile("" : "+v"(v))
#define MFMA32(a, b, c) __builtin_amdgcn_mfma_f32_32x32x16_bf16((a), (b), (c), 0, 0, 0)

constexpr int NTOK = 32768, DM = 1024, DFF = 2816;
constexpr int PROMPT_T = 16384, SAMPLE_T = 4096;
constexpr float EPS = 1e-6f;
constexpr float LOG2E = 1.4426950408889634f;

constexpr size_t W_UPA = 0, W_DNA = 5767168, W_UPB = 8650752, W_DNB = 14417920, W_IN = 17301504, W_OUT = 19660800, W_TOTAL = 20709376;

struct Params {
  const float* x_prompt; const float* x_sample; const float* norm_g; const float* w1; const float* w3; const float* w2;
  const float* ab_w_in; const float* ab_w_out; const float* ab_qg; const float* ab_kg;
  const float* c_w_in; const float* c_w_out; const float* c_sink; const float* final_g;
  float* h; bf16_t* wts; bf16_t* xn; bf16_t* big; unsigned* bar;
  int ffn_chunks; int pad;
};

DI bf16_t f2bf(float x) { unsigned u = __float_as_uint(x); u += 0x7fffu + ((u >> 16) & 1u); return (bf16_t)(u >> 16); }
DI float bf2f(bf16_t v) { return __uint_as_float(((unsigned)v) << 16); }
DI float bflo(unsigned u) { return __uint_as_float(u << 16); }
DI float bfhi(unsigned u) { return __uint_as_float(u & 0xffff0000u); }
typedef __bf16 bf16x2_t __attribute__((ext_vector_type(2)));
typedef float f32x2_t __attribute__((ext_vector_type(2)));
DI unsigned pack2(float lo, float hi) { f32x2_t v = {lo, hi}; return __builtin_bit_cast(unsigned, __builtin_convertvector(v, bf16x2_t)); }
DI int crow(int reg, int h) { return (reg & 3) + 8 * (reg >> 2) + 4 * h; }

DI void convert_tile(const float* __restrict__ src, int K, int N, int kt, int nt, bf16_t* __restrict__ dst, int mode, float* lds) {
  OPAQUE_TID(tid);
#pragma unroll 4
  for (int i = 0; i < 8; ++i) { int e = tid + 512 * i; int kk = e >> 6, nn = e & 63; lds[kk * 65 + nn] = src[(size_t)(kt * 64 + kk) * N + nt * 64 + nn]; }
  __syncthreads();
  { const int nn = tid >> 3, kc = tid & 7, n = nt * 64 + nn;
    const int drow = (mode == 0) ? n : ((n >> 7) * 256 + (n & 127) + (mode == 2 ? 128 : 0));
    const float* lp = lds + kc * 8 * 65 + nn;
    uint4 v; v.x = pack2(lp[0], lp[65]); v.y = pack2(lp[130], lp[195]); v.z = pack2(lp[260], lp[325]); v.w = pack2(lp[390], lp[455]);
    *(uint4*)(dst + (size_t)drow * K + kt * 64 + kc * 8) = v; }
  __syncthreads();
}

DI void convert_phase(const Params& p, int layer, float* lds) {
  const int n_in = (layer == 0) ? 2304 : 1536;
  const int t_up = 16 * 44, t_dn = 44 * 16, t_in = 16 * (n_in / 64), t_out = 16 * 16;
  const int total = 4 * t_up + 2 * t_dn + t_in + t_out;
  for (int u = blockIdx.x; u < total; u += gridDim.x) {
    int r = u; const float* src; bf16_t* dst; int K, N, mode;
    if (r < 6 * t_up) {
      int mtx = r / t_up; r -= mtx * t_up; int f = mtx / 3, which = mtx % 3;
      size_t base = (size_t)(layer * 2 + f) * DM * DFF;
      if (which == 0) { src = p.w1 + base; K = DM; N = DFF; mode = 1; dst = p.wts + (f ? W_UPB : W_UPA); }
      else if (which == 1) { src = p.w3 + base; K = DM; N = DFF; mode = 2; dst = p.wts + (f ? W_UPB : W_UPA); }
      else { src = p.w2 + base; K = DFF; N = DM; mode = 0; dst = p.wts + (f ? W_DNB : W_DNA); }
    } else if (r < 6 * t_up + t_in) {
      r -= 6 * t_up; src = (layer == 0) ? p.ab_w_in : p.c_w_in; K = DM; N = n_in; mode = 0; dst = p.wts + W_IN;
    } else {
      r -= 6 * t_up + t_in; src = (layer == 0) ? p.ab_w_out : p.c_w_out; K = DM; N = DM; mode = 0; dst = p.wts + W_OUT;
    }
    const int ntn = N / 64; const int kt = r / ntn, nt = r % ntn;
    convert_tile(src, K, N, kt, nt, dst, mode, lds);
  }
}

DI void norm_phase(const Params& p, int mode, const float* __restrict__ g) {
  OPAQUE_TID(tid);
  const int lane = tid & 63, wave = tid >> 6;
  float4 gv[4];
#pragma unroll
  for (int i = 0; i < 4; ++i) gv[i] = *(const float4*)(g + lane * 4 + 256 * i);
  for (int row = blockIdx.x * 8 + wave; row < NTOK; row += gridDim.x * 8) {
    const float* src = (mode == 0) ? ((row < PROMPT_T) ? p.x_prompt + (size_t)row * DM : p.x_sample + (size_t)(row - PROMPT_T) * DM) : p.h + (size_t)row * DM;
    float4 v[4]; float ss = 0.f;
#pragma unroll
    for (int i = 0; i < 4; ++i) { v[i] = *(const float4*)(src + lane * 4 + 256 * i); ss += v[i].x * v[i].x + v[i].y * v[i].y + v[i].z * v[i].z + v[i].w * v[i].w; }
#pragma unroll
    for (int o = 32; o > 0; o >>= 1) ss += __shfl_xor(ss, o);
    const float r = rsqrtf(ss * (1.0f / DM) + EPS);
#pragma unroll
    for (int i = 0; i < 4; ++i) {
      float4 y; y.x = v[i].x * r * gv[i].x; y.y = v[i].y * r * gv[i].y; y.z = v[i].z * r * gv[i].z; y.w = v[i].w * r * gv[i].w;
      if (mode == 0) *(float4*)(p.h + (size_t)row * DM + lane * 4 + 256 * i) = v[i];
      if (mode == 2) *(float4*)(p.h + (size_t)row * DM + lane * 4 + 256 * i) = y;
      else { uint2 o2; o2.x = pack2(y.x, y.y); o2.y = pack2(y.z, y.w); *(uint2*)(p.xn + (size_t)row * DM + lane * 4 + 256 * i) = o2; }
    }
  }
}

typedef float f32x4 __attribute__((ext_vector_type(4)));
typedef unsigned u32x4 __attribute__((ext_vector_type(4)));
#define PG8_LAS __attribute__((address_space(3)))
constexpr int BM = 256, BK = 64, HALF = 128, HTB = HALF * BK * 2, STAGE_B = 4 * HTB, NXCD = 8, WGM = 8;
DI int lds_byte(int r, int c) { const int st = (r >> 4) * 2 + (c >> 5), rr = r & 15, cc = c & 31, ob = rr * 64 + cc * 2; return st * 1024 + (ob ^ (((ob >> 9) & 1) << 5)); }
DI void stage_rc(int b, int& R, int& C) { const int st = b / 1024, sb = b % 1024, swz = sb ^ (((sb >> 9) & 1) << 5); R = (st >> 1) * 16 + swz / 64; C = (st & 1) * 32 + (swz % 64) / 2; }
DI int perm32(int rho) { const int n = rho >> 4, i = rho & 15; return 8 * (i >> 2) + 4 * n + (i & 3); }
struct Unit { int pm, pn; };
struct StaticOrder {
  int nM, nN, nwg, G, c;
  DI void init(int M, int N, int G_, int c_) { nM = M / BM; nN = N / BM; nwg = nM * nN; G = G_; c = c_; }
  DI bool next(int i, Unit& u) const {
    const long L = (long)i * G + c; if (L >= nwg) return false;
    int wgid = (int)L; { const int q = nwg / NXCD, r = nwg % NXCD, xcd = wgid % NXCD, off = wgid / NXCD; wgid = (xcd < r ? xcd * (q + 1) : r * (q + 1) + (xcd - r) * q) + off; }
    const int nig = WGM * nN, gid = wgid / nig, fm = gid * WGM, gsz = (nM - fm) < WGM ? (nM - fm) : WGM;
    u.pm = fm + ((wgid % nig) % gsz); u.pn = (wgid % nig) / gsz; return true;
  }
};
struct EpiProj {
  static constexpr bool PERM = true;
  bf16_t* O; int ldc;
  DI void init(f32x4 (&acc)[2][2][4][2], const Unit&, int, int, int, int) const {
#pragma unroll
    for (int a = 0; a < 2; ++a)
#pragma unroll
      for (int b = 0; b < 2; ++b)
#pragma unroll
        for (int m = 0; m < 4; ++m)
#pragma unroll
          for (int n = 0; n < 2; ++n) acc[a][b][m][n] = (f32x4){0.f, 0.f, 0.f, 0.f};
  }
  DI void operator()(const f32x4 (&acc)[2][2][4][2], const Unit& u, int wr, int wc, int fr, int fq) const {
    const int row0 = u.pm * BM + wr * 64 + fr, col0 = u.pn * BM + wc * 32 + 8 * fq;
#pragma unroll
    for (int ai = 0; ai < 2; ++ai)
#pragma unroll
      for (int m = 0; m < 4; ++m) { bf16_t* rowp = O + (size_t)(row0 + ai * HALF + m * 16) * ldc + col0;
#pragma unroll
        for (int bj = 0; bj < 2; ++bj) { const f32x4 v0 = acc[ai][bj][m][0], v1 = acc[ai][bj][m][1];
          u32x4 w; w.x = pack2(v0[0], v0[1]); w.y = pack2(v0[2], v0[3]); w.z = pack2(v1[0], v1[1]); w.w = pack2(v1[2], v1[3]);
          *(u32x4*)(rowp + bj * HALF) = w; } }
  }
};
struct EpiUp {
  static constexpr bool PERM = true;
  bf16_t* O;
  DI void init(f32x4 (&acc)[2][2][4][2], const Unit&, int, int, int, int) const {
#pragma unroll
    for (int a = 0; a < 2; ++a)
#pragma unroll
      for (int b = 0; b < 2; ++b)
#pragma unroll
        for (int m = 0; m < 4; ++m)
#pragma unroll
          for (int n = 0; n < 2; ++n) acc[a][b][m][n] = (f32x4){0.f, 0.f, 0.f, 0.f};
  }
  DI void operator()(const f32x4 (&acc)[2][2][4][2], const Unit& u, int wr, int wc, int fr, int fq) const {
    const int row0 = u.pm * BM + wr * 64 + fr, col0 = u.pn * HALF + wc * 32 + 8 * fq;
#pragma unroll
    for (int ai = 0; ai < 2; ++ai)
#pragma unroll
      for (int m = 0; m < 4; ++m) {
        float a[8];
#pragma unroll
        for (int n = 0; n < 2; ++n)
#pragma unroll
          for (int j = 0; j < 4; ++j) { const float u1 = acc[ai][0][m][n][j], u3 = acc[ai][1][m][n][j]; a[4 * n + j] = u1 * u3 * __builtin_amdgcn_rcpf(1.f + __builtin_amdgcn_exp2f(-LOG2E * u1)); }
        u32x4 w; w.x = pack2(a[0], a[1]); w.y = pack2(a[2], a[3]); w.z = pack2(a[4], a[5]); w.w = pack2(a[6], a[7]);
        *(u32x4*)(O + (size_t)(row0 + ai * HALF + m * 16) * DFF + col0) = w; }
  }
};
struct EpiResid {
  static constexpr bool PERM = false;
  float* C; float coef;
  DI void init(f32x4 (&acc)[2][2][4][2], const Unit& u, int wr, int wc, int fr, int fq) const {
    const int row0 = u.pm * BM + wr * 64 + fr, col0 = u.pn * BM + wc * 32 + 4 * fq; const float ic = 1.f / coef;
#pragma unroll
    for (int ai = 0; ai < 2; ++ai)
#pragma unroll
      for (int m = 0; m < 4; ++m) { const float* rowp = C + (size_t)(row0 + ai * HALF + m * 16) * DM + col0;
#pragma unroll
        for (int bj = 0; bj < 2; ++bj)
#pragma unroll
          for (int n = 0; n < 2; ++n) acc[ai][bj][m][n] = *(const f32x4*)(rowp + bj * HALF + n * 16) * ic; }
  }
  DI void operator()(const f32x4 (&acc)[2][2][4][2], const Unit& u, int wr, int wc, int fr, int fq) const {
    const int row0 = u.pm * BM + wr * 64 + fr, col0 = u.pn * BM + wc * 32 + 4 * fq;
#pragma unroll
    for (int ai = 0; ai < 2; ++ai)
#pragma unroll
      for (int m = 0; m < 4; ++m) { float* rowp = C + (size_t)(row0 + ai * HALF + m * 16) * DM + col0;
#pragma unroll
        for (int bj = 0; bj < 2; ++bj)
#pragma unroll
          for (int n = 0; n < 2; ++n) *(f32x4*)(rowp + bj * HALF + n * 16) = acc[ai][bj][m][n] * coef; }
  }
};

template <class Epi>
DI void gemm_phase(const bf16_t* __restrict__ gA, const bf16_t* __restrict__ gBt, int M, int N, int K, const Epi& E, char* lds_generic) {
  PG8_LAS unsigned char* lds = (PG8_LAS unsigned char*)lds_generic;
  OPAQUE_TID(tid);
  const int wid = __builtin_amdgcn_readfirstlane(tid >> 6), lane = tid & 63, wr = wid >> 2, wc = wid & 3, fr = lane & 15, fq = lane >> 4;
  const int nt = K / BK;
  StaticOrder S; S.init(M, N, gridDim.x, blockIdx.x);
  unsigned voffA[2], voffB[2];
#pragma unroll
  for (int i = 0; i < 2; ++i) { int R, C; stage_rc(tid * 16 + i * 8192, R, C); const int Rb = Epi::PERM ? ((R & ~31) + perm32(R & 31)) : R;
    voffA[i] = (unsigned)(R * K + C) * 2u; voffB[i] = (unsigned)(Rb * K + C) * 2u; }
  const size_t kstep = (size_t)(BK * 2);
  const size_t hstep = (size_t)HALF * K * 2;
  const size_t tstep = 2 * hstep;
  const unsigned ldsw = (unsigned)wid * 1024u;
  const int aoff = lds_byte(wr * 64 + fr, fq * 8), boff = lds_byte(wc * 32 + fr, fq * 8);
#define PG8_SA(b, h) (((b) * 2 + (h)) * HTB)
#define PG8_SB(b, h) ((4 + (b) * 2 + (h)) * HTB)
#define PG8_STAGE(bufoff, gbase, voff) do { _Pragma("unroll") for (int _i = 0; _i < 2; ++_i) \
    __builtin_amdgcn_global_load_lds((const unsigned*)((const char*)(gbase) + (voff)[_i]), (PG8_LAS unsigned*)(lds + (bufoff) + ldsw + _i * 8192), 16, 0, 0); } while (0)
#define PG8_LDA(dst, b, h) do { _Pragma("unroll") for (int m = 0; m < 4; ++m) _Pragma("unroll") for (int k = 0; k < 2; ++k) dst[m][k] = *(const PG8_LAS bf16x8*)(lds + PG8_SA(b, h) + aoff + m * 2048 + k * 1024); } while (0)
#define PG8_LDB(dst, b, h) do { _Pragma("unroll") for (int n = 0; n < 2; ++n) _Pragma("unroll") for (int k = 0; k < 2; ++k) dst[n][k] = *(const PG8_LAS bf16x8*)(lds + PG8_SB(b, h) + boff + n * 2048 + k * 1024); } while (0)
#define PG8_MMA(ai, bj, At, Bt) do { __builtin_amdgcn_s_setprio(1); _Pragma("unroll") for (int m = 0; m < 4; ++m) _Pragma("unroll") for (int n = 0; n < 2; ++n) _Pragma("unroll") for (int k = 0; k < 2; ++k) \
    acc[ai][bj][m][n] = __builtin_amdgcn_mfma_f32_16x16x32_bf16(Bt[n][k], At[m][k], acc[ai][bj][m][n], 0, 0, 0); __builtin_amdgcn_s_setprio(0); } while (0)
#define PG8_WAIT_V(n) asm volatile("s_waitcnt vmcnt(" #n ")" ::: "memory")
#define PG8_WAIT_L(n) asm volatile("s_waitcnt lgkmcnt(" #n ")" ::: "memory")
#define PG8_BAR __builtin_amdgcn_s_barrier()
#define PG8_SCHED __builtin_amdgcn_sched_barrier(0)
  Unit cur, nxt; int ui = 0;
  if (!S.next(0, cur)) return;
  f32x4 acc[2][2][4][2];
  E.init(acc, cur, wr, wc, fr, fq);
  bf16x8 At[4][2], B0[2][2], B1[2][2];
  const char* cA = (const char*)gA + (size_t)cur.pm * tstep; const char* cB = (const char*)gBt + (size_t)cur.pn * tstep;
  PG8_STAGE(PG8_SB(0, 0), cB, voffB); PG8_STAGE(PG8_SA(0, 0), cA, voffA); PG8_STAGE(PG8_SB(0, 1), cB + hstep, voffB); PG8_STAGE(PG8_SA(0, 1), cA + hstep, voffA);
  if (wr == 1) PG8_BAR;
  PG8_WAIT_V(4); PG8_BAR;
  PG8_STAGE(PG8_SB(1, 0), cB + kstep, voffB); PG8_STAGE(PG8_SA(1, 0), cA + kstep, voffA); PG8_STAGE(PG8_SB(1, 1), cB + hstep + kstep, voffB);
  PG8_WAIT_V(6); PG8_BAR;
  for (;;) {
    const bool has_next = S.next(ui + 1, nxt);
    const char* nA = has_next ? (const char*)gA + (size_t)nxt.pm * tstep : cA; const char* nB = has_next ? (const char*)gBt + (size_t)nxt.pn * tstep : cB;
    for (int t = 0; t < nt; t += 2) {
      const bool last = (t == nt - 2);
      const char* a1 = cA + (size_t)(t + 1) * kstep;
      const char* a2 = last ? nA : cA + (size_t)(t + 2) * kstep; const char* b2 = last ? nB : cB + (size_t)(t + 2) * kstep;
      const char* a3 = a2 + kstep; const char* b3 = b2 + kstep;
      PG8_LDB(B0, 0, 0); PG8_SCHED; PG8_LDA(At, 0, 0); PG8_STAGE(PG8_SA(1, 1), a1 + hstep, voffA);
      PG8_WAIT_L(8); PG8_BAR; PG8_WAIT_L(0); PG8_MMA(0, 0, At, B0); PG8_BAR; PG8_SCHED;
      PG8_LDB(B1, 0, 1); PG8_STAGE(PG8_SB(0, 0), b2, voffB);
      PG8_BAR; PG8_WAIT_L(0); PG8_MMA(0, 1, At, B1); PG8_BAR;
      PG8_LDA(At, 0, 1); PG8_STAGE(PG8_SA(0, 0), a2, voffA);
      PG8_BAR; PG8_WAIT_L(0); PG8_MMA(1, 0, At, B0); PG8_BAR; PG8_SCHED;
      PG8_STAGE(PG8_SB(0, 1), b2 + hstep, voffB);
      PG8_WAIT_V(6); PG8_BAR; PG8_MMA(1, 1, At, B1); PG8_BAR;
      PG8_LDB(B0, 1, 0); PG8_SCHED; PG8_LDA(At, 1, 0); PG8_STAGE(PG8_SA(0, 1), a2 + hstep, voffA);
      PG8_WAIT_L(8); PG8_BAR; PG8_WAIT_L(0); PG8_MMA(0, 0, At, B0); PG8_BAR; PG8_SCHED;
      PG8_LDB(B1, 1, 1); PG8_STAGE(PG8_SB(1, 0), b3, voffB);
      PG8_BAR; PG8_WAIT_L(0); PG8_MMA(0, 1, At, B1); PG8_BAR;
      PG8_LDA(At, 1, 1); PG8_STAGE(PG8_SA(1, 0), a3, voffA);
      PG8_BAR; PG8_WAIT_L(0); PG8_MMA(1, 0, At, B0); PG8_BAR; PG8_SCHED;
      PG8_STAGE(PG8_SB(1, 1), b3 + hstep, voffB);
      PG8_WAIT_V(6); PG8_BAR; PG8_MMA(1, 1, At, B1); PG8_BAR;
    }
    E(acc, cur, wr, wc, fr, fq);
    if (!has_next) break;
    E.init(acc, nxt, wr, wc, fr, fq);
    cur = nxt; cA = nA; cB = nB; ++ui;
  }
  PG8_WAIT_V(0);
  if (wr == 0) PG8_BAR;
  PG8_BAR;
#undef PG8_SA
#undef PG8_SB
#undef PG8_STAGE
#undef PG8_LDA
#undef PG8_LDB
#undef PG8_MMA
#undef PG8_WAIT_V
#undef PG8_WAIT_L
#undef PG8_BAR
#undef PG8_SCHED
}

DI void bprep_phase(const Params& p) {
  OPAQUE_TID(tid);
  const int pi = tid & 31, tl = tid >> 5;
  const float fr = exp2f(-(float)((pi & 15) * 2) * (1.0f / 32.0f) * 13.287712379549449f);
  const float qg0 = p.ab_qg[2 * pi], qg1 = p.ab_qg[2 * pi + 1], kg0 = p.ab_kg[2 * pi], kg1 = p.ab_kg[2 * pi + 1];
  for (int t = blockIdx.x * 16 + tl; t < NTOK; t += gridDim.x * 16) {
    const int pos = (t < PROMPT_T) ? t : ((t - PROMPT_T) & (SAMPLE_T - 1));
    const float ang = (float)((pi < 16) ? (pos >> 6) : (pos & 63)) * fr;
    const float cs = __cosf(ang), sn = __sinf(ang);
    unsigned* rowp = (unsigned*)(p.big + (size_t)t * 2304);
#pragma unroll
    for (int hd = 0; hd < 10; ++hd) {
      const int col = (hd < 8) ? (1536 + hd * 64) : (2048 + (hd - 8) * 64);
      unsigned u = rowp[(col >> 1) + pi];
      float x1 = bflo(u), x2 = bfhi(u);
      float ss = x1 * x1 + x2 * x2;
#pragma unroll
      for (int o = 16; o > 0; o >>= 1) ss += __shfl_xor(ss, o);
      const float r = rsqrtf(ss * (1.0f / 64.0f) + EPS);
      x1 = x1 * r * ((hd < 8) ? qg0 : kg0); x2 = x2 * r * ((hd < 8) ? qg1 : kg1);
      rowp[(col >> 1) + pi] = pack2(x1 * cs - x2 * sn, x1 * sn + x2 * cs);
    }
  }
}

template <int MODE>
DI void naive_attn(const Params& p, const bf16_t* __restrict__ proj, int ld, int qoff, int koff, int voff, int nqh, int G, bf16_t* cat, int cat_off) {
  const int total = NTOK * nqh;
  for (int idx = blockIdx.x * 256 + threadIdx.x; idx < total; idx += gridDim.x * 256) {
    const int head = idx / NTOK, t = idx % NTOK, hk = head / G;
    const int seq_base = (t < PROMPT_T) ? 0 : (PROMPT_T + ((t - PROMPT_T) / SAMPLE_T) * SAMPLE_T);
    const int T = (t < PROMPT_T) ? PROMPT_T : SAMPLE_T;
    const int pos = t - seq_base;
    float q[64], o[64];
    { const uint4* qp = (const uint4*)(proj + (size_t)t * ld + qoff + head * 64);
#pragma unroll
      for (int c = 0; c < 8; ++c) { uint4 v = qp[c]; q[8*c] = bflo(v.x); q[8*c+1] = bfhi(v.x); q[8*c+2] = bflo(v.y); q[8*c+3] = bfhi(v.y); q[8*c+4] = bflo(v.z); q[8*c+5] = bfhi(v.z); q[8*c+6] = bflo(v.w); q[8*c+7] = bfhi(v.w); } }
#pragma unroll
    for (int d = 0; d < 64; ++d) o[d] = 0.f;
    float m = -1e30f, l = 0.f, slope = 0.f;
    if (MODE == 0) slope = exp2f(-(float)(head + 1));
    if (MODE == 2) { slope = exp2f(-0.5f * (float)(head + 1)); m = p.c_sink[head]; l = 1.f; }
    const int nkeys = (MODE == 0) ? 387 : (MODE == 1 ? T : 257);
    for (int j = 0; j < nkeys; ++j) {
      int off;
      if (MODE == 0) { const int br = j / 129, jj = j % 129 - 64; off = jj * (br == 0 ? 1 : (br == 1 ? 4 : 16)); }
      else if (MODE == 1) off = j - pos;
      else off = j - 128;
      const int kp = pos + off;
      if (kp < 0 || kp >= T) continue;
      const uint4* kptr = (const uint4*)(proj + (size_t)(seq_base + kp) * ld + koff + hk * 64);
      float s = 0.f;
#pragma unroll
      for (int c = 0; c < 8; ++c) { uint4 v = kptr[c];
        s += q[8*c] * bflo(v.x) + q[8*c+1] * bfhi(v.x) + q[8*c+2] * bflo(v.y) + q[8*c+3] * bfhi(v.y) + q[8*c+4] * bflo(v.z) + q[8*c+5] * bfhi(v.z) + q[8*c+6] * bflo(v.w) + q[8*c+7] * bfhi(v.w); }
      s *= 0.125f;
      if (MODE != 1) s -= slope * fabsf((float)off);
      const float mn = fmaxf(m, s); const float al = __expf(m - mn), pw = __expf(s - mn);
      m = mn; l = l * al + pw;
      const uint4* vptr = (const uint4*)(proj + (size_t)(seq_base + kp) * ld + voff + hk * 64);
#pragma unroll
      for (int c = 0; c < 8; ++c) { uint4 v = vptr[c];
        o[8*c] = o[8*c] * al + pw * bflo(v.x); o[8*c+1] = o[8*c+1] * al + pw * bfhi(v.x); o[8*c+2] = o[8*c+2] * al + pw * bflo(v.y); o[8*c+3] = o[8*c+3] * al + pw * bfhi(v.y);
        o[8*c+4] = o[8*c+4] * al + pw * bflo(v.z); o[8*c+5] = o[8*c+5] * al + pw * bfhi(v.z); o[8*c+6] = o[8*c+6] * al + pw * bflo(v.w); o[8*c+7] = o[8*c+7] * al + pw * bfhi(v.w); }
    }
    const float inv = 1.f / l;
    uint4* op = (uint4*)(cat + (size_t)t * DM + cat_off + head * 64);
#pragma unroll
    for (int c = 0; c < 8; ++c) { uint4 v; v.x = pack2(o[8*c] * inv, o[8*c+1] * inv); v.y = pack2(o[8*c+2] * inv, o[8*c+3] * inv); v.z = pack2(o[8*c+4] * inv, o[8*c+5] * inv); v.w = pack2(o[8*c+6] * inv, o[8*c+7] * inv); op[c] = v; }
  }
}

typedef short s16x4 __attribute__((ext_vector_type(4)));
typedef __attribute__((address_space(3))) s16x4* lds_s16x4_ptr;
DI s16x4 vtr(const char* p) { return __builtin_amdgcn_ds_read_tr16_b64_v4i16((lds_s16x4_ptr)p); }

template <int MODE, int NQ>
DI void attn_unit(const bf16_t* __restrict__ proj, int ld, int seq_base, int kt0, int kt1, int koff, int voff,
                  int q0w, int qoff, int ooff, float slope2, float sink2, bf16_t* __restrict__ cat, char* lds) {
  OPAQUE_TID(tid);
  const int lane = tid & 63, wave = tid >> 6, r32 = lane & 31, hh = lane >> 5;
  constexpr float C2 = 0.125f * LOG2E;
  constexpr int NS = 6;
  bf16x8 qf[NQ][4];
#pragma unroll
  for (int nq = 0; nq < NQ; ++nq) { const bf16_t* qp = proj + (size_t)(seq_base + q0w + 32 * nq + r32) * ld + qoff + hh * 8;
#pragma unroll
    for (int ks = 0; ks < 4; ++ks) qf[nq][ks] = *(const bf16x8*)(qp + ks * 16); }
  f32x16 o[NQ][2];
  float m2[NQ], l[NQ];
#pragma unroll
  for (int nq = 0; nq < NQ; ++nq) { m2[nq] = (MODE == 2) ? sink2 : -1e30f; l[nq] = 0.f;
#pragma unroll
    for (int r = 0; r < 16; ++r) { o[nq][0][r] = 0.f; o[nq][1][r] = 0.f; } }
  PG8_LAS unsigned char* L = (PG8_LAS unsigned char*)lds;
  const bf16_t* kg = proj + (size_t)(seq_base + lane) * ld + koff + wave * 8;
  const bf16_t* vg = proj + (size_t)(seq_base + (wave & 3) * 16 + (lane >> 2)) * ld + voff + ((wave >> 2) * 4 + (lane & 3)) * 8;
  const unsigned sdst = (unsigned)__builtin_amdgcn_readfirstlane(wave * 1024);
#define ATT_ISSUE(tile, slot) do { const size_t go_ = (size_t)(tile) * 64 * ld; \
    __builtin_amdgcn_global_load_lds((const unsigned*)(kg + go_), (PG8_LAS unsigned*)(L + (slot) * 16384 + sdst), 16, 0, 0); \
    __builtin_amdgcn_global_load_lds((const unsigned*)(vg + go_), (PG8_LAS unsigned*)(L + (slot) * 16384 + 8192 + sdst), 16, 0, 0); } while (0)
  const int ktl = kt1 - 1;
  constexpr int TAB_OFF = 6 * 16384, TAB_N = 2560, TAB_ZERO = 1280;
  if (MODE == 0) {
    float* tab = (float*)(lds + TAB_OFF);
    for (int e = tid; e < TAB_N; e += 512) {
      const int oo = e - TAB_ZERO, aa = oo < 0 ? -oo : oo;
      const int c = (aa <= 64 ? 1 : 0) + (((oo & 3) == 0 && aa <= 256) ? 1 : 0) + (((oo & 15) == 0 && aa <= 1024) ? 1 : 0);
      tab[e] = c ? (-slope2 * (float)aa + (c == 1 ? 0.f : (c == 2 ? 1.f : 1.5849625007f))) : -1e30f;
    }
  }
  if (MODE == 2) {
    float* tab = (float*)(lds + TAB_OFF) + (wave & 3) * 384;
#pragma unroll
    for (int i = 0; i < 3; ++i) { const int e = (wave >> 2) * 64 + lane + 128 * i; const int oo = e - 192, aa = oo < 0 ? -oo : oo; tab[e] = (aa <= 128) ? -slope2 * (float)aa : -1e30f; }
  }
  ATT_ISSUE(kt0, 0); ATT_ISSUE((kt0 + 1 < ktl ? kt0 + 1 : ktl), 1); ATT_ISSUE((kt0 + 2 < ktl ? kt0 + 2 : ktl), 2); ATT_ISSUE((kt0 + 3 < ktl ? kt0 + 3 : ktl), 3);
  asm volatile("s_waitcnt vmcnt(6) lgkmcnt(0)\n\ts_barrier" ::: "memory");
  const int kfo = hh * 1024 + r32 * 16;
  const int vfo = 8192 + (4 * hh + ((lane & 15) >> 2)) * 64 + ((lane >> 4) & 1) * 32 + (lane & 3) * 8;
  const bool g2 = wave >= 4;
  f32x16 s[NQ][2];
  bf16x8 pf[NQ][4];
  auto tile_active = [&](int kt) -> bool { return (MODE != 0) || ((kt * 64 + 63 >= q0w - 1024) && (kt * 64 <= q0w + 32 * NQ - 1 + 1024)); };
  auto QK = [&](int slot) {
    const char* kb_ = lds + slot * 16384 + kfo;
#pragma unroll
    for (int nq = 0; nq < NQ; ++nq)
#pragma unroll
      for (int r = 0; r < 16; ++r) { s[nq][0][r] = 0.f; s[nq][1][r] = 0.f; }
#pragma unroll
    for (int ks = 0; ks < 4; ++ks) {
      const bf16x8 k0 = *(const bf16x8*)(kb_ + ks * 2048), k1 = *(const bf16x8*)(kb_ + ks * 2048 + 512);
#pragma unroll
      for (int nq = 0; nq < NQ; ++nq) { s[nq][0] = MFMA32(k0, qf[nq][ks], s[nq][0]); s[nq][1] = MFMA32(k1, qf[nq][ks], s[nq][1]); }
    }
  };
  auto SM = [&](int kt) {
#pragma unroll
    for (int nq = 0; nq < NQ; ++nq) {
      f32x16& s0 = s[nq][0]; f32x16& s1 = s[nq][1];
      float mx = -1e30f;
      if (MODE == 1) {
      } else if (MODE == 0) {
        const float* tb = (const float*)(lds + TAB_OFF) + (kt * 64 + 4 * hh - (q0w + 32 * nq + r32) + TAB_ZERO);
#pragma unroll
        for (int r = 0; r < 16; ++r) {
          const float va = fmaf(s0[r], C2, tb[(r & 3) + 8 * (r >> 2)]), vb = fmaf(s1[r], C2, tb[(r & 3) + 8 * (r >> 2) + 32]);
          s0[r] = va; s1[r] = vb; mx = fmaxf(mx, fmaxf(va, vb));
        }
      } else {
        const float* tb = (const float*)(lds + TAB_OFF) + (wave & 3) * 384 + (kt * 64 + 4 * hh - (q0w + 32 * nq + r32) + 192);
#pragma unroll
        for (int r = 0; r < 16; ++r) {
          const float va = fmaf(s0[r], C2, tb[(r & 3) + 8 * (r >> 2)]), vb = fmaf(s1[r], C2, tb[(r & 3) + 8 * (r >> 2) + 32]);
          s0[r] = va; s1[r] = vb; mx = fmaxf(mx, fmaxf(va, vb));
        }
      }
      float mn;
      if (MODE == 1) {
        mn = sink2;
      } else {
        mx = fmaxf(mx, __shfl_xor(mx, 32));
        mn = fmaxf(m2[nq], mx);
        if (__any(mn > m2[nq])) {
          const float alpha = __builtin_amdgcn_exp2f(m2[nq] - mn);
          l[nq] *= alpha;
#pragma unroll
          for (int r = 0; r < 16; ++r) { o[nq][0][r] *= alpha; o[nq][1][r] *= alpha; }
        }
        m2[nq] = mn;
      }
      float ls = 0.f;
#pragma unroll
      for (int r = 0; r < 16; ++r) {
        float pa, pb;
        if (MODE == 1) { pa = __builtin_amdgcn_exp2f(fmaf(s0[r], C2, -mn)); pb = __builtin_amdgcn_exp2f(fmaf(s1[r], C2, -mn)); }
        else { pa = __builtin_amdgcn_exp2f(s0[r] - mn); pb = __builtin_amdgcn_exp2f(s1[r] - mn); }
        s0[r] = pa; s1[r] = pb; ls += pa + pb;
      }
      l[nq] += ls;
#pragma unroll
      for (int ks = 0; ks < 4; ++ks) {
        uint4 t4;
        const int rb = 8 * (ks & 1);
        if (ks < 2) { t4.x = pack2(s0[rb], s0[rb + 1]); t4.y = pack2(s0[rb + 2], s0[rb + 3]); t4.z = pack2(s0[rb + 4], s0[rb + 5]); t4.w = pack2(s0[rb + 6], s0[rb + 7]); }
        else { t4.x = pack2(s1[rb], s1[rb + 1]); t4.y = pack2(s1[rb + 2], s1[rb + 3]); t4.z = pack2(s1[rb + 4], s1[rb + 5]); t4.w = pack2(s1[rb + 6], s1[rb + 7]); }
        pf[nq][ks] = __builtin_bit_cast(bf16x8, t4);
      }
    }
  };
  auto PV = [&](int slot) {
    const char* vb_ = lds + slot * 16384 + vfo;
#pragma unroll
    for (int ks = 0; ks < 4; ++ks) {
      const s16x4 a0 = vtr(vb_ + ks * 1024), a1 = vtr(vb_ + ks * 1024 + 512);
      const s16x4 b0 = vtr(vb_ + 4096 + ks * 1024), b1 = vtr(vb_ + 4096 + ks * 1024 + 512);
      const bf16x8 v0 = __builtin_shufflevector(a0, a1, 0, 1, 2, 3, 4, 5, 6, 7);
      const bf16x8 v1 = __builtin_shufflevector(b0, b1, 0, 1, 2, 3, 4, 5, 6, 7);
#pragma unroll
      for (int nq = 0; nq < NQ; ++nq) { o[nq][0] = MFMA32(v0, pf[nq][ks], o[nq][0]); o[nq][1] = MFMA32(v1, pf[nq][ks], o[nq][1]); }
    }
  };
  int slot = 0, sp = 0;
  for (int kt = kt0; kt < kt1; ++kt) {
    { const int tn = (kt + 4 < ktl) ? kt + 4 : ktl; int s4 = slot + 4; if (s4 >= NS) s4 -= NS; ATT_ISSUE(tn, s4); }
    const bool act = tile_active(kt);
    if (!g2) {
      if (act) { QK(slot); SM(kt); PV(slot); }
    } else {
      if (kt > kt0 && tile_active(kt - 1)) PV(sp);
      if (act) { QK(slot); SM(kt); }
    }
    asm volatile("s_waitcnt vmcnt(6) lgkmcnt(0)\n\ts_barrier" ::: "memory");
    sp = slot; slot = (slot + 1 == NS) ? 0 : slot + 1;
  }
  if (g2 && tile_active(ktl)) PV(sp);
  asm volatile("s_waitcnt vmcnt(0)\n\ts_barrier" ::: "memory");
#undef ATT_ISSUE
#pragma unroll
  for (int nq = 0; nq < NQ; ++nq) {
    float lt = l[nq] + __shfl_xor(l[nq], 32);
    if (MODE == 2) lt += __builtin_amdgcn_exp2f(sink2 - m2[nq]);
    const float inv = 1.f / lt;
    bf16_t* op = cat + (size_t)(seq_base + q0w + 32 * nq + r32) * DM + ooff + 4 * hh;
#pragma unroll
    for (int g = 0; g < 4; ++g) {
      uint2 a, b;
      a.x = pack2(o[nq][0][4 * g] * inv, o[nq][0][4 * g + 1] * inv); a.y = pack2(o[nq][0][4 * g + 2] * inv, o[nq][0][4 * g + 3] * inv);
      b.x = pack2(o[nq][1][4 * g] * inv, o[nq][1][4 * g + 1] * inv); b.y = pack2(o[nq][1][4 * g + 2] * inv, o[nq][1][4 * g + 3] * inv);
      *(uint2*)(op + 8 * g) = a; *(uint2*)(op + 32 + 8 * g) = b;
    }
  }
}

DI void attn_phase_l0(const Params& p, char* lds) {
  OPAQUE_TID(tid0);
  const int wave = tid0 >> 6;
  float mref;
  { float gq = fabsf(p.ab_qg[tid0 & 63]), gk = fabsf(p.ab_kg[tid0 & 63]);
#pragma unroll
    for (int o = 32; o > 0; o >>= 1) { gq = fmaxf(gq, __shfl_xor(gq, o)); gk = fmaxf(gk, __shfl_xor(gk, o)); }
    mref = 8.f * gq * gk * LOG2E; }
  for (int u = blockIdx.x; u < 1536; u += gridDim.x) {
    if (u < 512) {
      int seq_base, T, kvh, qt;
      if (u < 256) { seq_base = 0; T = PROMPT_T; kvh = u >> 7; qt = u & 127; }
      else { const int v = u - 256; seq_base = PROMPT_T + (v >> 6) * SAMPLE_T; T = SAMPLE_T; kvh = (v >> 5) & 1; qt = v & 31; }
      const int head = kvh * 4 + (wave & 3);
      attn_unit<1, 2>(p.big, 2304, seq_base, 0, T >> 6, 2048 + kvh * 64, 2176 + kvh * 64, qt * 128 + (wave >> 2) * 64, 1536 + head * 64, 512 + head * 64, 0.f, mref, p.xn, lds);
    } else {
      const int v = u - 512, head = v >> 7, tok0 = (v & 127) * 256;
      const int seq_base = (tok0 < PROMPT_T) ? 0 : (PROMPT_T + ((tok0 - PROMPT_T) / SAMPLE_T) * SAMPLE_T);
      const int T = (tok0 < PROMPT_T) ? PROMPT_T : SAMPLE_T;
      const int q0b = tok0 - seq_base;
      int kt0 = (q0b - 1024) >> 6; if (kt0 < 0) kt0 = 0;
      int kt1 = ((q0b + 255 + 1024) >> 6) + 1; if (kt1 > (T >> 6)) kt1 = T >> 6;
      attn_unit<0, 1>(p.big, 2304, seq_base, kt0, kt1, 512 + head * 64, 1024 + head * 64, q0b + wave * 32, head * 64, head * 64,
                   exp2f(-(float)(head + 1)) * LOG2E, 0.f, p.xn, lds);
    }
  }
}

DI void attn_phase_l1(const Params& p, char* lds) {
  OPAQUE_TID(tid0);
  const int wave = tid0 >> 6;
  for (int u = blockIdx.x; u < 2048; u += gridDim.x) {
    const int kvh = u >> 9, tok0 = (u & 511) * 64;
    const int seq_base = (tok0 < PROMPT_T) ? 0 : (PROMPT_T + ((tok0 - PROMPT_T) / SAMPLE_T) * SAMPLE_T);
    const int T = (tok0 < PROMPT_T) ? PROMPT_T : SAMPLE_T;
    const int q0 = tok0 - seq_base, head = kvh * 4 + (wave & 3);
    int kt0 = (q0 - 128) >> 6; if (kt0 < 0) kt0 = 0;
    int kt1 = ((q0 + 63 + 128) >> 6) + 1; if (kt1 > (T >> 6)) kt1 = T >> 6;
    attn_unit<2, 1>(p.big, 1536, seq_base, kt0, kt1, 1024 + kvh * 64, 1280 + kvh * 64, q0 + (wave >> 2) * 32, head * 64, head * 64,
                 exp2f(-0.5f * (float)(head + 1)) * LOG2E, p.c_sink[head] * LOG2E, p.xn, lds);
  }
}

#define XB_TMO      128
#define XB_XCNT(j)  (256  + 64 * (j))
#define XB_XSUB(j)  (1280 + 64 * (j))
#define XB_XGEN(j)  (2304 + 64 * (j))
#define XB_TOP      3328
#define XB_TOPGEN   3392
#define XCD_BAR_WORDS 3456
#define XB_SPIN_CAP (1u << 22)
DI unsigned xb_ld(unsigned* p) { return __hip_atomic_load(p, __ATOMIC_RELAXED, __HIP_MEMORY_SCOPE_AGENT); }
DI unsigned xb_add(unsigned* p, unsigned v) { return __hip_atomic_fetch_add(p, v, __ATOMIC_RELAXED, __HIP_MEMORY_SCOPE_AGENT); }
DI unsigned xb_xcc_id() { return (unsigned)__builtin_amdgcn_s_getreg((3 << 11) | 20) & 0xFu; }
#define XB_SPIN(cond, bar) do { unsigned _sp = 0; while (cond) { __builtin_amdgcn_s_sleep(1); \
    if ((++_sp & 255u) == 0u) { if (xb_ld(&(bar)[XB_TMO])) break; if (_sp > XB_SPIN_CAP) { atomicAdd(&(bar)[XB_TMO], 1u); break; } } } } while (0)
struct XcdBarrier { unsigned* bar; unsigned x; volatile unsigned* st; };
DI void xcd_barrier_complete(unsigned* bar, unsigned x, unsigned& nloc, unsigned& nx) {
  const unsigned G = gridDim.x;
  unsigned sum, cnt, mine, sp = 0u;
  for (;;) {
    sum = 0u; cnt = 0u; mine = 0u;
#pragma unroll
    for (unsigned j = 0; j < 16; ++j) { const unsigned c = xb_ld(&bar[XB_XCNT(j)]); sum += c; cnt += (c > 0u) ? 1u : 0u; mine = (j == x) ? c : mine; }
    if (sum == G) break;
    __builtin_amdgcn_s_sleep(1);
    if ((++sp & 255u) == 0u) { if (xb_ld(&bar[XB_TMO])) break; if (sp > XB_SPIN_CAP) { atomicAdd(&bar[XB_TMO], 1u); break; } }
  }
  nloc = mine > 0u ? mine : 1u; nx = cnt > 0u ? cnt : 1u;
}
DI void xcd_barrier(const XcdBarrier& b) {
  asm volatile("s_waitcnt vmcnt(0)" ::: "memory");
  __syncthreads();
  if (threadIdx.x == 0) {
    unsigned* bar = b.bar;
    __builtin_amdgcn_s_waitcnt(0);
    unsigned nloc = b.st[0], nx = b.st[1];
    if (nloc == 0u) { xcd_barrier_complete(bar, b.x, nloc, nx); b.st[0] = nloc; b.st[1] = nx; }
    const unsigned old = xb_add(&bar[XB_XSUB(b.x)], 1u);
    const unsigned gen = old / nloc;
    if (old + 1u == (gen + 1u) * nloc) {
      __builtin_amdgcn_fence(__ATOMIC_RELEASE, "agent");
      asm volatile("s_waitcnt vmcnt(0)" ::: "memory");
      const unsigned og = xb_add(&bar[XB_TOP], 1u);
      const unsigned tg = og / nx;
      if (og + 1u == (tg + 1u) * nx) xb_add(&bar[XB_TOPGEN], 1u);
      else XB_SPIN(xb_ld(&bar[XB_TOPGEN]) == tg, bar);
      __builtin_amdgcn_fence(__ATOMIC_ACQUIRE, "agent");
      xb_add(&bar[XB_XGEN(b.x)], 1u);
      asm volatile("s_waitcnt vmcnt(0)" ::: "memory");
    } else {
      XB_SPIN(xb_ld(&bar[XB_XGEN(b.x)]) == gen, bar);
      __builtin_amdgcn_fence(__ATOMIC_ACQUIRE, "agent");
      asm volatile("s_waitcnt vmcnt(0)" ::: "memory");
    }
  }
  __syncthreads();
}

__global__ void __launch_bounds__(512) fwd_megakernel(Params p) {
  cg::grid_group grid = cg::this_grid();
  __shared__ __attribute__((aligned(1024))) char lds[2 * STAGE_B + 16];
  volatile unsigned* bst = (volatile unsigned*)(lds + 2 * STAGE_B);
  if (threadIdx.x < 2) bst[threadIdx.x] = 0u;
  __syncthreads();
  XcdBarrier xb; xb.bar = p.bar; xb.x = xb_xcc_id(); xb.st = bst;
  if (threadIdx.x == 0) (void)xb_add(&p.bar[XB_XCNT(xb.x)], 1u);
  convert_phase(p, 0, (float*)lds);
  norm_phase(p, 0, p.norm_g);
  grid.sync();
  for (int layer = 0; layer < 2; ++layer) {
    for (int f = 0; f < 2; ++f) {
      if (f == 1) {
        if (layer == 0) gemm_phase(p.xn, p.wts + W_IN, NTOK, 2304, DM, EpiProj{p.big, 2304}, lds);
        else gemm_phase(p.xn, p.wts + W_IN, NTOK, 1536, DM, EpiProj{p.big, 1536}, lds);
        xcd_barrier(xb);
        if (layer == 0) {
          bprep_phase(p);
          xcd_barrier(xb);
          attn_phase_l0(p, lds);
        } else {
          attn_phase_l1(p, lds);
        }
        xcd_barrier(xb);
        gemm_phase(p.xn, p.wts + W_OUT, NTOK, DM, DM, EpiResid{p.h, 1.0f}, lds);
        xcd_barrier(xb);
        norm_phase(p, 1, p.norm_g + (layer * 3 + 2) * DM);
        xcd_barrier(xb);
      }
      const int rows = NTOK / p.ffn_chunks;
      for (int c = 0; c < p.ffn_chunks; ++c) {
        gemm_phase(p.xn + (size_t)c * rows * DM, p.wts + (f ? W_UPB : W_UPA), rows, 2 * DFF, DM, EpiUp{p.big}, lds);
        xcd_barrier(xb);
        gemm_phase(p.big, p.wts + (f ? W_DNB : W_DNA), rows, DM, DFF, EpiResid{p.h + (size_t)c * rows * DM, 0.5f}, lds);
        xcd_barrier(xb);
      }
      if (f == 0) { norm_phase(p, 1, p.norm_g + (layer * 3 + 1) * DM); xcd_barrier(xb); }
    }
    if (layer == 0) { convert_phase(p, 1, (float*)lds); norm_phase(p, 1, p.norm_g + 3 * DM); xcd_barrier(xb); }
  }
  norm_phase(p, 2, p.final_g);
}

extern "C" void kernel_launch(void* const* d_in, const int* in_sizes, int n_in, void* d_out, int out_size, void* d_ws, size_t ws_size, hipStream_t stream) {
  static int grid_blocks = 0;
  if (!grid_blocks) {
    int dev = 0, cus = 0, per_cu = 0;
    hipGetDevice(&dev);
    hipDeviceGetAttribute(&cus, hipDeviceAttributeMultiprocessorCount, dev);
    hipOccupancyMaxActiveBlocksPerMultiprocessor(&per_cu, fwd_megakernel, 512, 0);
    if (per_cu > 1) per_cu = 1;
    if (per_cu < 1) per_cu = 1;
    grid_blocks = cus * per_cu;
  }
  Params p{};
  p.x_prompt = (const float*)d_in[0]; p.x_sample = (const float*)d_in[1]; p.norm_g = (const float*)d_in[2];
  p.w1 = (const float*)d_in[3]; p.w3 = (const float*)d_in[4]; p.w2 = (const float*)d_in[5];
  p.ab_w_in = (const float*)d_in[6]; p.ab_w_out = (const float*)d_in[7]; p.ab_qg = (const float*)d_in[8]; p.ab_kg = (const float*)d_in[9];
  p.c_w_in = (const float*)d_in[10]; p.c_w_out = (const float*)d_in[11]; p.c_sink = (const float*)d_in[12]; p.final_g = (const float*)d_in[13];
  p.h = (float*)d_out;
  char* ws = (char*)d_ws;
  const size_t MiB = 1024 * 1024;
  p.wts = (bf16_t*)ws;
  p.xn = (bf16_t*)(ws + 40 * MiB);
  p.big = (bf16_t*)(ws + 104 * MiB);
  p.bar = (unsigned*)(ws + 280 * MiB);
  p.ffn_chunks = (ws_size >= 280 * MiB + 65536) ? 1 : 2;
  if (p.ffn_chunks == 2) p.bar = (unsigned*)(ws + 250 * MiB);
  hipMemsetAsync(p.bar, 0, XCD_BAR_WORDS * sizeof(unsigned), stream);
  p.pad = 0;
  void* args[] = {&p};
  hipError_t e = hipLaunchCooperativeKernel((void*)fwd_megakernel, dim3(grid_blocks), dim3(512), args, 0, stream);
  if (e != hipSuccess) fprintf(stderr, "cooperative launch failed: %s (grid %d)\n", hipGetErrorString(e), grid_blocks);
}
```

```cpp
#include <hip/hip_runtime.h>
#include <hip/hip_cooperative_groups.h>
#include <cstdio>
namespace cg = cooperative_groups;

typedef unsigned short bf16_t;
typedef short bf16x8 __attribute__((ext_vector_type(8)));
typedef float f32x16 __attribute__((ext_vector_type(16)));
#define DI __device__ __forceinline__
#define OPAQUE_TID(v) int v = threadIdx.x; asm volatile("" : "+v"(v))
#define MFMA32(a, b, c) __builtin_amdgcn_mfma_f32_32x32x16_bf16((a), (b), (c), 0, 0, 0)

constexpr int NTOK = 32768, DM = 1024, DFF = 2816;
constexpr int PROMPT_T = 16384, SAMPLE_T = 4096;
constexpr float EPS = 1e-6f;
constexpr float LOG2E = 1.4426950408889634f;

constexpr size_t W_UPA = 0, W_DNA = 5767168, W_UPB = 8650752, W_DNB = 14417920, W_IN = 17301504, W_OUT = 19660800, W_TOTAL = 20709376;

struct Params {
  const float* x_prompt; const float* x_sample; const float* norm_g; const float* w1; const float* w3; const float* w2;
  const float* ab_w_in; const float* ab_w_out; const float* ab_qg; const float* ab_kg;
  const float* c_w_in; const float* c_w_out; const float* c_sink; const float* final_g;
  float* h; bf16_t* wts; bf16_t* xn; bf16_t* big; unsigned* bar; float* ssq; bf16_t* h16;
  int ffn_chunks; int pad;
};

DI bf16_t f2bf(float x) { unsigned u = __float_as_uint(x); u += 0x7fffu + ((u >> 16) & 1u); return (bf16_t)(u >> 16); }
DI float bf2f(bf16_t v) { return __uint_as_float(((unsigned)v) << 16); }
DI float bflo(unsigned u) { return __uint_as_float(u << 16); }
DI float bfhi(unsigned u) { return __uint_as_float(u & 0xffff0000u); }
typedef __bf16 bf16x2_t __attribute__((ext_vector_type(2)));
typedef float f32x2_t __attribute__((ext_vector_type(2)));
DI unsigned pack2(float lo, float hi) { f32x2_t v = {lo, hi}; return __builtin_bit_cast(unsigned, __builtin_convertvector(v, bf16x2_t)); }
DI int crow(int reg, int h) { return (reg & 3) + 8 * (reg >> 2) + 4 * h; }

DI void convert_tile(const float* __restrict__ src, int K, int N, int kt, int nt, bf16_t* __restrict__ dst, int mode, const float* __restrict__ g, float* lds) {
  OPAQUE_TID(tid);
#pragma unroll 4
  for (int i = 0; i < 8; ++i) { int e = tid + 512 * i; int kk = e >> 6, nn = e & 63; lds[kk * 65 + nn] = src[(size_t)(kt * 64 + kk) * N + nt * 64 + nn] * (g ? g[kt * 64 + kk] : 1.f); }
  __syncthreads();
  { const int nn = tid >> 3, kc = tid & 7, n = nt * 64 + nn;
    const int drow = (mode == 0) ? n : ((n >> 7) * 256 + (n & 127) + (mode == 2 ? 128 : 0));
    const float* lp = lds + kc * 8 * 65 + nn;
    uint4 v; v.x = pack2(lp[0], lp[65]); v.y = pack2(lp[130], lp[195]); v.z = pack2(lp[260], lp[325]); v.w = pack2(lp[390], lp[455]);
    *(uint4*)(dst + (size_t)drow * K + kt * 64 + kc * 8) = v; }
  __syncthreads();
}

DI void convert_phase(const Params& p, int layer, float* lds) {
  const int n_in = (layer == 0) ? 2304 : 1536;
  const int t_up = 16 * 44, t_dn = 44 * 16, t_in = 16 * (n_in / 64), t_out = 16 * 16;
  const int total = 4 * t_up + 2 * t_dn + t_in + t_out;
  for (int u = blockIdx.x; u < total; u += gridDim.x) {
    int r = u; const float* src; bf16_t* dst; int K, N, mode; const float* g = nullptr;
    if (r < 6 * t_up) {
      int mtx = r / t_up; r -= mtx * t_up; int f = mtx / 3, which = mtx % 3;
      size_t base = (size_t)(layer * 2 + f) * DM * DFF;
      if (which == 0) { src = p.w1 + base; K = DM; N = DFF; mode = 1; dst = p.wts + (f ? W_UPB : W_UPA); g = p.norm_g + (layer * 3 + (f ? 2 : 0)) * DM; }
      else if (which == 1) { src = p.w3 + base; K = DM; N = DFF; mode = 2; dst = p.wts + (f ? W_UPB : W_UPA); g = p.norm_g + (layer * 3 + (f ? 2 : 0)) * DM; }
      else { src = p.w2 + base; K = DFF; N = DM; mode = 0; dst = p.wts + (f ? W_DNB : W_DNA); }
    } else if (r < 6 * t_up + t_in) {
      r -= 6 * t_up; src = (layer == 0) ? p.ab_w_in : p.c_w_in; K = DM; N = n_in; mode = 0; dst = p.wts + W_IN; g = p.norm_g + (layer * 3 + 1) * DM;
    } else {
      r -= 6 * t_up + t_in; src = (layer == 0) ? p.ab_w_out : p.c_w_out; K = DM; N = DM; mode = 0; dst = p.wts + W_OUT;
    }
    const int ntn = N / 64; const int kt = r / ntn, nt = r % ntn;
    convert_tile(src, K, N, kt, nt, dst, mode, g, lds);
  }
}

DI void init_phase(const Params& p) {
  OPAQUE_TID(tid);
  const int lane = tid & 63, wave = tid >> 6;
  for (int row = blockIdx.x * 8 + wave; row < NTOK; row += gridDim.x * 8) {
    const float* src = (row < PROMPT_T) ? p.x_prompt + (size_t)row * DM : p.x_sample + (size_t)(row - PROMPT_T) * DM;
    float ss = 0.f;
#pragma unroll
    for (int i = 0; i < 4; ++i) { const float4 v = *(const float4*)(src + lane * 4 + 256 * i); ss += v.x * v.x + v.y * v.y + v.z * v.z + v.w * v.w;
      uint2 o2; o2.x = pack2(v.x, v.y); o2.y = pack2(v.z, v.w); *(uint2*)(p.h16 + (size_t)row * DM + lane * 4 + 256 * i) = o2; }
#pragma unroll
    for (int o = 32; o > 0; o >>= 1) ss += __shfl_xor(ss, o);
    if (lane < 16) p.ssq[(size_t)row * 16 + lane] = (lane == 0) ? ss : 0.f;
  }
}
DI void final_norm_phase(const Params& p) {
  OPAQUE_TID(tid);
  const int lane = tid & 63, wave = tid >> 6;
  float4 gv[4];
#pragma unroll
  for (int i = 0; i < 4; ++i) gv[i] = *(const float4*)(p.final_g + lane * 4 + 256 * i);
  for (int row = blockIdx.x * 8 + wave; row < NTOK; row += gridDim.x * 8) {
    float4 v[4]; float ss = 0.f;
#pragma unroll
    for (int i = 0; i < 4; ++i) { const uint2 u = *(const uint2*)(p.xn + (size_t)row * DM + lane * 4 + 256 * i);
      v[i].x = bflo(u.x); v[i].y = bfhi(u.x); v[i].z = bflo(u.y); v[i].w = bfhi(u.y); ss += v[i].x * v[i].x + v[i].y * v[i].y + v[i].z * v[i].z + v[i].w * v[i].w; }
#pragma unroll
    for (int o = 32; o > 0; o >>= 1) ss += __shfl_xor(ss, o);
    const float r = rsqrtf(ss * (1.0f / DM) + EPS);
#pragma unroll
    for (int i = 0; i < 4; ++i) { float4 y; y.x = v[i].x * r * gv[i].x; y.y = v[i].y * r * gv[i].y; y.z = v[i].z * r * gv[i].z; y.w = v[i].w * r * gv[i].w;
      *(float4*)(p.h + (size_t)row * DM + lane * 4 + 256 * i) = y; }
  }
}

typedef float f32x4 __attribute__((ext_vector_type(4)));
typedef unsigned u32x4 __attribute__((ext_vector_type(4)));
#define PG8_LAS __attribute__((address_space(3)))
constexpr int BM = 256, BK = 64, HALF = 128, HTB = HALF * BK * 2, STAGE_B = 4 * HTB, NXCD = 8, WGM = 8;
DI int lds_byte(int r, int c) { const int st = (r >> 4) * 2 + (c >> 5), rr = r & 15, cc = c & 31, ob = rr * 64 + cc * 2; return st * 1024 + (ob ^ (((ob >> 9) & 1) << 5)); }
DI void stage_rc(int b, int& R, int& C) { const int st = b / 1024, sb = b % 1024, swz = sb ^ (((sb >> 9) & 1) << 5); R = (st >> 1) * 16 + swz / 64; C = (st & 1) * 32 + (swz % 64) / 2; }
DI int perm32(int rho) { const int n = rho >> 4, i = rho & 15; return 8 * (i >> 2) + 4 * n + (i & 3); }
struct Unit { int pm, pn; };
struct StaticOrder {
  int nM, nN, nwg, G, c;
  DI void init(int M, int N, int G_, int c_) { nM = M / BM; nN = N / BM; nwg = nM * nN; G = G_; c = c_; }
  DI bool next(int i, Unit& u) const {
    const long L = (long)i * G + c; if (L >= nwg) return false;
    int wgid = (int)L; { const int q = nwg / NXCD, r = nwg % NXCD, xcd = wgid % NXCD, off = wgid / NXCD; wgid = (xcd < r ? xcd * (q + 1) : r * (q + 1) + (xcd - r) * q) + off; }
    const int nig = WGM * nN, gid = wgid / nig, fm = gid * WGM, gsz = (nM - fm) < WGM ? (nM - fm) : WGM;
    u.pm = fm + ((wgid % nig) % gsz); u.pn = (wgid % nig) / gsz; return true;
  }
};
constexpr int RT_OFF = 8 * HTB + 64;
DI void acc_zero(f32x4 (&acc)[2][2][4][2]) {
#pragma unroll
  for (int a = 0; a < 2; ++a)
#pragma unroll
    for (int b = 0; b < 2; ++b)
#pragma unroll
      for (int m = 0; m < 4; ++m)
#pragma unroll
        for (int n = 0; n < 2; ++n) acc[a][b][m][n] = (f32x4){0.f, 0.f, 0.f, 0.f};
}
struct EpiProj {
  static constexpr bool PERM = true, NEEDS_R = true;
  bf16_t* O; int ldc; const float* ssq;
  DI void init(f32x4 (&acc)[2][2][4][2], const Unit&, int, int, int, int) const { acc_zero(acc); }
  DI void operator()(const f32x4 (&acc)[2][2][4][2], const Unit& u, int wr, int wc, int fr, int fq, const PG8_LAS float* rt) const {
    const int row0 = u.pm * BM + wr * 64 + fr, col0 = u.pn * BM + wc * 32 + 8 * fq;
#pragma unroll
    for (int ai = 0; ai < 2; ++ai)
#pragma unroll
      for (int m = 0; m < 4; ++m) { bf16_t* rowp = O + (size_t)(row0 + ai * HALF + m * 16) * ldc + col0; const float r = rt[ai * HALF + wr * 64 + m * 16 + fr];
#pragma unroll
        for (int bj = 0; bj < 2; ++bj) { const f32x4 v0 = acc[ai][bj][m][0] * r, v1 = acc[ai][bj][m][1] * r;
          u32x4 w; w.x = pack2(v0[0], v0[1]); w.y = pack2(v0[2], v0[3]); w.z = pack2(v1[0], v1[1]); w.w = pack2(v1[2], v1[3]);
          *(u32x4*)(rowp + bj * HALF) = w; } }
  }
};
struct EpiUp {
  static constexpr bool PERM = true, NEEDS_R = true;
  bf16_t* O; const float* ssq;
  DI void init(f32x4 (&acc)[2][2][4][2], const Unit&, int, int, int, int) const { acc_zero(acc); }
  DI void operator()(const f32x4 (&acc)[2][2][4][2], const Unit& u, int wr, int wc, int fr, int fq, const PG8_LAS float* rt) const {
    const int row0 = u.pm * BM + wr * 64 + fr, col0 = u.pn * HALF + wc * 32 + 8 * fq;
#pragma unroll
    for (int ai = 0; ai < 2; ++ai)
#pragma unroll
      for (int m = 0; m < 4; ++m) {
        const float r = rt[ai * HALF + wr * 64 + m * 16 + fr];
        float a[8];
#pragma unroll
        for (int n = 0; n < 2; ++n)
#pragma unroll
          for (int j = 0; j < 4; ++j) { const float u1 = acc[ai][0][m][n][j] * r, u3 = acc[ai][1][m][n][j] * r; a[4 * n + j] = u1 * u3 * __builtin_amdgcn_rcpf(1.f + __builtin_amdgcn_exp2f(-LOG2E * u1)); }
        u32x4 w; w.x = pack2(a[0], a[1]); w.y = pack2(a[2], a[3]); w.z = pack2(a[4], a[5]); w.w = pack2(a[6], a[7]);
        *(u32x4*)(O + (size_t)(row0 + ai * HALF + m * 16) * DFF + col0) = w; }
  }
};
struct EpiResid {
  static constexpr bool PERM = true, NEEDS_R = false;
  const bf16_t* src; bf16_t* dst; float coef; float* ssq;
  DI void init(f32x4 (&acc)[2][2][4][2], const Unit& u, int wr, int wc, int fr, int fq) const {
    const int row0 = u.pm * BM + wr * 64 + fr, col0 = u.pn * BM + wc * 32 + 8 * fq; const float ic = 1.f / coef;
#pragma unroll
    for (int ai = 0; ai < 2; ++ai)
#pragma unroll
      for (int m = 0; m < 4; ++m) { const bf16_t* rowp = src + (size_t)(row0 + ai * HALF + m * 16) * DM + col0;
#pragma unroll
        for (int bj = 0; bj < 2; ++bj) { const u32x4 w = *(const u32x4*)(rowp + bj * HALF);
          acc[ai][bj][m][0] = (f32x4){bflo(w.x), bfhi(w.x), bflo(w.y), bfhi(w.y)} * ic; acc[ai][bj][m][1] = (f32x4){bflo(w.z), bfhi(w.z), bflo(w.w), bfhi(w.w)} * ic; } }
  }
  DI void operator()(const f32x4 (&acc)[2][2][4][2], const Unit& u, int wr, int wc, int fr, int fq, const PG8_LAS float*) const {
    const int row0 = u.pm * BM + wr * 64 + fr, col0 = u.pn * BM + wc * 32 + 8 * fq;
#pragma unroll
    for (int ai = 0; ai < 2; ++ai)
#pragma unroll
      for (int m = 0; m < 4; ++m) { const int row = row0 + ai * HALF + m * 16; bf16_t* rowp = dst + (size_t)row * DM + col0; float ss = 0.f;
#pragma unroll
        for (int bj = 0; bj < 2; ++bj) { const f32x4 v0 = acc[ai][bj][m][0] * coef, v1 = acc[ai][bj][m][1] * coef;
          ss += v0[0] * v0[0] + v0[1] * v0[1] + v0[2] * v0[2] + v0[3] * v0[3] + v1[0] * v1[0] + v1[1] * v1[1] + v1[2] * v1[2] + v1[3] * v1[3];
          u32x4 w; w.x = pack2(v0[0], v0[1]); w.y = pack2(v0[2], v0[3]); w.z = pack2(v1[0], v1[1]); w.w = pack2(v1[2], v1[3]);
          *(u32x4*)(rowp + bj * HALF) = w; }
        ss += __shfl_xor(ss, 16); ss += __shfl_xor(ss, 32);
        if (fq == 0) ssq[(size_t)row * 16 + u.pn * 4 + wc] = ss; }
  }
};

template <class Epi>
DI void gemm_phase(const bf16_t* __restrict__ gA, const bf16_t* __restrict__ gBt, int M, int N, int K, const Epi& E, char* lds_generic) {
  PG8_LAS unsigned char* lds = (PG8_LAS unsigned char*)lds_generic;
  OPAQUE_TID(tid);
  const int wid = __builtin_amdgcn_readfirstlane(tid >> 6), lane = tid & 63, wr = wid >> 2, wc = wid & 3, fr = lane & 15, fq = lane >> 4;
  const int nt = K / BK;
  StaticOrder S; S.init(M, N, gridDim.x, blockIdx.x);
  unsigned voffA[2], voffB[2];
#pragma unroll
  for (int i = 0; i < 2; ++i) { int R, C; stage_rc(tid * 16 + i * 8192, R, C); const int Rb = Epi::PERM ? ((R & ~31) + perm32(R & 31)) : R;
    voffA[i] = (unsigned)(R * K + C) * 2u; voffB[i] = (unsigned)(Rb * K + C) * 2u; }
  const size_t kstep = (size_t)(BK * 2);
  const size_t hstep = (size_t)HALF * K * 2;
  const size_t tstep = 2 * hstep;
  const unsigned ldsw = (unsigned)wid * 1024u;
  const int aoff = lds_byte(wr * 64 + fr, fq * 8), boff = lds_byte(wc * 32 + fr, fq * 8);
#define PG8_SA(b, h) (((b) * 2 + (h)) * HTB)
#define PG8_SB(b, h) ((4 + (b) * 2 + (h)) * HTB)
#define PG8_STAGE(bufoff, gbase, voff) do { _Pragma("unroll") for (int _i = 0; _i < 2; ++_i) \
    __builtin_amdgcn_global_load_lds((const unsigned*)((const char*)(gbase) + (voff)[_i]), (PG8_LAS unsigned*)(lds + (bufoff) + ldsw + _i * 8192), 16, 0, 0); } while (0)
#define PG8_LDA(dst, b, h) do { _Pragma("unroll") for (int m = 0; m < 4; ++m) _Pragma("unroll") for (int k = 0; k < 2; ++k) dst[m][k] = *(const PG8_LAS bf16x8*)(lds + PG8_SA(b, h) + aoff + m * 2048 + k * 1024); } while (0)
#define PG8_LDB(dst, b, h) do { _Pragma("unroll") for (int n = 0; n < 2; ++n) _Pragma("unroll") for (int k = 0; k < 2; ++k) dst[n][k] = *(const PG8_LAS bf16x8*)(lds + PG8_SB(b, h) + boff + n * 2048 + k * 1024); } while (0)
#define PG8_MMA(ai, bj, At, Bt) do { __builtin_amdgcn_s_setprio(1); _Pragma("unroll") for (int m = 0; m < 4; ++m) _Pragma("unroll") for (int n = 0; n < 2; ++n) _Pragma("unroll") for (int k = 0; k < 2; ++k) \
    acc[ai][bj][m][n] = __builtin_amdgcn_mfma_f32_16x16x32_bf16(Bt[n][k], At[m][k], acc[ai][bj][m][n], 0, 0, 0); __builtin_amdgcn_s_setprio(0); } while (0)
#define PG8_WAIT_V(n) asm volatile("s_waitcnt vmcnt(" #n ")" ::: "memory")
#define PG8_WAIT_L(n) asm volatile("s_waitcnt lgkmcnt(" #n ")" ::: "memory")
#define PG8_BAR __builtin_amdgcn_s_barrier()
#define PG8_SCHED __builtin_amdgcn_sched_barrier(0)
  Unit cur, nxt; int ui = 0;
  if (!S.next(0, cur)) return;
  f32x4 acc[2][2][4][2];
  E.init(acc, cur, wr, wc, fr, fq);
#define PG8_RTAB(unit, buf) do { if constexpr (Epi::NEEDS_R) { const int rr_ = tid >> 1, hf_ = tid & 1; \
    const float4* sp_ = (const float4*)(E.ssq + (size_t)((unit).pm * BM + rr_) * 16 + hf_ * 8); const float4 a_ = sp_[0], b_ = sp_[1]; \
    float ss_ = a_.x + a_.y + a_.z + a_.w + b_.x + b_.y + b_.z + b_.w; ss_ += __shfl_xor(ss_, 1); \
    if (!hf_) ((PG8_LAS float*)(lds + RT_OFF))[(buf) * 256 + rr_] = rsqrtf(ss_ * (1.0f / DM) + EPS); } } while (0)
  PG8_RTAB(cur, 0);
  bf16x8 At[4][2], B0[2][2], B1[2][2];
  const char* cA = (const char*)gA + (size_t)cur.pm * tstep; const char* cB = (const char*)gBt + (size_t)cur.pn * tstep;
  PG8_STAGE(PG8_SB(0, 0), cB, voffB); PG8_STAGE(PG8_SA(0, 0), cA, voffA); PG8_STAGE(PG8_SB(0, 1), cB + hstep, voffB); PG8_STAGE(PG8_SA(0, 1), cA + hstep, voffA);
  if (wr == 1) PG8_BAR;
  PG8_WAIT_V(4); PG8_BAR;
  PG8_STAGE(PG8_SB(1, 0), cB + kstep, voffB); PG8_STAGE(PG8_SA(1, 0), cA + kstep, voffA); PG8_STAGE(PG8_SB(1, 1), cB + hstep + kstep, voffB);
  PG8_WAIT_V(6); PG8_BAR;
  for (;;) {
    const bool has_next = S.next(ui + 1, nxt);
    const char* nA = has_next ? (const char*)gA + (size_t)nxt.pm * tstep : cA; const char* nB = has_next ? (const char*)gBt + (size_t)nxt.pn * tstep : cB;
    for (int t = 0; t < nt; t += 2) {
      const bool last = (t == nt - 2);
      const char* a1 = cA + (size_t)(t + 1) * kstep;
      const char* a2 = last ? nA : cA + (size_t)(t + 2) * kstep; const char* b2 = last ? nB : cB + (size_t)(t + 2) * kstep;
      const char* a3 = a2 + kstep; const char* b3 = b2 + kstep;
      PG8_LDB(B0, 0, 0); PG8_SCHED; PG8_LDA(At, 0, 0); PG8_STAGE(PG8_SA(1, 1), a1 + hstep, voffA);
      PG8_WAIT_L(8); PG8_BAR; PG8_WAIT_L(0); PG8_MMA(0, 0, At, B0); PG8_BAR; PG8_SCHED;
      PG8_LDB(B1, 0, 1); PG8_STAGE(PG8_SB(0, 0), b2, voffB);
      PG8_BAR; PG8_WAIT_L(0); PG8_MMA(0, 1, At, B1); PG8_BAR;
      PG8_LDA(At, 0, 1); PG8_STAGE(PG8_SA(0, 0), a2, voffA);
      PG8_BAR; PG8_WAIT_L(0); PG8_MMA(1, 0, At, B0); PG8_BAR; PG8_SCHED;
      PG8_STAGE(PG8_SB(0, 1), b2 + hstep, voffB);
      PG8_WAIT_V(6); PG8_BAR; PG8_MMA(1, 1, At, B1); PG8_BAR;
      PG8_LDB(B0, 1, 0); PG8_SCHED; PG8_LDA(At, 1, 0); PG8_STAGE(PG8_SA(0, 1), a2 + hstep, voffA);
      PG8_WAIT_L(8); PG8_BAR; PG8_WAIT_L(0); PG8_MMA(0, 0, At, B0); PG8_BAR; PG8_SCHED;
      PG8_LDB(B1, 1, 1); PG8_STAGE(PG8_SB(1, 0), b3, voffB);
      PG8_BAR; PG8_WAIT_L(0); PG8_MMA(0, 1, At, B1); PG8_BAR;
      PG8_LDA(At, 1, 1); PG8_STAGE(PG8_SA(1, 0), a3, voffA);
      PG8_BAR; PG8_WAIT_L(0); PG8_MMA(1, 0, At, B0); PG8_BAR; PG8_SCHED;
      PG8_STAGE(PG8_SB(1, 1), b3 + hstep, voffB);
      PG8_WAIT_V(6); PG8_BAR; PG8_MMA(1, 1, At, B1); PG8_BAR;
    }
    E(acc, cur, wr, wc, fr, fq, (const PG8_LAS float*)(lds + RT_OFF) + (ui & 1) * 256);
    if (!has_next) break;
    E.init(acc, nxt, wr, wc, fr, fq);
    PG8_RTAB(nxt, (ui + 1) & 1);
    cur = nxt; cA = nA; cB = nB; ++ui;
  }
  PG8_WAIT_V(0);
  if (wr == 0) PG8_BAR;
  PG8_BAR;
#undef PG8_RTAB
#undef PG8_SA
#undef PG8_SB
#undef PG8_STAGE
#undef PG8_LDA
#undef PG8_LDB
#undef PG8_MMA
#undef PG8_WAIT_V
#undef PG8_WAIT_L
#undef PG8_BAR
#undef PG8_SCHED
}

DI void bprep_phase(const Params& p) {
  OPAQUE_TID(tid);
  const int pi = tid & 31, tl = tid >> 5;
  const float fr = exp2f(-(float)((pi & 15) * 2) * (1.0f / 32.0f) * 13.287712379549449f);
  const float qg0 = p.ab_qg[2 * pi], qg1 = p.ab_qg[2 * pi + 1], kg0 = p.ab_kg[2 * pi], kg1 = p.ab_kg[2 * pi + 1];
  for (int t = blockIdx.x * 16 + tl; t < NTOK; t += gridDim.x * 16) {
    const int pos = (t < PROMPT_T) ? t : ((t - PROMPT_T) & (SAMPLE_T - 1));
    const float ang = (float)((pi < 16) ? (pos >> 6) : (pos & 63)) * fr;
    const float cs = __cosf(ang), sn = __sinf(ang);
    unsigned* rowp = (unsigned*)(p.big + (size_t)t * 2304);
#pragma unroll
    for (int hd = 0; hd < 10; ++hd) {
      const int col = (hd < 8) ? (1536 + hd * 64) : (2048 + (hd - 8) * 64);
      unsigned u = rowp[(col >> 1) + pi];
      float x1 = bflo(u), x2 = bfhi(u);
      float ss = x1 * x1 + x2 * x2;
#pragma unroll
      for (int o = 16; o > 0; o >>= 1) ss += __shfl_xor(ss, o);
      const float r = rsqrtf(ss * (1.0f / 64.0f) + EPS);
      x1 = x1 * r * ((hd < 8) ? qg0 : kg0); x2 = x2 * r * ((hd < 8) ? qg1 : kg1);
      rowp[(col >> 1) + pi] = pack2(x1 * cs - x2 * sn, x1 * sn + x2 * cs);
    }
  }
}

template <int MODE>
DI void naive_attn(const Params& p, const bf16_t* __restrict__ proj, int ld, int qoff, int koff, int voff, int nqh, int G, bf16_t* cat, int cat_off) {
  const int total = NTOK * nqh;
  for (int idx = blockIdx.x * 256 + threadIdx.x; idx < total; idx += gridDim.x * 256) {
    const int head = idx / NTOK, t = idx % NTOK, hk = head / G;
    const int seq_base = (t < PROMPT_T) ? 0 : (PROMPT_T + ((t - PROMPT_T) / SAMPLE_T) * SAMPLE_T);
    const int T = (t < PROMPT_T) ? PROMPT_T : SAMPLE_T;
    const int pos = t - seq_base;
    float q[64], o[64];
    { const uint4* qp = (const uint4*)(proj + (size_t)t * ld + qoff + head * 64);
#pragma unroll
      for (int c = 0; c < 8; ++c) { uint4 v = qp[c]; q[8*c] = bflo(v.x); q[8*c+1] = bfhi(v.x); q[8*c+2] = bflo(v.y); q[8*c+3] = bfhi(v.y); q[8*c+4] = bflo(v.z); q[8*c+5] = bfhi(v.z); q[8*c+6] = bflo(v.w); q[8*c+7] = bfhi(v.w); } }
#pragma unroll
    for (int d = 0; d < 64; ++d) o[d] = 0.f;
    float m = -1e30f, l = 0.f, slope = 0.f;
    if (MODE == 0) slope = exp2f(-(float)(head + 1));
    if (MODE == 2) { slope = exp2f(-0.5f * (float)(head + 1)); m = p.c_sink[head]; l = 1.f; }
    const int nkeys = (MODE == 0) ? 387 : (MODE == 1 ? T : 257);
    for (int j = 0; j < nkeys; ++j) {
      int off;
      if (MODE == 0) { const int br = j / 129, jj = j % 129 - 64; off = jj * (br == 0 ? 1 : (br == 1 ? 4 : 16)); }
      else if (MODE == 1) off = j - pos;
      else off = j - 128;
      const int kp = pos + off;
      if (kp < 0 || kp >= T) continue;
      const uint4* kptr = (const uint4*)(proj + (size_t)(seq_base + kp) * ld + koff + hk * 64);
      float s = 0.f;
#pragma unroll
      for (int c = 0; c < 8; ++c) { uint4 v = kptr[c];
        s += q[8*c] * bflo(v.x) + q[8*c+1] * bfhi(v.x) + q[8*c+2] * bflo(v.y) + q[8*c+3] * bfhi(v.y) + q[8*c+4] * bflo(v.z) + q[8*c+5] * bfhi(v.z) + q[8*c+6] * bflo(v.w) + q[8*c+7] * bfhi(v.w); }
      s *= 0.125f;
      if (MODE != 1) s -= slope * fabsf((float)off);
      const float mn = fmaxf(m, s); const float al = __expf(m - mn), pw = __expf(s - mn);
      m = mn; l = l * al + pw;
      const uint4* vptr = (const uint4*)(proj + (size_t)(seq_base + kp) * ld + voff + hk * 64);
#pragma unroll
      for (int c = 0; c < 8; ++c) { uint4 v = vptr[c];
        o[8*c] = o[8*c] * al + pw * bflo(v.x); o[8*c+1] = o[8*c+1] * al + pw * bfhi(v.x); o[8*c+2] = o[8*c+2] * al + pw * bflo(v.y); o[8*c+3] = o[8*c+3] * al + pw * bfhi(v.y);
        o[8*c+4] = o[8*c+4] * al + pw * bflo(v.z); o[8*c+5] = o[8*c+5] * al + pw * bfhi(v.z); o[8*c+6] = o[8*c+6] * al + pw * bflo(v.w); o[8*c+7] = o[8*c+7] * al + pw * bfhi(v.w); }
    }
    const float inv = 1.f / l;
    uint4* op = (uint4*)(cat + (size_t)t * DM + cat_off + head * 64);
#pragma unroll
    for (int c = 0; c < 8; ++c) { uint4 v; v.x = pack2(o[8*c] * inv, o[8*c+1] * inv); v.y = pack2(o[8*c+2] * inv, o[8*c+3] * inv); v.z = pack2(o[8*c+4] * inv, o[8*c+5] * inv); v.w = pack2(o[8*c+6] * inv, o[8*c+7] * inv); op[c] = v; }
  }
}

typedef short s16x4 __attribute__((ext_vector_type(4)));
typedef __attribute__((address_space(3))) s16x4* lds_s16x4_ptr;
DI s16x4 vtr(const char* p) { return __builtin_amdgcn_ds_read_tr16_b64_v4i16((lds_s16x4_ptr)p); }

template <int MODE, int NQ>
DI void attn_unit(const bf16_t* __restrict__ proj, int ld, int seq_base, int kt0, int kt1, int koff, int voff,
                  int q0w, int qoff, int ooff, float slope2, float sink2, bf16_t* __restrict__ cat, char* lds) {
  OPAQUE_TID(tid);
  const int lane = tid & 63, wave = tid >> 6, r32 = lane & 31, hh = lane >> 5;
  constexpr float C2 = 0.125f * LOG2E;
  constexpr int NS = 6;
  bf16x8 qf[NQ][4];
#pragma unroll
  for (int nq = 0; nq < NQ; ++nq) { const bf16_t* qp = proj + (size_t)(seq_base + q0w + 32 * nq + r32) * ld + qoff + hh * 8;
#pragma unroll
    for (int ks = 0; ks < 4; ++ks) qf[nq][ks] = *(const bf16x8*)(qp + ks * 16); }
  f32x16 o[NQ][2];
  float m2[NQ], l[NQ];
#pragma unroll
  for (int nq = 0; nq < NQ; ++nq) { m2[nq] = (MODE == 2) ? sink2 : -1e30f; l[nq] = 0.f;
#pragma unroll
    for (int r = 0; r < 16; ++r) { o[nq][0][r] = 0.f; o[nq][1][r] = 0.f; } }
  PG8_LAS unsigned char* L = (PG8_LAS unsigned char*)lds;
  const bf16_t* kg = proj + (size_t)(seq_base + lane) * ld + koff + wave * 8;
  const bf16_t* vg = proj + (size_t)(seq_base + (wave & 3) * 16 + (lane >> 2)) * ld + voff + ((wave >> 2) * 4 + (lane & 3)) * 8;
  const unsigned sdst = (unsigned)__builtin_amdgcn_readfirstlane(wave * 1024);
#define ATT_ISSUE(tile, slot) do { const size_t go_ = (size_t)(tile) * 64 * ld; \
    __builtin_amdgcn_global_load_lds((const unsigned*)(kg + go_), (PG8_LAS unsigned*)(L + (slot) * 16384 + sdst), 16, 0, 0); \
    __builtin_amdgcn_global_load_lds((const unsigned*)(vg + go_), (PG8_LAS unsigned*)(L + (slot) * 16384 + 8192 + sdst), 16, 0, 0); } while (0)
  const int ktl = kt1 - 1;
  constexpr int TAB_OFF = 6 * 16384, TAB_N = 2560, TAB_ZERO = 1280;
  if (MODE == 0) {
    float* tab = (float*)(lds + TAB_OFF);
    for (int e = tid; e < TAB_N; e += 512) {
      const int oo = e - TAB_ZERO, aa = oo < 0 ? -oo : oo;
      const int c = (aa <= 64 ? 1 : 0) + (((oo & 3) == 0 && aa <= 256) ? 1 : 0) + (((oo & 15) == 0 && aa <= 1024) ? 1 : 0);
      tab[e] = c ? (-slope2 * (float)aa + (c == 1 ? 0.f : (c == 2 ? 1.f : 1.5849625007f))) : -1e30f;
    }
  }
  if (MODE == 2) {
    float* tab = (float*)(lds + TAB_OFF) + (wave & 3) * 384;
#pragma unroll
    for (int i = 0; i < 3; ++i) { const int e = (wave >> 2) * 64 + lane + 128 * i; const int oo = e - 192, aa = oo < 0 ? -oo : oo; tab[e] = (aa <= 128) ? -slope2 * (float)aa : -1e30f; }
  }
  ATT_ISSUE(kt0, 0); ATT_ISSUE((kt0 + 1 < ktl ? kt0 + 1 : ktl), 1); ATT_ISSUE((kt0 + 2 < ktl ? kt0 + 2 : ktl), 2); ATT_ISSUE((kt0 + 3 < ktl ? kt0 + 3 : ktl), 3);
  asm volatile("s_waitcnt vmcnt(6) lgkmcnt(0)\n\ts_barrier" ::: "memory");
  const int kfo = hh * 1024 + r32 * 16;
  const int vfo = 8192 + (4 * hh + ((lane & 15) >> 2)) * 64 + ((lane >> 4) & 1) * 32 + (lane & 3) * 8;
  const bool g2 = wave >= 4;
  f32x16 s[NQ][2];
  bf16x8 pf[NQ][4];
  auto tile_active = [&](int kt) -> bool { return (MODE != 0) || ((kt * 64 + 63 >= q0w - 1024) && (kt * 64 <= q0w + 32 * NQ - 1 + 1024)); };
  auto QK = [&](int slot) {
    const char* kb_ = lds + slot * 16384 + kfo;
#pragma unroll
    for (int nq = 0; nq < NQ; ++nq)
#pragma unroll
      for (int r = 0; r < 16; ++r) { s[nq][0][r] = 0.f; s[nq][1][r] = 0.f; }
#pragma unroll
    for (int ks = 0; ks < 4; ++ks) {
      const bf16x8 k0 = *(const bf16x8*)(kb_ + ks * 2048), k1 = *(const bf16x8*)(kb_ + ks * 2048 + 512);
#pragma unroll
      for (int nq = 0; nq < NQ; ++nq) { s[nq][0] = MFMA32(k0, qf[nq][ks], s[nq][0]); s[nq][1] = MFMA32(k1, qf[nq][ks], s[nq][1]); }
    }
  };
  auto SM = [&](int kt) {
#pragma unroll
    for (int nq = 0; nq < NQ; ++nq) {
      f32x16& s0 = s[nq][0]; f32x16& s1 = s[nq][1];
      float mx = -1e30f;
      if (MODE == 1) {
      } else if (MODE == 0) {
        const float* tb = (const float*)(lds + TAB_OFF) + (kt * 64 + 4 * hh - (q0w + 32 * nq + r32) + TAB_ZERO);
#pragma unroll
        for (int r = 0; r < 16; ++r) {
          const float va = fmaf(s0[r], C2, tb[(r & 3) + 8 * (r >> 2)]), vb = fmaf(s1[r], C2, tb[(r & 3) + 8 * (r >> 2) + 32]);
          s0[r] = va; s1[r] = vb; mx = fmaxf(mx, fmaxf(va, vb));
        }
      } else {
        const float* tb = (const float*)(lds + TAB_OFF) + (wave & 3) * 384 + (kt * 64 + 4 * hh - (q0w + 32 * nq + r32) + 192);
#pragma unroll
        for (int r = 0; r < 16; ++r) {
          const float va = fmaf(s0[r], C2, tb[(r & 3) + 8 * (r >> 2)]), vb = fmaf(s1[r], C2, tb[(r & 3) + 8 * (r >> 2) + 32]);
          s0[r] = va; s1[r] = vb; mx = fmaxf(mx, fmaxf(va, vb));
        }
      }
      float mn;
      if (MODE == 1) {
        mn = sink2;
      } else {
        if (__any(mx > m2[nq] + 8.f)) {
          mx = fmaxf(mx, __shfl_xor(mx, 32));
          mn = fmaxf(m2[nq], mx);
          const float alpha = __builtin_amdgcn_exp2f(m2[nq] - mn);
          l[nq] *= alpha;
#pragma unroll
          for (int r = 0; r < 16; ++r) { o[nq][0][r] *= alpha; o[nq][1][r] *= alpha; }
          m2[nq] = mn;
        }
        mn = m2[nq];
      }
      float ls = 0.f;
#pragma unroll
      for (int r = 0; r < 16; ++r) {
        float pa, pb;
        if (MODE == 1) { pa = __builtin_amdgcn_exp2f(fmaf(s0[r], C2, -mn)); pb = __builtin_amdgcn_exp2f(fmaf(s1[r], C2, -mn)); }
        else { pa = __builtin_amdgcn_exp2f(s0[r] - mn); pb = __builtin_amdgcn_exp2f(s1[r] - mn); }
        s0[r] = pa; s1[r] = pb; ls += pa + pb;
      }
      l[nq] += ls;
#pragma unroll
      for (int ks = 0; ks < 4; ++ks) {
        uint4 t4;
        const int rb = 8 * (ks & 1);
        if (ks < 2) { t4.x = pack2(s0[rb], s0[rb + 1]); t4.y = pack2(s0[rb + 2], s0[rb + 3]); t4.z = pack2(s0[rb + 4], s0[rb + 5]); t4.w = pack2(s0[rb + 6], s0[rb + 7]); }
        else { t4.x = pack2(s1[rb], s1[rb + 1]); t4.y = pack2(s1[rb + 2], s1[rb + 3]); t4.z = pack2(s1[rb + 4], s1[rb + 5]); t4.w = pack2(s1[rb + 6], s1[rb + 7]); }
        pf[nq][ks] = __builtin_bit_cast(bf16x8, t4);
      }
    }
  };
  auto PV = [&](int slot) {
    const char* vb_ = lds + slot * 16384 + vfo;
#pragma unroll
    for (int ks = 0; ks < 4; ++ks) {
      const s16x4 a0 = vtr(vb_ + ks * 1024), a1 = vtr(vb_ + ks * 1024 + 512);
      const s16x4 b0 = vtr(vb_ + 4096 + ks * 1024), b1 = vtr(vb_ + 4096 + ks * 1024 + 512);
      const bf16x8 v0 = __builtin_shufflevector(a0, a1, 0, 1, 2, 3, 4, 5, 6, 7);
      const bf16x8 v1 = __builtin_shufflevector(b0, b1, 0, 1, 2, 3, 4, 5, 6, 7);
#pragma unroll
      for (int nq = 0; nq < NQ; ++nq) { o[nq][0] = MFMA32(v0, pf[nq][ks], o[nq][0]); o[nq][1] = MFMA32(v1, pf[nq][ks], o[nq][1]); }
    }
  };
  int slot = 0, sp = 0;
  for (int kt = kt0; kt < kt1; ++kt) {
    { const int tn = (kt + 4 < ktl) ? kt + 4 : ktl; int s4 = slot + 4; if (s4 >= NS) s4 -= NS; ATT_ISSUE(tn, s4); }
    const bool act = tile_active(kt);
    if (!g2) {
      if (act) { QK(slot); SM(kt); PV(slot); }
    } else {
      if (kt > kt0 && tile_active(kt - 1)) PV(sp);
      if (act) { QK(slot); SM(kt); }
    }
    asm volatile("s_waitcnt vmcnt(6) lgkmcnt(0)\n\ts_barrier" ::: "memory");
    sp = slot; slot = (slot + 1 == NS) ? 0 : slot + 1;
  }
  if (g2 && tile_active(ktl)) PV(sp);
  asm volatile("s_waitcnt vmcnt(0)\n\ts_barrier" ::: "memory");
#undef ATT_ISSUE
#pragma unroll
  for (int nq = 0; nq < NQ; ++nq) {
    float lt = l[nq] + __shfl_xor(l[nq], 32);
    if (MODE == 2) lt += __builtin_amdgcn_exp2f(sink2 - m2[nq]);
    const float inv = 1.f / lt;
    bf16_t* op = cat + (size_t)(seq_base + q0w + 32 * nq + r32) * DM + ooff + 4 * hh;
#pragma unroll
    for (int g = 0; g < 4; ++g) {
      uint2 a, b;
      a.x = pack2(o[nq][0][4 * g] * inv, o[nq][0][4 * g + 1] * inv); a.y = pack2(o[nq][0][4 * g + 2] * inv, o[nq][0][4 * g + 3] * inv);
      b.x = pack2(o[nq][1][4 * g] * inv, o[nq][1][4 * g + 1] * inv); b.y = pack2(o[nq][1][4 * g + 2] * inv, o[nq][1][4 * g + 3] * inv);
      *(uint2*)(op + 8 * g) = a; *(uint2*)(op + 32 + 8 * g) = b;
    }
  }
}

DI void attn_phase_l0(const Params& p, char* lds) {
  OPAQUE_TID(tid0);
  const int wave = tid0 >> 6;
  float mref;
  { float gq = fabsf(p.ab_qg[tid0 & 63]), gk = fabsf(p.ab_kg[tid0 & 63]);
#pragma unroll
    for (int o = 32; o > 0; o >>= 1) { gq = fmaxf(gq, __shfl_xor(gq, o)); gk = fmaxf(gk, __shfl_xor(gk, o)); }
    mref = 8.f * gq * gk * LOG2E; }
  for (int u = blockIdx.x; u < 1536; u += gridDim.x) {
    if (u < 512) {
      int seq_base, T, kvh, qt;
      if (u < 256) { seq_base = 0; T = PROMPT_T; kvh = u >> 7; qt = u & 127; }
      else { const int v = u - 256; seq_base = PROMPT_T + (v >> 6) * SAMPLE_T; T = SAMPLE_T; kvh = (v >> 5) & 1; qt = v & 31; }
      const int head = kvh * 4 + (wave & 3);
      attn_unit<1, 2>(p.big, 2304, seq_base, 0, T >> 6, 2048 + kvh * 64, 2176 + kvh * 64, qt * 128 + (wave >> 2) * 64, 1536 + head * 64, 512 + head * 64, 0.f, mref, p.xn, lds);
    } else {
      const int v = u - 512, head = v >> 7, tok0 = (v & 127) * 256;
      const int seq_base = (tok0 < PROMPT_T) ? 0 : (PROMPT_T + ((tok0 - PROMPT_T) / SAMPLE_T) * SAMPLE_T);
      const int T = (tok0 < PROMPT_T) ? PROMPT_T : SAMPLE_T;
      const int q0b = tok0 - seq_base;
      int kt0 = (q0b - 1024) >> 6; if (kt0 < 0) kt0 = 0;
      int kt1 = ((q0b + 255 + 1024) >> 6) + 1; if (kt1 > (T >> 6)) kt1 = T >> 6;
      attn_unit<0, 1>(p.big, 2304, seq_base, kt0, kt1, 512 + head * 64, 1024 + head * 64, q0b + wave * 32, head * 64, head * 64,
                   exp2f(-(float)(head + 1)) * LOG2E, 0.f, p.xn, lds);
    }
  }
}

DI void attn_phase_l1(const Params& p, char* lds) {
  OPAQUE_TID(tid0);
  const int wave = tid0 >> 6;
  for (int u = blockIdx.x; u < 2048; u += gridDim.x) {
    const int kvh = u >> 9, tok0 = (u & 511) * 64;
    const int seq_base = (tok0 < PROMPT_T) ? 0 : (PROMPT_T + ((tok0 - PROMPT_T) / SAMPLE_T) * SAMPLE_T);
    const int T = (tok0 < PROMPT_T) ? PROMPT_T : SAMPLE_T;
    const int q0 = tok0 - seq_base, head = kvh * 4 + (wave & 3);
    int kt0 = (q0 - 128) >> 6; if (kt0 < 0) kt0 = 0;
    int kt1 = ((q0 + 63 + 128) >> 6) + 1; if (kt1 > (T >> 6)) kt1 = T >> 6;
    attn_unit<2, 1>(p.big, 1536, seq_base, kt0, kt1, 1024 + kvh * 64, 1280 + kvh * 64, q0 + (wave >> 2) * 32, head * 64, head * 64,
                 exp2f(-0.5f * (float)(head + 1)) * LOG2E, p.c_sink[head] * LOG2E, p.xn, lds);
  }
}

#define XB_TMO      128
#define XB_XCNT(j)  (256  + 64 * (j))
#define XB_XSUB(j)  (1280 + 64 * (j))
#define XB_XGEN(j)  (2304 + 64 * (j))
#define XB_TOP      3328
#define XB_TOPGEN   3392
#define XCD_BAR_WORDS 3456
#define XB_SPIN_CAP (1u << 22)
DI unsigned xb_ld(unsigned* p) { return __hip_atomic_load(p, __ATOMIC_RELAXED, __HIP_MEMORY_SCOPE_AGENT); }
DI unsigned xb_add(unsigned* p, unsigned v) { return __hip_atomic_fetch_add(p, v, __ATOMIC_RELAXED, __HIP_MEMORY_SCOPE_AGENT); }
DI unsigned xb_xcc_id() { return (unsigned)__builtin_amdgcn_s_getreg((3 << 11) | 20) & 0xFu; }
#define XB_SPIN(cond, bar) do { unsigned _sp = 0; while (cond) { __builtin_amdgcn_s_sleep(1); \
    if ((++_sp & 255u) == 0u) { if (xb_ld(&(bar)[XB_TMO])) break; if (_sp > XB_SPIN_CAP) { atomicAdd(&(bar)[XB_TMO], 1u); break; } } } } while (0)
struct XcdBarrier { unsigned* bar; unsigned x; volatile unsigned* st; };
DI void xcd_barrier_complete(unsigned* bar, unsigned x, unsigned& nloc, unsigned& nx) {
  const unsigned G = gridDim.x;
  unsigned sum, cnt, mine, sp = 0u;
  for (;;) {
    sum = 0u; cnt = 0u; mine = 0u;
#pragma unroll
    for (unsigned j = 0; j < 16; ++j) { const unsigned c = xb_ld(&bar[XB_XCNT(j)]); sum += c; cnt += (c > 0u) ? 1u : 0u; mine = (j == x) ? c : mine; }
    if (sum == G) break;
    __builtin_amdgcn_s_sleep(1);
    if ((++sp & 255u) == 0u) { if (xb_ld(&bar[XB_TMO])) break; if (sp > XB_SPIN_CAP) { atomicAdd(&bar[XB_TMO], 1u); break; } }
  }
  nloc = mine > 0u ? mine : 1u; nx = cnt > 0u ? cnt : 1u;
}
DI void xcd_barrier(const XcdBarrier& b) {
  asm volatile("s_waitcnt vmcnt(0)" ::: "memory");
  __syncthreads();
  if (threadIdx.x == 0) {
    unsigned* bar = b.bar;
    __builtin_amdgcn_s_waitcnt(0);
    unsigned nloc = b.st[0], nx = b.st[1];
    if (nloc == 0u) { xcd_barrier_complete(bar, b.x, nloc, nx); b.st[0] = nloc; b.st[1] = nx; }
    const unsigned old = xb_add(&bar[XB_XSUB(b.x)], 1u);
    const unsigned gen = old / nloc;
    if (old + 1u == (gen + 1u) * nloc) {
      __builtin_amdgcn_fence(__ATOMIC_RELEASE, "agent");
      asm volatile("s_waitcnt vmcnt(0)" ::: "memory");
      const unsigned og = xb_add(&bar[XB_TOP], 1u);
      const unsigned tg = og / nx;
      if (og + 1u == (tg + 1u) * nx) xb_add(&bar[XB_TOPGEN], 1u);
      else XB_SPIN(xb_ld(&bar[XB_TOPGEN]) == tg, bar);
      __builtin_amdgcn_fence(__ATOMIC_ACQUIRE, "agent");
      xb_add(&bar[XB_XGEN(b.x)], 1u);
      asm volatile("s_waitcnt vmcnt(0)" ::: "memory");
    } else {
      XB_SPIN(xb_ld(&bar[XB_XGEN(b.x)]) == gen, bar);
      __builtin_amdgcn_fence(__ATOMIC_ACQUIRE, "agent");
      asm volatile("s_waitcnt vmcnt(0)" ::: "memory");
    }
  }
  __syncthreads();
}

__global__ void __launch_bounds__(512) fwd_megakernel(Params p) {
  cg::grid_group grid = cg::this_grid();
  __shared__ __attribute__((aligned(1024))) char lds[8 * HTB + 64 + 2048];
  volatile unsigned* bst = (volatile unsigned*)(lds + 8 * HTB);
  if (threadIdx.x < 2) bst[threadIdx.x] = 0u;
  __syncthreads();
  XcdBarrier xb; xb.bar = p.bar; xb.x = xb_xcc_id(); xb.st = bst;
  if (threadIdx.x == 0) (void)xb_add(&p.bar[XB_XCNT(xb.x)], 1u);
  convert_phase(p, 0, (float*)lds);
  init_phase(p);
  grid.sync();
  for (int layer = 0; layer < 2; ++layer) {
    for (int f = 0; f < 2; ++f) {
      if (f == 1) {
        if (layer == 0) gemm_phase(p.h16, p.wts + W_IN, NTOK, 2304, DM, EpiProj{p.big, 2304, p.ssq}, lds);
        else gemm_phase(p.h16, p.wts + W_IN, NTOK, 1536, DM, EpiProj{p.big, 1536, p.ssq}, lds);
        xcd_barrier(xb);
        if (layer == 0) {
          bprep_phase(p);
          xcd_barrier(xb);
          attn_phase_l0(p, lds);
        } else {
          attn_phase_l1(p, lds);
        }
        xcd_barrier(xb);
        gemm_phase(p.xn, p.wts + W_OUT, NTOK, DM, DM, EpiResid{p.h16, p.h16, 1.0f, p.ssq}, lds);
        xcd_barrier(xb);
      }
      const int rows = NTOK / p.ffn_chunks;
      const bool last = (layer == 1 && f == 1);
      for (int c = 0; c < p.ffn_chunks; ++c) {
        const size_t ro = (size_t)c * rows;
        gemm_phase(p.h16 + ro * DM, p.wts + (f ? W_UPB : W_UPA), rows, 2 * DFF, DM, EpiUp{p.big, p.ssq + ro * 16}, lds);
        xcd_barrier(xb);
        gemm_phase(p.big, p.wts + (f ? W_DNB : W_DNA), rows, DM, DFF, EpiResid{p.h16 + ro * DM, (last ? p.xn : p.h16) + ro * DM, 0.5f, p.ssq + ro * 16}, lds);
        xcd_barrier(xb);
      }
    }
    if (layer == 0) { convert_phase(p, 1, (float*)lds); xcd_barrier(xb); }
  }
  final_norm_phase(p);
}

extern "C" void kernel_launch(void* const* d_in, const int* in_sizes, int n_in, void* d_out, int out_size, void* d_ws, size_t ws_size, hipStream_t stream) {
  static int grid_blocks = 0;
  if (!grid_blocks) {
    int dev = 0, cus = 0, per_cu = 0;
    hipGetDevice(&dev);
    hipDeviceGetAttribute(&cus, hipDeviceAttributeMultiprocessorCount, dev);
    hipOccupancyMaxActiveBlocksPerMultiprocessor(&per_cu, fwd_megakernel, 512, 0);
    if (per_cu > 1) per_cu = 1;
    if (per_cu < 1) per_cu = 1;
    grid_blocks = cus * per_cu;
  }
  Params p{};
  p.x_prompt = (const float*)d_in[0]; p.x_sample = (const float*)d_in[1]; p.norm_g = (const float*)d_in[2];
  p.w1 = (const float*)d_in[3]; p.w3 = (const float*)d_in[4]; p.w2 = (const float*)d_in[5];
  p.ab_w_in = (const float*)d_in[6]; p.ab_w_out = (const float*)d_in[7]; p.ab_qg = (const float*)d_in[8]; p.ab_kg = (const float*)d_in[9];
  p.c_w_in = (const float*)d_in[10]; p.c_w_out = (const float*)d_in[11]; p.c_sink = (const float*)d_in[12]; p.final_g = (const float*)d_in[13];
  p.h = (float*)d_out;
  char* ws = (char*)d_ws;
  const size_t MiB = 1024 * 1024;
  p.wts = (bf16_t*)ws;
  p.xn = (bf16_t*)(ws + 40 * MiB);
  p.big = (bf16_t*)(ws + 104 * MiB);
  p.ffn_chunks = (ws_size >= 283 * MiB) ? 1 : 2;
  { const size_t tail = (p.ffn_chunks == 1 ? 280 : 250) * MiB; p.bar = (unsigned*)(ws + tail); p.ssq = (float*)(ws + tail + 65536); }
  p.h16 = (bf16_t*)d_out;
  hipMemsetAsync(p.bar, 0, XCD_BAR_WORDS * sizeof(unsigned), stream);
  p.pad = 0;
  void* args[] = {&p};
  hipError_t e = hipLaunchCooperativeKernel((void*)fwd_megakernel, dim3(grid_blocks), dim3(512), args, 0, stream);
  if (e != hipSuccess) fprintf(stderr, "cooperative launch failed: %s (grid %d)\n", hipGetErrorString(e), grid_blocks);
}
```

```cpp
#include <hip/hip_runtime.h>
#include <hip/hip_cooperative_groups.h>
#include <cstdio>
namespace cg = cooperative_groups;

typedef unsigned short bf16_t;
typedef short bf16x8 __attribute__((ext_vector_type(8)));
typedef float f32x16 __attribute__((ext_vector_type(16)));
#define DI __device__ __forceinline__
#define OPAQUE_TID(v) int v = threadIdx.x; asm volatile("" : "+v"(v))
#define MFMA32(a, b, c) __builtin_amdgcn_mfma_f32_32x32x16_bf16((a), (b), (c), 0, 0, 0)

constexpr int NTOK = 32768, DM = 1024, DFF = 2816;
constexpr int PROMPT_T = 16384, SAMPLE_T = 4096;
constexpr float EPS = 1e-6f;
constexpr float LOG2E = 1.4426950408889634f;

constexpr size_t W_UPA = 0, W_DNA = 5767168, W_UPB = 8650752, W_DNB = 14417920, W_IN = 17301504, W_OUT = 19660800, W_TOTAL = 20709376;

struct Params {
  const float* x_prompt; const float* x_sample; const float* norm_g; const float* w1; const float* w3; const float* w2;
  const float* ab_w_in; const float* ab_w_out; const float* ab_qg; const float* ab_kg;
  const float* c_w_in; const float* c_w_out; const float* c_sink; const float* final_g;
  float* h; bf16_t* wts; bf16_t* xn; bf16_t* big; unsigned* bar; float* ssq; bf16_t* h16;
  int ffn_chunks; int pad;
};

DI bf16_t f2bf(float x) { unsigned u = __float_as_uint(x); u += 0x7fffu + ((u >> 16) & 1u); return (bf16_t)(u >> 16); }
DI float bf2f(bf16_t v) { return __uint_as_float(((unsigned)v) << 16); }
DI float bflo(unsigned u) { return __uint_as_float(u << 16); }
DI float bfhi(unsigned u) { return __uint_as_float(u & 0xffff0000u); }
typedef __bf16 bf16x2_t __attribute__((ext_vector_type(2)));
typedef float f32x2_t __attribute__((ext_vector_type(2)));
DI unsigned pack2(float lo, float hi) { f32x2_t v = {lo, hi}; return __builtin_bit_cast(unsigned, __builtin_convertvector(v, bf16x2_t)); }
DI int crow(int reg, int h) { return (reg & 3) + 8 * (reg >> 2) + 4 * h; }

DI void convert_tile(const float* __restrict__ src, int K, int N, int kt, int nt, bf16_t* __restrict__ dst, int mode, const float* __restrict__ g, float* lds) {
  OPAQUE_TID(tid);
#pragma unroll 4
  for (int i = 0; i < 8; ++i) { int e = tid + 512 * i; int kk = e >> 6, nn = e & 63; lds[kk * 65 + nn] = src[(size_t)(kt * 64 + kk) * N + nt * 64 + nn] * (g ? g[kt * 64 + kk] : 1.f); }
  __syncthreads();
  { const int nn = tid >> 3, kc = tid & 7, n = nt * 64 + nn;
    const int drow = (mode == 0) ? n : ((n >> 7) * 256 + (n & 127) + (mode == 2 ? 128 : 0));
    const float* lp = lds + kc * 8 * 65 + nn;
    uint4 v; v.x = pack2(lp[0], lp[65]); v.y = pack2(lp[130], lp[195]); v.z = pack2(lp[260], lp[325]); v.w = pack2(lp[390], lp[455]);
    *(uint4*)(dst + (size_t)drow * K + kt * 64 + kc * 8) = v; }
  __syncthreads();
}

DI void convert_phase(const Params& p, int layer, float* lds) {
  const int n_in = (layer == 0) ? 2304 : 1536;
  const int t_up = 16 * 44, t_dn = 44 * 16, t_in = 16 * (n_in / 64), t_out = 16 * 16;
  const int total = 4 * t_up + 2 * t_dn + t_in + t_out;
  for (int u = blockIdx.x; u < total; u += gridDim.x) {
    int r = u; const float* src; bf16_t* dst; int K, N, mode; const float* g = nullptr;
    if (r < 6 * t_up) {
      int mtx = r / t_up; r -= mtx * t_up; int f = mtx / 3, which = mtx % 3;
      size_t base = (size_t)(layer * 2 + f) * DM * DFF;
      if (which == 0) { src = p.w1 + base; K = DM; N = DFF; mode = 1; dst = p.wts + (f ? W_UPB : W_UPA); g = p.norm_g + (layer * 3 + (f ? 2 : 0)) * DM; }
      else if (which == 1) { src = p.w3 + base; K = DM; N = DFF; mode = 2; dst = p.wts + (f ? W_UPB : W_UPA); g = p.norm_g + (layer * 3 + (f ? 2 : 0)) * DM; }
      else { src = p.w2 + base; K = DFF; N = DM; mode = 0; dst = p.wts + (f ? W_DNB : W_DNA); }
    } else if (r < 6 * t_up + t_in) {
      r -= 6 * t_up; src = (layer == 0) ? p.ab_w_in : p.c_w_in; K = DM; N = n_in; mode = 0; dst = p.wts + W_IN; g = p.norm_g + (layer * 3 + 1) * DM;
    } else {
      r -= 6 * t_up + t_in; src = (layer == 0) ? p.ab_w_out : p.c_w_out; K = DM; N = DM; mode = 0; dst = p.wts + W_OUT;
    }
    const int ntn = N / 64; const int kt = r / ntn, nt = r % ntn;
    convert_tile(src, K, N, kt, nt, dst, mode, g, lds);
  }
}

DI void init_phase(const Params& p) {
  OPAQUE_TID(tid);
  const int lane = tid & 63, wave = tid >> 6;
  for (int row = blockIdx.x * 8 + wave; row < NTOK; row += gridDim.x * 8) {
    const float* src = (row < PROMPT_T) ? p.x_prompt + (size_t)row * DM : p.x_sample + (size_t)(row - PROMPT_T) * DM;
    float ss = 0.f;
#pragma unroll
    for (int i = 0; i < 4; ++i) { const float4 v = *(const float4*)(src + lane * 4 + 256 * i); ss += v.x * v.x + v.y * v.y + v.z * v.z + v.w * v.w;
      uint2 o2; o2.x = pack2(v.x, v.y); o2.y = pack2(v.z, v.w); *(uint2*)(p.h16 + (size_t)row * DM + lane * 4 + 256 * i) = o2; }
#pragma unroll
    for (int o = 32; o > 0; o >>= 1) ss += __shfl_xor(ss, o);
    if (lane < 16) p.ssq[(size_t)row * 16 + lane] = (lane == 0) ? ss : 0.f;
  }
}
DI void final_norm_phase(const Params& p) {
  OPAQUE_TID(tid);
  const int lane = tid & 63, wave = tid >> 6;
  float4 gv[4];
#pragma unroll
  for (int i = 0; i < 4; ++i) gv[i] = *(const float4*)(p.final_g + lane * 4 + 256 * i);
  for (int row = blockIdx.x * 8 + wave; row < NTOK; row += gridDim.x * 8) {
    float4 v[4]; float ss = 0.f;
#pragma unroll
    for (int i = 0; i < 4; ++i) { const uint2 u = *(const uint2*)(p.xn + (size_t)row * DM + lane * 4 + 256 * i);
      v[i].x = bflo(u.x); v[i].y = bfhi(u.x); v[i].z = bflo(u.y); v[i].w = bfhi(u.y); ss += v[i].x * v[i].x + v[i].y * v[i].y + v[i].z * v[i].z + v[i].w * v[i].w; }
#pragma unroll
    for (int o = 32; o > 0; o >>= 1) ss += __shfl_xor(ss, o);
    const float r = rsqrtf(ss * (1.0f / DM) + EPS);
#pragma unroll
    for (int i = 0; i < 4; ++i) { float4 y; y.x = v[i].x * r * gv[i].x; y.y = v[i].y * r * gv[i].y; y.z = v[i].z * r * gv[i].z; y.w = v[i].w * r * gv[i].w;
      *(float4*)(p.h + (size_t)row * DM + lane * 4 + 256 * i) = y; }
  }
}

typedef float f32x4 __attribute__((ext_vector_type(4)));
typedef unsigned u32x4 __attribute__((ext_vector_type(4)));
#define PG8_LAS __attribute__((address_space(3)))
constexpr int BM = 256, BK = 64, HALF = 128, HTB = HALF * BK * 2, STAGE_B = 4 * HTB, NXCD = 8, WGM = 8;
DI int lds_byte(int r, int c) { const int st = (r >> 4) * 2 + (c >> 5), rr = r & 15, cc = c & 31, ob = rr * 64 + cc * 2; return st * 1024 + (ob ^ (((ob >> 9) & 1) << 5)); }
DI void stage_rc(int b, int& R, int& C) { const int st = b / 1024, sb = b % 1024, swz = sb ^ (((sb >> 9) & 1) << 5); R = (st >> 1) * 16 + swz / 64; C = (st & 1) * 32 + (swz % 64) / 2; }
DI int perm32(int rho) { const int n = rho >> 4, i = rho & 15; return 8 * (i >> 2) + 4 * n + (i & 3); }
struct Unit { int pm, pn; };
struct StaticOrder {
  int nM, nN, nwg, G, c;
  DI void init(int M, int N, int G_, int c_) { nM = M / BM; nN = N / BM; nwg = nM * nN; G = G_; c = c_; }
  DI bool next(int i, Unit& u) const {
    const long L = (long)i * G + c; if (L >= nwg) return false;
    int wgid = (int)L; { const int q = nwg / NXCD, r = nwg % NXCD, xcd = wgid % NXCD, off = wgid / NXCD; wgid = (xcd < r ? xcd * (q + 1) : r * (q + 1) + (xcd - r) * q) + off; }
    const int nig = WGM * nN, gid = wgid / nig, fm = gid * WGM, gsz = (nM - fm) < WGM ? (nM - fm) : WGM;
    u.pm = fm + ((wgid % nig) % gsz); u.pn = (wgid % nig) / gsz; return true;
  }
};
constexpr int RT_OFF = 8 * HTB + 64;
DI void acc_zero(f32x4 (&acc)[2][2][4][2]) {
#pragma unroll
  for (int a = 0; a < 2; ++a)
#pragma unroll
    for (int b = 0; b < 2; ++b)
#pragma unroll
      for (int m = 0; m < 4; ++m)
#pragma unroll
        for (int n = 0; n < 2; ++n) acc[a][b][m][n] = (f32x4){0.f, 0.f, 0.f, 0.f};
}
struct EpiProj {
  static constexpr bool PERM = true, NEEDS_R = true;
  bf16_t* O; int ldc; const float* ssq;
  DI void init(f32x4 (&acc)[2][2][4][2], const Unit&, int, int, int, int) const { acc_zero(acc); }
  DI void operator()(const f32x4 (&acc)[2][2][4][2], const Unit& u, int wr, int wc, int fr, int fq, const PG8_LAS float* rt) const {
    const int row0 = u.pm * BM + wr * 64 + fr, col0 = u.pn * BM + wc * 32 + 8 * fq;
#pragma unroll
    for (int ai = 0; ai < 2; ++ai)
#pragma unroll
      for (int m = 0; m < 4; ++m) { bf16_t* rowp = O + (size_t)(row0 + ai * HALF + m * 16) * ldc + col0; const float r = rt[ai * HALF + wr * 64 + m * 16 + fr];
#pragma unroll
        for (int bj = 0; bj < 2; ++bj) { const f32x4 v0 = acc[ai][bj][m][0] * r, v1 = acc[ai][bj][m][1] * r;
          u32x4 w; w.x = pack2(v0[0], v0[1]); w.y = pack2(v0[2], v0[3]); w.z = pack2(v1[0], v1[1]); w.w = pack2(v1[2], v1[3]);
          *(u32x4*)(rowp + bj * HALF) = w; } }
  }
};
struct EpiUp {
  static constexpr bool PERM = true, NEEDS_R = true;
  bf16_t* O; const float* ssq;
  DI void init(f32x4 (&acc)[2][2][4][2], const Unit&, int, int, int, int) const { acc_zero(acc); }
  DI void operator()(const f32x4 (&acc)[2][2][4][2], const Unit& u, int wr, int wc, int fr, int fq, const PG8_LAS float* rt) const {
    const int row0 = u.pm * BM + wr * 64 + fr, col0 = u.pn * HALF + wc * 32 + 8 * fq;
#pragma unroll
    for (int ai = 0; ai < 2; ++ai)
#pragma unroll
      for (int m = 0; m < 4; ++m) {
        const float r = rt[ai * HALF + wr * 64 + m * 16 + fr];
        float a[8];
#pragma unroll
        for (int n = 0; n < 2; ++n)
#pragma unroll
          for (int j = 0; j < 4; ++j) { const float u1 = acc[ai][0][m][n][j] * r, u3 = acc[ai][1][m][n][j] * r; a[4 * n + j] = u1 * u3 * __builtin_amdgcn_rcpf(1.f + __builtin_amdgcn_exp2f(-LOG2E * u1)); }
        u32x4 w; w.x = pack2(a[0], a[1]); w.y = pack2(a[2], a[3]); w.z = pack2(a[4], a[5]); w.w = pack2(a[6], a[7]);
        *(u32x4*)(O + (size_t)(row0 + ai * HALF + m * 16) * DFF + col0) = w; }
  }
};
struct EpiResid {
  static constexpr bool PERM = true, NEEDS_R = false;
  const bf16_t* src; bf16_t* dst; float coef; float* ssq;
  DI void init(f32x4 (&acc)[2][2][4][2], const Unit& u, int wr, int wc, int fr, int fq) const {
    const int row0 = u.pm * BM + wr * 64 + fr, col0 = u.pn * BM + wc * 32 + 8 * fq; const float ic = 1.f / coef;
#pragma unroll
    for (int ai = 0; ai < 2; ++ai)
#pragma unroll
      for (int m = 0; m < 4; ++m) { const bf16_t* rowp = src + (size_t)(row0 + ai * HALF + m * 16) * DM + col0;
#pragma unroll
        for (int bj = 0; bj < 2; ++bj) { const u32x4 w = *(const u32x4*)(rowp + bj * HALF);
          acc[ai][bj][m][0] = (f32x4){bflo(w.x), bfhi(w.x), bflo(w.y), bfhi(w.y)} * ic; acc[ai][bj][m][1] = (f32x4){bflo(w.z), bfhi(w.z), bflo(w.w), bfhi(w.w)} * ic; } }
  }
  DI void operator()(const f32x4 (&acc)[2][2][4][2], const Unit& u, int wr, int wc, int fr, int fq, const PG8_LAS float*) const {
    const int row0 = u.pm * BM + wr * 64 + fr, col0 = u.pn * BM + wc * 32 + 8 * fq;
#pragma unroll
    for (int ai = 0; ai < 2; ++ai)
#pragma unroll
      for (int m = 0; m < 4; ++m) { const int row = row0 + ai * HALF + m * 16; bf16_t* rowp = dst + (size_t)row * DM + col0; float ss = 0.f;
#pragma unroll
        for (int bj = 0; bj < 2; ++bj) { const f32x4 v0 = acc[ai][bj][m][0] * coef, v1 = acc[ai][bj][m][1] * coef;
          ss += v0[0] * v0[0] + v0[1] * v0[1] + v0[2] * v0[2] + v0[3] * v0[3] + v1[0] * v1[0] + v1[1] * v1[1] + v1[2] * v1[2] + v1[3] * v1[3];
          u32x4 w; w.x = pack2(v0[0], v0[1]); w.y = pack2(v0[2], v0[3]); w.z = pack2(v1[0], v1[1]); w.w = pack2(v1[2], v1[3]);
          *(u32x4*)(rowp + bj * HALF) = w; }
        ss += __shfl_xor(ss, 16); ss += __shfl_xor(ss, 32);
        if (fq == 0) ssq[(size_t)row * 16 + u.pn * 4 + wc] = ss; }
  }
};

template <class Epi>
DI void gemm_phase(const bf16_t* __restrict__ gA, const bf16_t* __restrict__ gBt, int M, int N, int K, const Epi& E, char* lds_generic) {
  PG8_LAS unsigned char* lds = (PG8_LAS unsigned char*)lds_generic;
  OPAQUE_TID(tid);
  const int wid = __builtin_amdgcn_readfirstlane(tid >> 6), lane = tid & 63, wr = wid >> 2, wc = wid & 3, fr = lane & 15, fq = lane >> 4;
  const int nt = K / BK;
  StaticOrder S; S.init(M, N, gridDim.x, blockIdx.x);
  unsigned voffA[2], voffB[2];
#pragma unroll
  for (int i = 0; i < 2; ++i) { int R, C; stage_rc(tid * 16 + i * 8192, R, C); const int Rb = Epi::PERM ? ((R & ~31) + perm32(R & 31)) : R;
    voffA[i] = (unsigned)(R * K + C) * 2u; voffB[i] = (unsigned)(Rb * K + C) * 2u; }
  const size_t kstep = (size_t)(BK * 2);
  const size_t hstep = (size_t)HALF * K * 2;
  const size_t tstep = 2 * hstep;
  const unsigned ldsw = (unsigned)wid * 1024u;
  const int aoff = lds_byte(wr * 64 + fr, fq * 8), boff = lds_byte(wc * 32 + fr, fq * 8);
#define PG8_SA(b, h) (((b) * 2 + (h)) * HTB)
#define PG8_SB(b, h) ((4 + (b) * 2 + (h)) * HTB)
#define PG8_STAGE(bufoff, gbase, voff) do { _Pragma("unroll") for (int _i = 0; _i < 2; ++_i) \
    __builtin_amdgcn_global_load_lds((const unsigned*)((const char*)(gbase) + (voff)[_i]), (PG8_LAS unsigned*)(lds + (bufoff) + ldsw + _i * 8192), 16, 0, 0); } while (0)
#define PG8_LDA(dst, b, h) do { _Pragma("unroll") for (int m = 0; m < 4; ++m) _Pragma("unroll") for (int k = 0; k < 2; ++k) dst[m][k] = *(const PG8_LAS bf16x8*)(lds + PG8_SA(b, h) + aoff + m * 2048 + k * 1024); } while (0)
#define PG8_LDB(dst, b, h) do { _Pragma("unroll") for (int n = 0; n < 2; ++n) _Pragma("unroll") for (int k = 0; k < 2; ++k) dst[n][k] = *(const PG8_LAS bf16x8*)(lds + PG8_SB(b, h) + boff + n * 2048 + k * 1024); } while (0)
#define PG8_MMA(ai, bj, At, Bt) do { __builtin_amdgcn_s_setprio(1); _Pragma("unroll") for (int m = 0; m < 4; ++m) _Pragma("unroll") for (int n = 0; n < 2; ++n) _Pragma("unroll") for (int k = 0; k < 2; ++k) \
    acc[ai][bj][m][n] = __builtin_amdgcn_mfma_f32_16x16x32_bf16(Bt[n][k], At[m][k], acc[ai][bj][m][n], 0, 0, 0); __builtin_amdgcn_s_setprio(0); } while (0)
#define PG8_WAIT_V(n) asm volatile("s_waitcnt vmcnt(" #n ")" ::: "memory")
#define PG8_WAIT_L(n) asm volatile("s_waitcnt lgkmcnt(" #n ")" ::: "memory")
#define PG8_BAR __builtin_amdgcn_s_barrier()
#define PG8_SCHED __builtin_amdgcn_sched_barrier(0)
  Unit cur, nxt; int ui = 0;
  if (!S.next(0, cur)) return;
  f32x4 acc[2][2][4][2];
  E.init(acc, cur, wr, wc, fr, fq);
#define PG8_RTAB(unit, buf) do { if constexpr (Epi::NEEDS_R) { const int rr_ = tid >> 1, hf_ = tid & 1; \
    const float4* sp_ = (const float4*)(E.ssq + (size_t)((unit).pm * BM + rr_) * 16 + hf_ * 8); const float4 a_ = sp_[0], b_ = sp_[1]; \
    float ss_ = a_.x + a_.y + a_.z + a_.w + b_.x + b_.y + b_.z + b_.w; ss_ += __shfl_xor(ss_, 1); \
    if (!hf_) ((PG8_LAS float*)(lds + RT_OFF))[(buf) * 256 + rr_] = rsqrtf(ss_ * (1.0f / DM) + EPS); } } while (0)
  PG8_RTAB(cur, 0);
  bf16x8 At[4][2], B0[2][2], B1[2][2];
  const char* cA = (const char*)gA + (size_t)cur.pm * tstep; const char* cB = (const char*)gBt + (size_t)cur.pn * tstep;
  PG8_STAGE(PG8_SB(0, 0), cB, voffB); PG8_STAGE(PG8_SA(0, 0), cA, voffA); PG8_STAGE(PG8_SB(0, 1), cB + hstep, voffB); PG8_STAGE(PG8_SA(0, 1), cA + hstep, voffA);
  if (wr == 1) PG8_BAR;
  PG8_WAIT_V(4); PG8_BAR;
  PG8_STAGE(PG8_SB(1, 0), cB + kstep, voffB); PG8_STAGE(PG8_SA(1, 0), cA + kstep, voffA); PG8_STAGE(PG8_SB(1, 1), cB + hstep + kstep, voffB);
  PG8_WAIT_V(6); PG8_BAR;
  for (;;) {
    const bool has_next = S.next(ui + 1, nxt);
    const char* nA = has_next ? (const char*)gA + (size_t)nxt.pm * tstep : cA; const char* nB = has_next ? (const char*)gBt + (size_t)nxt.pn * tstep : cB;
    for (int t = 0; t < nt; t += 2) {
      const bool last = (t == nt - 2);
      const char* a1 = cA + (size_t)(t + 1) * kstep;
      const char* a2 = last ? nA : cA + (size_t)(t + 2) * kstep; const char* b2 = last ? nB : cB + (size_t)(t + 2) * kstep;
      const char* a3 = a2 + kstep; const char* b3 = b2 + kstep;
      PG8_LDB(B0, 0, 0); PG8_SCHED; PG8_LDA(At, 0, 0); PG8_STAGE(PG8_SA(1, 1), a1 + hstep, voffA);
      PG8_WAIT_L(8); PG8_BAR; PG8_WAIT_L(0); PG8_MMA(0, 0, At, B0); PG8_BAR; PG8_SCHED;
      PG8_LDB(B1, 0, 1); PG8_STAGE(PG8_SB(0, 0), b2, voffB);
      PG8_BAR; PG8_WAIT_L(0); PG8_MMA(0, 1, At, B1); PG8_BAR;
      PG8_LDA(At, 0, 1); PG8_STAGE(PG8_SA(0, 0), a2, voffA);
      PG8_BAR; PG8_WAIT_L(0); PG8_MMA(1, 0, At, B0); PG8_BAR; PG8_SCHED;
      PG8_STAGE(PG8_SB(0, 1), b2 + hstep, voffB);
      PG8_WAIT_V(6); PG8_BAR; PG8_MMA(1, 1, At, B1); PG8_BAR;
      PG8_LDB(B0, 1, 0); PG8_SCHED; PG8_LDA(At, 1, 0); PG8_STAGE(PG8_SA(0, 1), a2 + hstep, voffA);
      PG8_WAIT_L(8); PG8_BAR; PG8_WAIT_L(0); PG8_MMA(0, 0, At, B0); PG8_BAR; PG8_SCHED;
      PG8_LDB(B1, 1, 1); PG8_STAGE(PG8_SB(1, 0), b3, voffB);
      PG8_BAR; PG8_WAIT_L(0); PG8_MMA(0, 1, At, B1); PG8_BAR;
      PG8_LDA(At, 1, 1); PG8_STAGE(PG8_SA(1, 0), a3, voffA);
      PG8_BAR; PG8_WAIT_L(0); PG8_MMA(1, 0, At, B0); PG8_BAR; PG8_SCHED;
      PG8_STAGE(PG8_SB(1, 1), b3 + hstep, voffB);
      PG8_WAIT_V(6); PG8_BAR; PG8_MMA(1, 1, At, B1); PG8_BAR;
    }
    E(acc, cur, wr, wc, fr, fq, (const PG8_LAS float*)(lds + RT_OFF) + (ui & 1) * 256);
    if (!has_next) break;
    E.init(acc, nxt, wr, wc, fr, fq);
    PG8_RTAB(nxt, (ui + 1) & 1);
    cur = nxt; cA = nA; cB = nB; ++ui;
  }
  PG8_WAIT_V(0);
  if (wr == 0) PG8_BAR;
  PG8_BAR;
#undef PG8_RTAB
#undef PG8_SA
#undef PG8_SB
#undef PG8_STAGE
#undef PG8_LDA
#undef PG8_LDB
#undef PG8_MMA
#undef PG8_WAIT_V
#undef PG8_WAIT_L
#undef PG8_BAR
#undef PG8_SCHED
}

DI void bprep_phase(const Params& p) {
  OPAQUE_TID(tid);
  const int pi = tid & 31, tl = tid >> 5;
  const float fr = exp2f(-(float)((pi & 15) * 2) * (1.0f / 32.0f) * 13.287712379549449f);
  const float qg0 = p.ab_qg[2 * pi], qg1 = p.ab_qg[2 * pi + 1], kg0 = p.ab_kg[2 * pi], kg1 = p.ab_kg[2 * pi + 1];
  for (int t = blockIdx.x * 16 + tl; t < NTOK; t += gridDim.x * 16) {
    const int pos = (t < PROMPT_T) ? t : ((t - PROMPT_T) & (SAMPLE_T - 1));
    const float ang = (float)((pi < 16) ? (pos >> 6) : (pos & 63)) * fr;
    const float cs = __cosf(ang), sn = __sinf(ang);
    unsigned* rowp = (unsigned*)(p.big + (size_t)t * 2304);
#pragma unroll
    for (int hd = 0; hd < 10; ++hd) {
      const int col = (hd < 8) ? (1536 + hd * 64) : (2048 + (hd - 8) * 64);
      unsigned u = rowp[(col >> 1) + pi];
      float x1 = bflo(u), x2 = bfhi(u);
      float ss = x1 * x1 + x2 * x2;
#pragma unroll
      for (int o = 16; o > 0; o >>= 1) ss += __shfl_xor(ss, o);
      const float r = rsqrtf(ss * (1.0f / 64.0f) + EPS);
      x1 = x1 * r * ((hd < 8) ? qg0 : kg0); x2 = x2 * r * ((hd < 8) ? qg1 : kg1);
      rowp[(col >> 1) + pi] = pack2(x1 * cs - x2 * sn, x1 * sn + x2 * cs);
    }
  }
}

template <int MODE>
DI void naive_attn(const Params& p, const bf16_t* __restrict__ proj, int ld, int qoff, int koff, int voff, int nqh, int G, bf16_t* cat, int cat_off) {
  const int total = NTOK * nqh;
  for (int idx = blockIdx.x * 256 + threadIdx.x; idx < total; idx += gridDim.x * 256) {
    const int head = idx / NTOK, t = idx % NTOK, hk = head / G;
    const int seq_base = (t < PROMPT_T) ? 0 : (PROMPT_T + ((t - PROMPT_T) / SAMPLE_T) * SAMPLE_T);
    const int T = (t < PROMPT_T) ? PROMPT_T : SAMPLE_T;
    const int pos = t - seq_base;
    float q[64], o[64];
    { const uint4* qp = (const uint4*)(proj + (size_t)t * ld + qoff + head * 64);
#pragma unroll
      for (int c = 0; c < 8; ++c) { uint4 v = qp[c]; q[8*c] = bflo(v.x); q[8*c+1] = bfhi(v.x); q[8*c+2] = bflo(v.y); q[8*c+3] = bfhi(v.y); q[8*c+4] = bflo(v.z); q[8*c+5] = bfhi(v.z); q[8*c+6] = bflo(v.w); q[8*c+7] = bfhi(v.w); } }
#pragma unroll
    for (int d = 0; d < 64; ++d) o[d] = 0.f;
    float m = -1e30f, l = 0.f, slope = 0.f;
    if (MODE == 0) slope = exp2f(-(float)(head + 1));
    if (MODE == 2) { slope = exp2f(-0.5f * (float)(head + 1)); m = p.c_sink[head]; l = 1.f; }
    const int nkeys = (MODE == 0) ? 387 : (MODE == 1 ? T : 257);
    for (int j = 0; j < nkeys; ++j) {
      int off;
      if (MODE == 0) { const int br = j / 129, jj = j % 129 - 64; off = jj * (br == 0 ? 1 : (br == 1 ? 4 : 16)); }
      else if (MODE == 1) off = j - pos;
      else off = j - 128;
      const int kp = pos + off;
      if (kp < 0 || kp >= T) continue;
      const uint4* kptr = (const uint4*)(proj + (size_t)(seq_base + kp) * ld + koff + hk * 64);
      float s = 0.f;
#pragma unroll
      for (int c = 0; c < 8; ++c) { uint4 v = kptr[c];
        s += q[8*c] * bflo(v.x) + q[8*c+1] * bfhi(v.x) + q[8*c+2] * bflo(v.y) + q[8*c+3] * bfhi(v.y) + q[8*c+4] * bflo(v.z) + q[8*c+5] * bfhi(v.z) + q[8*c+6] * bflo(v.w) + q[8*c+7] * bfhi(v.w); }
      s *= 0.125f;
      if (MODE != 1) s -= slope * fabsf((float)off);
      const float mn = fmaxf(m, s); const float al = __expf(m - mn), pw = __expf(s - mn);
      m = mn; l = l * al + pw;
      const uint4* vptr = (const uint4*)(proj + (size_t)(seq_base + kp) * ld + voff + hk * 64);
#pragma unroll
      for (int c = 0; c < 8; ++c) { uint4 v = vptr[c];
        o[8*c] = o[8*c] * al + pw * bflo(v.x); o[8*c+1] = o[8*c+1] * al + pw * bfhi(v.x); o[8*c+2] = o[8*c+2] * al + pw * bflo(v.y); o[8*c+3] = o[8*c+3] * al + pw * bfhi(v.y);
        o[8*c+4] = o[8*c+4] * al + pw * bflo(v.z); o[8*c+5] = o[8*c+5] * al + pw * bfhi(v.z); o[8*c+6] = o[8*c+6] * al + pw * bflo(v.w); o[8*c+7] = o[8*c+7] * al + pw * bfhi(v.w); }
    }
    const float inv = 1.f / l;
    uint4* op = (uint4*)(cat + (size_t)t * DM + cat_off + head * 64);
#pragma unroll
    for (int c = 0; c < 8; ++c) { uint4 v; v.x = pack2(o[8*c] * inv, o[8*c+1] * inv); v.y = pack2(o[8*c+2] * inv, o[8*c+3] * inv); v.z = pack2(o[8*c+4] * inv, o[8*c+5] * inv); v.w = pack2(o[8*c+6] * inv, o[8*c+7] * inv); op[c] = v; }
  }
}

typedef short s16x4 __attribute__((ext_vector_type(4)));
typedef __attribute__((address_space(3))) s16x4* lds_s16x4_ptr;
DI s16x4 vtr(const char* p) { return __builtin_amdgcn_ds_read_tr16_b64_v4i16((lds_s16x4_ptr)p); }

template <int MODE, int NQ, int TS>
DI void attn_unit(const bf16_t* __restrict__ proj, int ld, int seq_base, int kt0, int kt1, int koff, int voff,
                  int q0w, int qoff, int ooff, float slope2, float sink2, bf16_t* __restrict__ cat, char* lds, float* part_o, float* part_ml) {
  OPAQUE_TID(tid);
  const int lane = tid & 63, wave = tid >> 6, r32 = lane & 31, hh = lane >> 5;
  constexpr float C2 = 0.125f * LOG2E;
  constexpr int NS = 6;
  bf16x8 qf[NQ][4];
#pragma unroll
  for (int nq = 0; nq < NQ; ++nq) { const bf16_t* qp = proj + (size_t)(seq_base + TS * (q0w + 32 * nq + r32)) * ld + qoff + hh * 8;
#pragma unroll
    for (int ks = 0; ks < 4; ++ks) qf[nq][ks] = *(const bf16x8*)(qp + ks * 16); }
  f32x16 o[NQ][2];
  float m2[NQ], l[NQ];
#pragma unroll
  for (int nq = 0; nq < NQ; ++nq) {
    if (MODE == 0) {
      const size_t tok = (size_t)(seq_base + q0w + 32 * nq + r32);
      const float* po = part_o + tok * 512 + ooff + 4 * hh; const float* pm = part_ml + (tok * 8 + (ooff >> 6)) * 2;
      m2[nq] = pm[0]; l[nq] = hh ? 0.f : pm[1];
#pragma unroll
      for (int g = 0; g < 4; ++g) { const float4 a = *(const float4*)(po + 8 * g), b = *(const float4*)(po + 32 + 8 * g);
        o[nq][0][4 * g] = a.x; o[nq][0][4 * g + 1] = a.y; o[nq][0][4 * g + 2] = a.z; o[nq][0][4 * g + 3] = a.w;
        o[nq][1][4 * g] = b.x; o[nq][1][4 * g + 1] = b.y; o[nq][1][4 * g + 2] = b.z; o[nq][1][4 * g + 3] = b.w; }
    } else {
      m2[nq] = (MODE == 2) ? sink2 : -1e30f; l[nq] = 0.f;
#pragma unroll
      for (int r = 0; r < 16; ++r) { o[nq][0][r] = 0.f; o[nq][1][r] = 0.f; }
    }
  }
  PG8_LAS unsigned char* L = (PG8_LAS unsigned char*)lds;
  const int kkey_ = wave * 8 + (lane >> 3);
  const bf16_t* kg = proj + (size_t)(seq_base + TS * kkey_) * ld + koff + (((lane & 7) ^ ((kkey_ >> 1) & 7)) * 8);
  const bf16_t* vg = proj + (size_t)(seq_base + TS * ((wave & 3) * 16 + (lane >> 2))) * ld + voff + ((wave >> 2) * 4 + (lane & 3)) * 8;
  const unsigned sdst = (unsigned)__builtin_amdgcn_readfirstlane(wave * 1024);
#define ATT_ISSUE(tile, slot) do { const size_t go_ = (size_t)(tile) * 64 * TS * ld; \
    __builtin_amdgcn_global_load_lds((const unsigned*)(kg + go_), (PG8_LAS unsigned*)(L + (slot) * 16384 + sdst), 16, 0, 0); \
    __builtin_amdgcn_global_load_lds((const unsigned*)(vg + go_), (PG8_LAS unsigned*)(L + (slot) * 16384 + 8192 + sdst), 16, 0, 0); } while (0)
  const int ktl = kt1 - 1;
  constexpr int TAB_OFF = 6 * 16384, TAB_N = (MODE == 3) ? 640 : 1024, TAB_ZERO = TAB_N / 2;
  if (MODE == 0 || MODE == 3) {
    float* tab = (float*)(lds + TAB_OFF);
    for (int e = tid; e < TAB_N; e += 512) {
      const int oo = e - TAB_ZERO, aa = oo < 0 ? -oo : oo;
      if (MODE == 0) {
        const int c = (aa <= 64 ? 1 : 0) + (((oo & 3) == 0 && aa <= 256) ? 1 : 0) + (((oo & 15) == 0 && aa <= 256) ? 1 : 0);
        tab[e] = c ? (-slope2 * (float)aa + (c == 1 ? 0.f : (c == 2 ? 1.f : 1.5849625007f))) : -1e30f;
      } else {
        tab[e] = (aa >= 17 && aa <= 64) ? -slope2 * (float)(16 * aa) : -1e30f;
      }
    }
  }
  if (MODE == 2) {
    float* tab = (float*)(lds + TAB_OFF) + (wave & 3) * 384;
#pragma unroll
    for (int i = 0; i < 3; ++i) { const int e = (wave >> 2) * 64 + lane + 128 * i; const int oo = e - 192, aa = oo < 0 ? -oo : oo; tab[e] = (aa <= 128) ? -slope2 * (float)aa : -1e30f; }
  }
  ATT_ISSUE(kt0, 0); ATT_ISSUE((kt0 + 1 < ktl ? kt0 + 1 : ktl), 1); ATT_ISSUE((kt0 + 2 < ktl ? kt0 + 2 : ktl), 2); ATT_ISSUE((kt0 + 3 < ktl ? kt0 + 3 : ktl), 3);
  asm volatile("s_waitcnt vmcnt(6) lgkmcnt(0)\n\ts_barrier" ::: "memory");
  int kfo4[4];
#pragma unroll
  for (int ks = 0; ks < 4; ++ks) kfo4[ks] = r32 * 128 + (((2 * ks + hh) ^ ((r32 >> 1) & 7)) << 4);
  const int vfo = 8192 + (4 * hh + ((lane & 15) >> 2)) * 64 + ((lane >> 4) & 1) * 32 + (lane & 3) * 8;
  const bool g2 = wave >= 4;
  f32x16 s[NQ][2];
  bf16x8 pf[NQ][4];
  constexpr int WIN = (MODE == 0) ? 256 : 64;
  auto tile_active = [&](int kt) -> bool { return (MODE != 0 && MODE != 3) || ((kt * 64 + 63 >= q0w - WIN) && (kt * 64 <= q0w + 32 * NQ - 1 + WIN)); };
  auto QK = [&](int slot) {
    const char* kb_ = lds + slot * 16384;
#pragma unroll
    for (int nq = 0; nq < NQ; ++nq)
#pragma unroll
      for (int r = 0; r < 16; ++r) { s[nq][0][r] = 0.f; s[nq][1][r] = 0.f; }
#pragma unroll
    for (int ks = 0; ks < 4; ++ks) {
      const bf16x8 k0 = *(const bf16x8*)(kb_ + kfo4[ks]), k1 = *(const bf16x8*)(kb_ + kfo4[ks] + 4096);
#pragma unroll
      for (int nq = 0; nq < NQ; ++nq) { s[nq][0] = MFMA32(k0, qf[nq][ks], s[nq][0]); s[nq][1] = MFMA32(k1, qf[nq][ks], s[nq][1]); }
    }
  };
  auto SM = [&](int kt) {
#pragma unroll
    for (int nq = 0; nq < NQ; ++nq) {
      f32x16& s0 = s[nq][0]; f32x16& s1 = s[nq][1];
      float mx = -1e30f;
      if (MODE == 1) {
      } else if (MODE == 0 || MODE == 3) {
        const float* tb = (const float*)(lds + TAB_OFF) + (kt * 64 + 4 * hh - (q0w + 32 * nq + r32) + TAB_ZERO);
#pragma unroll
        for (int r = 0; r < 16; ++r) {
          const float va = fmaf(s0[r], C2, tb[(r & 3) + 8 * (r >> 2)]), vb = fmaf(s1[r], C2, tb[(r & 3) + 8 * (r >> 2) + 32]);
          s0[r] = va; s1[r] = vb; mx = fmaxf(mx, fmaxf(va, vb));
        }
      } else {
        const float* tb = (const float*)(lds + TAB_OFF) + (wave & 3) * 384 + (kt * 64 + 4 * hh - (q0w + 32 * nq + r32) + 192);
#pragma unroll
        for (int r = 0; r < 16; ++r) {
          const float va = fmaf(s0[r], C2, tb[(r & 3) + 8 * (r >> 2)]), vb = fmaf(s1[r], C2, tb[(r & 3) + 8 * (r >> 2) + 32]);
          s0[r] = va; s1[r] = vb; mx = fmaxf(mx, fmaxf(va, vb));
        }
      }
      float mn;
      if (MODE == 1) {
        mn = sink2;
      } else {
        if (__any(mx > m2[nq] + 8.f)) {
          mx = fmaxf(mx, __shfl_xor(mx, 32));
          mn = fmaxf(m2[nq], mx);
          const float alpha = __builtin_amdgcn_exp2f(m2[nq] - mn);
          l[nq] *= alpha;
#pragma unroll
          for (int r = 0; r < 16; ++r) { o[nq][0][r] *= alpha; o[nq][1][r] *= alpha; }
          m2[nq] = mn;
        }
        mn = m2[nq];
      }
      float ls = 0.f;
#pragma unroll
      for (int r = 0; r < 16; ++r) {
        float pa, pb;
        if (MODE == 1) { pa = __builtin_amdgcn_exp2f(fmaf(s0[r], C2, -mn)); pb = __builtin_amdgcn_exp2f(fmaf(s1[r], C2, -mn)); }
        else { pa = __builtin_amdgcn_exp2f(s0[r] - mn); pb = __builtin_amdgcn_exp2f(s1[r] - mn); }
        s0[r] = pa; s1[r] = pb; ls += pa + pb;
      }
      l[nq] += ls;
#pragma unroll
      for (int ks = 0; ks < 4; ++ks) {
        uint4 t4;
        const int rb = 8 * (ks & 1);
        if (ks < 2) { t4.x = pack2(s0[rb], s0[rb + 1]); t4.y = pack2(s0[rb + 2], s0[rb + 3]); t4.z = pack2(s0[rb + 4], s0[rb + 5]); t4.w = pack2(s0[rb + 6], s0[rb + 7]); }
        else { t4.x = pack2(s1[rb], s1[rb + 1]); t4.y = pack2(s1[rb + 2], s1[rb + 3]); t4.z = pack2(s1[rb + 4], s1[rb + 5]); t4.w = pack2(s1[rb + 6], s1[rb + 7]); }
        pf[nq][ks] = __builtin_bit_cast(bf16x8, t4);
      }
    }
  };
  auto PV = [&](int slot) {
    const char* vb_ = lds + slot * 16384 + vfo;
#pragma unroll
    for (int ks = 0; ks < 4; ++ks) {
      const s16x4 a0 = vtr(vb_ + ks * 1024), a1 = vtr(vb_ + ks * 1024 + 512);
      const s16x4 b0 = vtr(vb_ + 4096 + ks * 1024), b1 = vtr(vb_ + 4096 + ks * 1024 + 512);
      const bf16x8 v0 = __builtin_shufflevector(a0, a1, 0, 1, 2, 3, 4, 5, 6, 7);
      const bf16x8 v1 = __builtin_shufflevector(b0, b1, 0, 1, 2, 3, 4, 5, 6, 7);
#pragma unroll
      for (int nq = 0; nq < NQ; ++nq) { o[nq][0] = MFMA32(v0, pf[nq][ks], o[nq][0]); o[nq][1] = MFMA32(v1, pf[nq][ks], o[nq][1]); }
    }
  };
  int slot = 0, sp = 0;
  for (int kt = kt0; kt < kt1; ++kt) {
    { const int tn = (kt + 4 < ktl) ? kt + 4 : ktl; int s4 = slot + 4; if (s4 >= NS) s4 -= NS; ATT_ISSUE(tn, s4); }
    const bool act = tile_active(kt);
    if (!g2) {
      if (act) { QK(slot); SM(kt); PV(slot); }
    } else {
      if (kt > kt0 && tile_active(kt - 1)) PV(sp);
      if (act) { QK(slot); SM(kt); }
    }
    asm volatile("s_waitcnt vmcnt(6) lgkmcnt(0)\n\ts_barrier" ::: "memory");
    sp = slot; slot = (slot + 1 == NS) ? 0 : slot + 1;
  }
  if (g2 && tile_active(ktl)) PV(sp);
  asm volatile("s_waitcnt vmcnt(0)\n\ts_barrier" ::: "memory");
#undef ATT_ISSUE
  if (MODE == 3) {
#pragma unroll
    for (int nq = 0; nq < NQ; ++nq) {
      const float lt = l[nq] + __shfl_xor(l[nq], 32);
      const size_t tok = (size_t)(seq_base + TS * (q0w + 32 * nq + r32));
      float* po = part_o + tok * 512 + ooff + 4 * hh; float* pm = part_ml + (tok * 8 + (ooff >> 6)) * 2;
      if (hh == 0) { pm[0] = m2[nq]; pm[1] = lt; }
#pragma unroll
      for (int g = 0; g < 4; ++g) {
        *(float4*)(po + 8 * g) = make_float4(o[nq][0][4 * g], o[nq][0][4 * g + 1], o[nq][0][4 * g + 2], o[nq][0][4 * g + 3]);
        *(float4*)(po + 32 + 8 * g) = make_float4(o[nq][1][4 * g], o[nq][1][4 * g + 1], o[nq][1][4 * g + 2], o[nq][1][4 * g + 3]);
      }
    }
    return;
  }
#pragma unroll
  for (int nq = 0; nq < NQ; ++nq) {
    float lt = l[nq] + __shfl_xor(l[nq], 32);
    if (MODE == 2) lt += __builtin_amdgcn_exp2f(sink2 - m2[nq]);
    const float inv = 1.f / lt;
    bf16_t* op = cat + (size_t)(seq_base + q0w + 32 * nq + r32) * DM + ooff + 4 * hh;
#pragma unroll
    for (int g = 0; g < 4; ++g) {
      uint2 a, b;
      a.x = pack2(o[nq][0][4 * g] * inv, o[nq][0][4 * g + 1] * inv); a.y = pack2(o[nq][0][4 * g + 2] * inv, o[nq][0][4 * g + 3] * inv);
      b.x = pack2(o[nq][1][4 * g] * inv, o[nq][1][4 * g + 1] * inv); b.y = pack2(o[nq][1][4 * g + 2] * inv, o[nq][1][4 * g + 3] * inv);
      *(uint2*)(op + 8 * g) = a; *(uint2*)(op + 32 + 8 * g) = b;
    }
  }
}

DI void attn_far_phase(const Params& p, char* lds) {
  OPAQUE_TID(tid0);
  const int wave = tid0 >> 6;
  float* part_o = p.h + (size_t)NTOK * 512;
  float* part_ml = (float*)(p.big + (size_t)NTOK * 2304);
  for (int u = blockIdx.x; u < 1024; u += gridDim.x) {
    const int head = u >> 7, v = u & 127;
    int seq_base, T16, rho, n0;
    if (v < 64) { seq_base = 0; T16 = PROMPT_T / 16; rho = v >> 2; n0 = (v & 3) * 256; }
    else { const int w = v - 64; seq_base = PROMPT_T + (w >> 4) * SAMPLE_T; T16 = SAMPLE_T / 16; rho = w & 15; n0 = 0; }
    int kt0 = (n0 - 64) >> 6; if (kt0 < 0) kt0 = 0;
    int kt1 = ((n0 + 255 + 64) >> 6) + 1; if (kt1 > (T16 >> 6)) kt1 = T16 >> 6;
    attn_unit<3, 1, 16>(p.big, 2304, seq_base + rho, kt0, kt1, 512 + head * 64, 1024 + head * 64, n0 + wave * 32, head * 64, head * 64,
                        exp2f(-(float)(head + 1)) * LOG2E, 0.f, p.xn, lds, part_o, part_ml);
  }
}

DI void attn_phase_l0(const Params& p, char* lds) {
  OPAQUE_TID(tid0);
  const int wave = tid0 >> 6;
  float* part_o = p.h + (size_t)NTOK * 512;
  float* part_ml = (float*)(p.big + (size_t)NTOK * 2304);
  float mref;
  { float gq = fabsf(p.ab_qg[tid0 & 63]), gk = fabsf(p.ab_kg[tid0 & 63]);
#pragma unroll
    for (int o = 32; o > 0; o >>= 1) { gq = fmaxf(gq, __shfl_xor(gq, o)); gk = fmaxf(gk, __shfl_xor(gk, o)); }
    mref = 8.f * gq * gk * LOG2E; }
  for (int u = blockIdx.x; u < 1536; u += gridDim.x) {
    if (u < 512) {
      int seq_base, T, kvh, qt;
      if (u < 256) { seq_base = 0; T = PROMPT_T; kvh = u >> 7; qt = u & 127; }
      else { const int v = u - 256; seq_base = PROMPT_T + (v >> 6) * SAMPLE_T; T = SAMPLE_T; kvh = (v >> 5) & 1; qt = v & 31; }
      const int head = kvh * 4 + (wave & 3);
      attn_unit<1, 2, 1>(p.big, 2304, seq_base, 0, T >> 6, 2048 + kvh * 64, 2176 + kvh * 64, qt * 128 + (wave >> 2) * 64, 1536 + head * 64, 512 + head * 64, 0.f, mref, p.xn, lds, nullptr, nullptr);
    } else {
      const int v = u - 512, head = v >> 7, tok0 = (v & 127) * 256;
      const int seq_base = (tok0 < PROMPT_T) ? 0 : (PROMPT_T + ((tok0 - PROMPT_T) / SAMPLE_T) * SAMPLE_T);
      const int T = (tok0 < PROMPT_T) ? PROMPT_T : SAMPLE_T;
      const int q0b = tok0 - seq_base;
      int kt0 = (q0b - 256) >> 6; if (kt0 < 0) kt0 = 0;
      int kt1 = ((q0b + 255 + 256) >> 6) + 1; if (kt1 > (T >> 6)) kt1 = T >> 6;
      attn_unit<0, 1, 1>(p.big, 2304, seq_base, kt0, kt1, 512 + head * 64, 1024 + head * 64, q0b + wave * 32, head * 64, head * 64,
                         exp2f(-(float)(head + 1)) * LOG2E, 0.f, p.xn, lds, part_o, part_ml);
    }
  }
}

DI void attn_phase_l1(const Params& p, char* lds) {
  OPAQUE_TID(tid0);
  const int wave = tid0 >> 6;
  for (int u = blockIdx.x; u < 2048; u += gridDim.x) {
    const int kvh = u >> 9, tok0 = (u & 511) * 64;
    const int seq_base = (tok0 < PROMPT_T) ? 0 : (PROMPT_T + ((tok0 - PROMPT_T) / SAMPLE_T) * SAMPLE_T);
    const int T = (tok0 < PROMPT_T) ? PROMPT_T : SAMPLE_T;
    const int q0 = tok0 - seq_base, head = kvh * 4 + (wave & 3);
    int kt0 = (q0 - 128) >> 6; if (kt0 < 0) kt0 = 0;
    int kt1 = ((q0 + 63 + 128) >> 6) + 1; if (kt1 > (T >> 6)) kt1 = T >> 6;
    attn_unit<2, 1, 1>(p.big, 1536, seq_base, kt0, kt1, 1024 + kvh * 64, 1280 + kvh * 64, q0 + (wave >> 2) * 32, head * 64, head * 64,
                       exp2f(-0.5f * (float)(head + 1)) * LOG2E, p.c_sink[head] * LOG2E, p.xn, lds, nullptr, nullptr);
  }
}

#define XB_TMO      128
#define XB_XCNT(j)  (256  + 64 * (j))
#define XB_XSUB(j)  (1280 + 64 * (j))
#define XB_XGEN(j)  (2304 + 64 * (j))
#define XB_TOP      3328
#define XB_TOPGEN   3392
#define XCD_BAR_WORDS 3456
#define XB_SPIN_CAP (1u << 22)
DI unsigned xb_ld(unsigned* p) { return __hip_atomic_load(p, __ATOMIC_RELAXED, __HIP_MEMORY_SCOPE_AGENT); }
DI unsigned xb_add(unsigned* p, unsigned v) { return __hip_atomic_fetch_add(p, v, __ATOMIC_RELAXED, __HIP_MEMORY_SCOPE_AGENT); }
DI unsigned xb_xcc_id() { return (unsigned)__builtin_amdgcn_s_getreg((3 << 11) | 20) & 0xFu; }
#define XB_SPIN(cond, bar) do { unsigned _sp = 0; while (cond) { __builtin_amdgcn_s_sleep(1); \
    if ((++_sp & 255u) == 0u) { if (xb_ld(&(bar)[XB_TMO])) break; if (_sp > XB_SPIN_CAP) { atomicAdd(&(bar)[XB_TMO], 1u); break; } } } } while (0)
struct XcdBarrier { unsigned* bar; unsigned x; volatile unsigned* st; };
DI void xcd_barrier_complete(unsigned* bar, unsigned x, unsigned& nloc, unsigned& nx) {
  const unsigned G = gridDim.x;
  unsigned sum, cnt, mine, sp = 0u;
  for (;;) {
    sum = 0u; cnt = 0u; mine = 0u;
#pragma unroll
    for (unsigned j = 0; j < 16; ++j) { const unsigned c = xb_ld(&bar[XB_XCNT(j)]); sum += c; cnt += (c > 0u) ? 1u : 0u; mine = (j == x) ? c : mine; }
    if (sum == G) break;
    __builtin_amdgcn_s_sleep(1);
    if ((++sp & 255u) == 0u) { if (xb_ld(&bar[XB_TMO])) break; if (sp > XB_SPIN_CAP) { atomicAdd(&bar[XB_TMO], 1u); break; } }
  }
  nloc = mine > 0u ? mine : 1u; nx = cnt > 0u ? cnt : 1u;
}
DI void xcd_barrier(const XcdBarrier& b) {
  asm volatile("s_waitcnt vmcnt(0)" ::: "memory");
  __syncthreads();
  if (threadIdx.x == 0) {
    unsigned* bar = b.bar;
    __builtin_amdgcn_s_waitcnt(0);
    unsigned nloc = b.st[0], nx = b.st[1];
    if (nloc == 0u) { xcd_barrier_complete(bar, b.x, nloc, nx); b.st[0] = nloc; b.st[1] = nx; }
    const unsigned old = xb_add(&bar[XB_XSUB(b.x)], 1u);
    const unsigned gen = old / nloc;
    if (old + 1u == (gen + 1u) * nloc) {
      __builtin_amdgcn_fence(__ATOMIC_RELEASE, "agent");
      asm volatile("s_waitcnt vmcnt(0)" ::: "memory");
      const unsigned og = xb_add(&bar[XB_TOP], 1u);
      const unsigned tg = og / nx;
      if (og + 1u == (tg + 1u) * nx) xb_add(&bar[XB_TOPGEN], 1u);
      else XB_SPIN(xb_ld(&bar[XB_TOPGEN]) == tg, bar);
      __builtin_amdgcn_fence(__ATOMIC_ACQUIRE, "agent");
      xb_add(&bar[XB_XGEN(b.x)], 1u);
      asm volatile("s_waitcnt vmcnt(0)" ::: "memory");
    } else {
      XB_SPIN(xb_ld(&bar[XB_XGEN(b.x)]) == gen, bar);
      __builtin_amdgcn_fence(__ATOMIC_ACQUIRE, "agent");
      asm volatile("s_waitcnt vmcnt(0)" ::: "memory");
    }
  }
  __syncthreads();
}

__global__ void __launch_bounds__(512) fwd_megakernel(Params p) {
  cg::grid_group grid = cg::this_grid();
  __shared__ __attribute__((aligned(1024))) char lds[8 * HTB + 64 + 2048];
  volatile unsigned* bst = (volatile unsigned*)(lds + 8 * HTB);
  if (threadIdx.x < 2) bst[threadIdx.x] = 0u;
  __syncthreads();
  XcdBarrier xb; xb.bar = p.bar; xb.x = xb_xcc_id(); xb.st = bst;
  if (threadIdx.x == 0) (void)xb_add(&p.bar[XB_XCNT(xb.x)], 1u);
  convert_phase(p, 0, (float*)lds);
  init_phase(p);
  grid.sync();
  for (int layer = 0; layer < 2; ++layer) {
    for (int f = 0; f < 2; ++f) {
      if (f == 1) {
        if (layer == 0) gemm_phase(p.h16, p.wts + W_IN, NTOK, 2304, DM, EpiProj{p.big, 2304, p.ssq}, lds);
        else gemm_phase(p.h16, p.wts + W_IN, NTOK, 1536, DM, EpiProj{p.big, 1536, p.ssq}, lds);
        xcd_barrier(xb);
        if (layer == 0) {
          bprep_phase(p);
          attn_far_phase(p, lds);
          xcd_barrier(xb);
          attn_phase_l0(p, lds);
        } else {
          attn_phase_l1(p, lds);
        }
        xcd_barrier(xb);
        gemm_phase(p.xn, p.wts + W_OUT, NTOK, DM, DM, EpiResid{p.h16, p.h16, 1.0f, p.ssq}, lds);
        xcd_barrier(xb);
      }
      const int rows = NTOK / p.ffn_chunks;
      const bool last = (layer == 1 && f == 1);
      for (int c = 0; c < p.ffn_chunks; ++c) {
        const size_t ro = (size_t)c * rows;
        gemm_phase(p.h16 + ro * DM, p.wts + (f ? W_UPB : W_UPA), rows, 2 * DFF, DM, EpiUp{p.big, p.ssq + ro * 16}, lds);
        xcd_barrier(xb);
        gemm_phase(p.big, p.wts + (f ? W_DNB : W_DNA), rows, DM, DFF, EpiResid{p.h16 + ro * DM, (last ? p.xn : p.h16) + ro * DM, 0.5f, p.ssq + ro * 16}, lds);
        xcd_barrier(xb);
      }
    }
    if (layer == 0) { convert_phase(p, 1, (float*)lds); xcd_barrier(xb); }
  }
  final_norm_phase(p);
}

extern "C" void kernel_launch(void* const* d_in, const int* in_sizes, int n_in, void* d_out, int out_size, void* d_ws, size_t ws_size, hipStream_t stream) {
  static int grid_blocks = 0;
  if (!grid_blocks) {
    int dev = 0, cus = 0, per_cu = 0;
    hipGetDevice(&dev);
    hipDeviceGetAttribute(&cus, hipDeviceAttributeMultiprocessorCount, dev);
    hipOccupancyMaxActiveBlocksPerMultiprocessor(&per_cu, fwd_megakernel, 512, 0);
    if (per_cu > 1) per_cu = 1;
    if (per_cu < 1) per_cu = 1;
    grid_blocks = cus * per_cu;
  }
  Params p{};
  p.x_prompt = (const float*)d_in[0]; p.x_sample = (const float*)d_in[1]; p.norm_g = (const float*)d_in[2];
  p.w1 = (const float*)d_in[3]; p.w3 = (const float*)d_in[4]; p.w2 = (const float*)d_in[5];
  p.ab_w_in = (const float*)d_in[6]; p.ab_w_out = (const float*)d_in[7]; p.ab_qg = (const float*)d_in[8]; p.ab_kg = (const float*)d_in[9];
  p.c_w_in = (const float*)d_in[10]; p.c_w_out = (const float*)d_in[11]; p.c_sink = (const float*)d_in[12]; p.final_g = (const float*)d_in[13];
  p.h = (float*)d_out;
  char* ws = (char*)d_ws;
  const size_t MiB = 1024 * 1024;
  p.wts = (bf16_t*)ws;
  p.xn = (bf16_t*)(ws + 40 * MiB);
  p.big = (bf16_t*)(ws + 104 * MiB);
  p.ffn_chunks = (ws_size >= 283 * MiB) ? 1 : 2;
  { const size_t tail = (p.ffn_chunks == 1 ? 280 : 250) * MiB; p.bar = (unsigned*)(ws + tail); p.ssq = (float*)(ws + tail + 65536); }
  p.h16 = (bf16_t*)d_out;
  hipMemsetAsync(p.bar, 0, XCD_BAR_WORDS * sizeof(unsigned), stream);
  p.pad = 0;
  void* args[] = {&p};
  hipError_t e = hipLaunchCooperativeKernel((void*)fwd_megakernel, dim3(grid_blocks), dim3(512), args, 0, stream);
  if (e != hipSuccess) fprintf(stderr, "cooperative launch failed: %s (grid %d)\n", hipGetErrorString(e), grid_blocks);
}
```

```cpp
#include <hip/hip_runtime.h>
#include <hip/hip_cooperative_groups.h>
#include <cstdio>
namespace cg = cooperative_groups;

typedef unsigned short bf16_t;
typedef short bf16x8 __attribute__((ext_vector_type(8)));
typedef float f32x16 __attribute__((ext_vector_type(16)));
#define DI __device__ __forceinline__
#define OPAQUE_TID(v) int v = threadIdx.x; asm volatile("" : "+v"(v))
#define MFMA32(a, b, c) __builtin_amdgcn_mfma_f32_32x32x16_bf16((a), (b), (c), 0, 0, 0)

constexpr int NTOK = 32768, DM = 1024, DFF = 2816;
constexpr int PROMPT_T = 16384, SAMPLE_T = 4096;
constexpr float EPS = 1e-6f;
constexpr float LOG2E = 1.4426950408889634f;

constexpr size_t W_UPA = 0, W_DNA = 5767168, W_UPB = 8650752, W_DNB = 14417920, W_IN = 17301504, W_OUT = 19660800, W_TOTAL = 20709376;

struct Params {
  const float* x_prompt; const float* x_sample; const float* norm_g; const float* w1; const float* w3; const float* w2;
  const float* ab_w_in; const float* ab_w_out; const float* ab_qg; const float* ab_kg;
  const float* c_w_in; const float* c_w_out; const float* c_sink; const float* final_g;
  float* h; bf16_t* wts; bf16_t* xn; bf16_t* big; unsigned* bar; bf16_t* ssq; bf16_t* h16;
  int ffn_chunks; int pad;
};

DI bf16_t f2bf(float x) { unsigned u = __float_as_uint(x); u += 0x7fffu + ((u >> 16) & 1u); return (bf16_t)(u >> 16); }
DI float bf2f(bf16_t v) { return __uint_as_float(((unsigned)v) << 16); }
DI float bflo(unsigned u) { return __uint_as_float(u << 16); }
DI float bfhi(unsigned u) { return __uint_as_float(u & 0xffff0000u); }
typedef __bf16 bf16x2_t __attribute__((ext_vector_type(2)));
typedef float f32x2_t __attribute__((ext_vector_type(2)));
DI unsigned pack2(float lo, float hi) { f32x2_t v = {lo, hi}; return __builtin_bit_cast(unsigned, __builtin_convertvector(v, bf16x2_t)); }
DI int crow(int reg, int h) { return (reg & 3) + 8 * (reg >> 2) + 4 * h; }

DI void convert_tile(const float* __restrict__ src, int K, int N, int kt, int nt, bf16_t* __restrict__ dst, int mode, const float* __restrict__ g, float* lds) {
  OPAQUE_TID(tid);
#pragma unroll 8
  for (int i = 0; i < 32; ++i) { const int e = tid + 512 * i, kk = e >> 8, nn = e & 255; lds[kk * 257 + nn] = src[(size_t)(kt * 64 + kk) * N + nt * 256 + nn] * (g ? g[kt * 64 + kk] : 1.f); }
  __syncthreads();
#pragma unroll
  for (int j = 0; j < 4; ++j) {
    const int pc = tid + 512 * j, nn = pc >> 3, kc = pc & 7, n = nt * 256 + nn;
    const int drow = (mode == 0) ? n : ((n >> 7) * 256 + (n & 127) + (mode == 2 ? 128 : 0));
    const float* lp = lds + kc * 8 * 257 + nn;
    uint4 v; v.x = pack2(lp[0], lp[257]); v.y = pack2(lp[514], lp[771]); v.z = pack2(lp[1028], lp[1285]); v.w = pack2(lp[1542], lp[1799]);
    *(uint4*)(dst + (size_t)drow * K + kt * 64 + kc * 8) = v;
  }
  __syncthreads();
}

DI void convert_phase(const Params& p, int layer, float* lds) {
  const int n_in = (layer == 0) ? 2304 : 1536;
  const int t_up = 16 * 11, t_in = 16 * (n_in / 256), t_out = 16 * 4;
  const int total = 6 * t_up + t_in + t_out;
  for (int u = blockIdx.x; u < total; u += gridDim.x) {
    int r = u; const float* src; bf16_t* dst; int K, N, mode; const float* g = nullptr;
    if (r < 6 * t_up) {
      int mtx = r / t_up; r -= mtx * t_up; int f = mtx / 3, which = mtx % 3;
      size_t base = (size_t)(layer * 2 + f) * DM * DFF;
      if (which == 0) { src = p.w1 + base; K = DM; N = DFF; mode = 1; dst = p.wts + (f ? W_UPB : W_UPA); g = p.norm_g + (layer * 3 + (f ? 2 : 0)) * DM; }
      else if (which == 1) { src = p.w3 + base; K = DM; N = DFF; mode = 2; dst = p.wts + (f ? W_UPB : W_UPA); g = p.norm_g + (layer * 3 + (f ? 2 : 0)) * DM; }
      else { src = p.w2 + base; K = DFF; N = DM; mode = 0; dst = p.wts + (f ? W_DNB : W_DNA); }
    } else if (r < 6 * t_up + t_in) {
      r -= 6 * t_up; src = (layer == 0) ? p.ab_w_in : p.c_w_in; K = DM; N = n_in; mode = 0; dst = p.wts + W_IN; g = p.norm_g + (layer * 3 + 1) * DM;
    } else {
      r -= 6 * t_up + t_in; src = (layer == 0) ? p.ab_w_out : p.c_w_out; K = DM; N = DM; mode = 0; dst = p.wts + W_OUT;
    }
    const int ntn = N / 256; const int kt = r / ntn, nt = r % ntn;
    convert_tile(src, K, N, kt, nt, dst, mode, g, lds);
  }
}

DI void init_phase(const Params& p) {
  OPAQUE_TID(tid);
  const int lane = tid & 63, wave = tid >> 6;
  for (int row = blockIdx.x * 8 + wave; row < NTOK; row += gridDim.x * 8) {
    const float* src = (row < PROMPT_T) ? p.x_prompt + (size_t)row * DM : p.x_sample + (size_t)(row - PROMPT_T) * DM;
    float ss = 0.f;
#pragma unroll
    for (int i = 0; i < 4; ++i) { const float4 v = *(const float4*)(src + lane * 4 + 256 * i); ss += v.x * v.x + v.y * v.y + v.z * v.z + v.w * v.w;
      uint2 o2; o2.x = pack2(v.x, v.y); o2.y = pack2(v.z, v.w); *(uint2*)(p.h16 + (size_t)row * DM + lane * 4 + 256 * i) = o2; }
#pragma unroll
    for (int o = 32; o > 0; o >>= 1) ss += __shfl_xor(ss, o);
    if (lane < 16) p.ssq[(size_t)row * 16 + lane] = (lane == 0) ? f2bf(ss) : (bf16_t)0;
  }
}
DI void final_norm_phase(const Params& p) {
  OPAQUE_TID(tid);
  const int lane = tid & 63, wave = tid >> 6;
  float4 gv[4];
#pragma unroll
  for (int i = 0; i < 4; ++i) gv[i] = *(const float4*)(p.final_g + lane * 4 + 256 * i);
  for (int row = blockIdx.x * 8 + wave; row < NTOK; row += gridDim.x * 8) {
    float4 v[4]; float ss = 0.f;
#pragma unroll
    for (int i = 0; i < 4; ++i) { const uint2 u = *(const uint2*)(p.xn + (size_t)row * DM + lane * 4 + 256 * i);
      v[i].x = bflo(u.x); v[i].y = bfhi(u.x); v[i].z = bflo(u.y); v[i].w = bfhi(u.y); ss += v[i].x * v[i].x + v[i].y * v[i].y + v[i].z * v[i].z + v[i].w * v[i].w; }
#pragma unroll
    for (int o = 32; o > 0; o >>= 1) ss += __shfl_xor(ss, o);
    const float r = rsqrtf(ss * (1.0f / DM) + EPS);
#pragma unroll
    for (int i = 0; i < 4; ++i) { float4 y; y.x = v[i].x * r * gv[i].x; y.y = v[i].y * r * gv[i].y; y.z = v[i].z * r * gv[i].z; y.w = v[i].w * r * gv[i].w;
      *(float4*)(p.h + (size_t)row * DM + lane * 4 + 256 * i) = y; }
  }
}

typedef float f32x4 __attribute__((ext_vector_type(4)));
typedef unsigned u32x4 __attribute__((ext_vector_type(4)));
#define PG8_LAS __attribute__((address_space(3)))
constexpr int BM = 256, BK = 64, HALF = 128, HTB = HALF * BK * 2, STAGE_B = 4 * HTB, NXCD = 8, WGM = 8;
DI int lds_byte(int r, int c) { const int st = (r >> 4) * 2 + (c >> 5), rr = r & 15, cc = c & 31, ob = rr * 64 + cc * 2; return st * 1024 + (ob ^ (((ob >> 9) & 1) << 5)); }
DI void stage_rc(int b, int& R, int& C) { const int st = b / 1024, sb = b % 1024, swz = sb ^ (((sb >> 9) & 1) << 5); R = (st >> 1) * 16 + swz / 64; C = (st & 1) * 32 + (swz % 64) / 2; }
DI int perm32(int rho) { const int n = rho >> 4, i = rho & 15; return 8 * (i >> 2) + 4 * n + (i & 3); }
struct Unit { int pm, pn; };
struct StaticOrder {
  int nM, nN, nwg, G, c;
  DI void init(int M, int N, int G_, int c_) { nM = M / BM; nN = N / BM; nwg = nM * nN; G = G_; c = c_; }
  DI bool next(int i, Unit& u) const {
    const long L = (long)i * G + c; if (L >= nwg) return false;
    int wgid = (int)L; { const int q = nwg / NXCD, r = nwg % NXCD, xcd = wgid % NXCD, off = wgid / NXCD; wgid = (xcd < r ? xcd * (q + 1) : r * (q + 1) + (xcd - r) * q) + off; }
    const int nig = WGM * nN, gid = wgid / nig, fm = gid * WGM, gsz = (nM - fm) < WGM ? (nM - fm) : WGM;
    u.pm = fm + ((wgid % nig) % gsz); u.pn = (wgid % nig) / gsz; return true;
  }
};
constexpr int RT_OFF = 8 * HTB + 64;
DI void acc_zero(f32x4 (&acc)[2][2][4][2]) {
#pragma unroll
  for (int a = 0; a < 2; ++a)
#pragma unroll
    for (int b = 0; b < 2; ++b)
#pragma unroll
      for (int m = 0; m < 4; ++m)
#pragma unroll
        for (int n = 0; n < 2; ++n) acc[a][b][m][n] = (f32x4){0.f, 0.f, 0.f, 0.f};
}
struct EpiProj {
  static constexpr bool PERM = true, NEEDS_R = true;
  bf16_t* O; int ldc; const bf16_t* ssq;
  DI void init(f32x4 (&acc)[2][2][4][2], const Unit&, int, int, int, int) const { acc_zero(acc); }
  DI void operator()(const f32x4 (&acc)[2][2][4][2], const Unit& u, int wr, int wc, int fr, int fq, const PG8_LAS float* rt) const {
    const int row0 = u.pm * BM + wr * 64 + fr, col0 = u.pn * BM + wc * 32 + 8 * fq;
#pragma unroll
    for (int ai = 0; ai < 2; ++ai)
#pragma unroll
      for (int m = 0; m < 4; ++m) { bf16_t* rowp = O + (size_t)(row0 + ai * HALF + m * 16) * ldc + col0; const float r = rt[ai * HALF + wr * 64 + m * 16 + fr];
#pragma unroll
        for (int bj = 0; bj < 2; ++bj) { const f32x4 v0 = acc[ai][bj][m][0] * r, v1 = acc[ai][bj][m][1] * r;
          u32x4 w; w.x = pack2(v0[0], v0[1]); w.y = pack2(v0[2], v0[3]); w.z = pack2(v1[0], v1[1]); w.w = pack2(v1[2], v1[3]);
          *(u32x4*)(rowp + bj * HALF) = w; } }
  }
};
struct EpiUp {
  static constexpr bool PERM = true, NEEDS_R = true;
  bf16_t* O; const bf16_t* ssq;
  DI void init(f32x4 (&acc)[2][2][4][2], const Unit&, int, int, int, int) const { acc_zero(acc); }
  DI void operator()(const f32x4 (&acc)[2][2][4][2], const Unit& u, int wr, int wc, int fr, int fq, const PG8_LAS float* rt) const {
    const int row0 = u.pm * BM + wr * 64 + fr, col0 = u.pn * HALF + wc * 32 + 8 * fq;
#pragma unroll
    for (int ai = 0; ai < 2; ++ai)
#pragma unroll
      for (int m = 0; m < 4; ++m) {
        const float r = rt[ai * HALF + wr * 64 + m * 16 + fr], nr = -LOG2E * r, r2 = r * r;
        float a[8];
#pragma unroll
        for (int n = 0; n < 2; ++n)
#pragma unroll
          for (int j = 0; j < 4; ++j) { const float u1 = acc[ai][0][m][n][j], u3 = acc[ai][1][m][n][j]; a[4 * n + j] = (u1 * u3) * (r2 * __builtin_amdgcn_rcpf(1.f + __builtin_amdgcn_exp2f(u1 * nr))); }
        u32x4 w; w.x = pack2(a[0], a[1]); w.y = pack2(a[2], a[3]); w.z = pack2(a[4], a[5]); w.w = pack2(a[6], a[7]);
        *(u32x4*)(O + (size_t)(row0 + ai * HALF + m * 16) * DFF + col0) = w; }
  }
};
struct EpiResid {
  static constexpr bool PERM = true, NEEDS_R = false;
  const bf16_t* src; bf16_t* dst; float coef; bf16_t* ssq;
  DI void init(f32x4 (&acc)[2][2][4][2], const Unit& u, int wr, int wc, int fr, int fq) const {
    const int row0 = u.pm * BM + wr * 64 + fr, col0 = u.pn * BM + wc * 32 + 8 * fq; const float ic = 1.f / coef;
#pragma unroll
    for (int ai = 0; ai < 2; ++ai)
#pragma unroll
      for (int m = 0; m < 4; ++m) { const bf16_t* rowp = src + (size_t)(row0 + ai * HALF + m * 16) * DM + col0;
#pragma unroll
        for (int bj = 0; bj < 2; ++bj) { const u32x4 w = *(const u32x4*)(rowp + bj * HALF);
          acc[ai][bj][m][0] = (f32x4){bflo(w.x), bfhi(w.x), bflo(w.y), bfhi(w.y)} * ic; acc[ai][bj][m][1] = (f32x4){bflo(w.z), bfhi(w.z), bflo(w.w), bfhi(w.w)} * ic; } }
  }
  DI void operator()(const f32x4 (&acc)[2][2][4][2], const Unit& u, int wr, int wc, int fr, int fq, const PG8_LAS float*) const {
    const int row0 = u.pm * BM + wr * 64 + fr, col0 = u.pn * BM + wc * 32 + 8 * fq;
#pragma unroll
    for (int ai = 0; ai < 2; ++ai)
#pragma unroll
      for (int m = 0; m < 4; ++m) { const int row = row0 + ai * HALF + m * 16; bf16_t* rowp = dst + (size_t)row * DM + col0; float ss = 0.f;
#pragma unroll
        for (int bj = 0; bj < 2; ++bj) { const f32x4 v0 = acc[ai][bj][m][0] * coef, v1 = acc[ai][bj][m][1] * coef;
          ss += v0[0] * v0[0] + v0[1] * v0[1] + v0[2] * v0[2] + v0[3] * v0[3] + v1[0] * v1[0] + v1[1] * v1[1] + v1[2] * v1[2] + v1[3] * v1[3];
          u32x4 w; w.x = pack2(v0[0], v0[1]); w.y = pack2(v0[2], v0[3]); w.z = pack2(v1[0], v1[1]); w.w = pack2(v1[2], v1[3]);
          *(u32x4*)(rowp + bj * HALF) = w; }
        ss += __shfl_xor(ss, 16); ss += __shfl_xor(ss, 32);
        if (fq == 0) ssq[(size_t)row * 16 + u.pn * 4 + wc] = f2bf(ss); }
  }
};

template <class Epi>
DI void gemm_phase(const bf16_t* __restrict__ gA, const bf16_t* __restrict__ gBt, int M, int N, int K, const Epi& E, char* lds_generic) {
  PG8_LAS unsigned char* lds = (PG8_LAS unsigned char*)lds_generic;
  OPAQUE_TID(tid);
  const int wid = __builtin_amdgcn_readfirstlane(tid >> 6), lane = tid & 63, wr = wid >> 2, wc = wid & 3, fr = lane & 15, fq = lane >> 4;
  const int nt = K / BK;
  StaticOrder S; S.init(M, N, gridDim.x, blockIdx.x);
  unsigned voffA[2], voffB[2];
#pragma unroll
  for (int i = 0; i < 2; ++i) { int R, C; stage_rc(tid * 16 + i * 8192, R, C); const int Rb = Epi::PERM ? ((R & ~31) + perm32(R & 31)) : R;
    voffA[i] = (unsigned)(R * K + C) * 2u; voffB[i] = (unsigned)(Rb * K + C) * 2u; }
  const size_t kstep = (size_t)(BK * 2);
  const size_t hstep = (size_t)HALF * K * 2;
  const size_t tstep = 2 * hstep;
  const unsigned ldsw = (unsigned)wid * 1024u;
  const int aoff = lds_byte(wr * 64 + fr, fq * 8), boff = lds_byte(wc * 32 + fr, fq * 8);
#define PG8_SA(b, h) (((b) * 2 + (h)) * HTB)
#define PG8_SB(b, h) ((4 + (b) * 2 + (h)) * HTB)
#define PG8_STAGE(bufoff, gbase, voff) do { _Pragma("unroll") for (int _i = 0; _i < 2; ++_i) \
    __builtin_amdgcn_global_load_lds((const unsigned*)((const char*)(gbase) + (voff)[_i]), (PG8_LAS unsigned*)(lds + (bufoff) + ldsw + _i * 8192), 16, 0, 0); } while (0)
#define PG8_LDA(dst, b, h) do { _Pragma("unroll") for (int m = 0; m < 4; ++m) _Pragma("unroll") for (int k = 0; k < 2; ++k) dst[m][k] = *(const PG8_LAS bf16x8*)(lds + PG8_SA(b, h) + aoff + m * 2048 + k * 1024); } while (0)
#define PG8_LDB(dst, b, h) do { _Pragma("unroll") for (int n = 0; n < 2; ++n) _Pragma("unroll") for (int k = 0; k < 2; ++k) dst[n][k] = *(const PG8_LAS bf16x8*)(lds + PG8_SB(b, h) + boff + n * 2048 + k * 1024); } while (0)
#define PG8_MMA(ai, bj, At, Bt) do { __builtin_amdgcn_s_setprio(1); _Pragma("unroll") for (int m = 0; m < 4; ++m) _Pragma("unroll") for (int n = 0; n < 2; ++n) _Pragma("unroll") for (int k = 0; k < 2; ++k) \
    acc[ai][bj][m][n] = __builtin_amdgcn_mfma_f32_16x16x32_bf16(Bt[n][k], At[m][k], acc[ai][bj][m][n], 0, 0, 0); __builtin_amdgcn_s_setprio(0); } while (0)
#define PG8_WAIT_V(n) asm volatile("s_waitcnt vmcnt(" #n ")" ::: "memory")
#define PG8_WAIT_L(n) asm volatile("s_waitcnt lgkmcnt(" #n ")" ::: "memory")
#define PG8_BAR __builtin_amdgcn_s_barrier()
#define PG8_SCHED __builtin_amdgcn_sched_barrier(0)
  Unit cur, nxt; int ui = 0;
  if (!S.next(0, cur)) return;
  f32x4 acc[2][2][4][2];
  E.init(acc, cur, wr, wc, fr, fq);
#define PG8_RTAB_LOAD(var, unit) do { if constexpr (Epi::NEEDS_R) { var = *(const uint4*)(E.ssq + (size_t)((unit).pm * BM + (tid >> 1)) * 16 + (tid & 1) * 8); } } while (0)
#define PG8_RTAB_FIN(var, buf) do { if constexpr (Epi::NEEDS_R) { float ss_ = bflo(var.x) + bfhi(var.x) + bflo(var.y) + bfhi(var.y) + bflo(var.z) + bfhi(var.z) + bflo(var.w) + bfhi(var.w); ss_ += __shfl_xor(ss_, 1); \
    if (!(tid & 1)) ((PG8_LAS float*)(lds + RT_OFF))[(buf) * 256 + (tid >> 1)] = rsqrtf(ss_ * (1.0f / DM) + EPS); } } while (0)
  { uint4 rt0_ = {0u, 0u, 0u, 0u}; PG8_RTAB_LOAD(rt0_, cur); PG8_RTAB_FIN(rt0_, 0); }
  bf16x8 At[4][2], B0[2][2], B1[2][2];
  const char* cA = (const char*)gA + (size_t)cur.pm * tstep; const char* cB = (const char*)gBt + (size_t)cur.pn * tstep;
  PG8_STAGE(PG8_SB(0, 0), cB, voffB); PG8_STAGE(PG8_SA(0, 0), cA, voffA); PG8_STAGE(PG8_SB(0, 1), cB + hstep, voffB); PG8_STAGE(PG8_SA(0, 1), cA + hstep, voffA);
  if (wr == 1) PG8_BAR;
  PG8_WAIT_V(4); PG8_BAR;
  PG8_STAGE(PG8_SB(1, 0), cB + kstep, voffB); PG8_STAGE(PG8_SA(1, 0), cA + kstep, voffA); PG8_STAGE(PG8_SB(1, 1), cB + hstep + kstep, voffB);
  PG8_WAIT_V(6); PG8_BAR;
  for (;;) {
    const bool has_next = S.next(ui + 1, nxt);
    const char* nA = has_next ? (const char*)gA + (size_t)nxt.pm * tstep : cA; const char* nB = has_next ? (const char*)gBt + (size_t)nxt.pn * tstep : cB;
    for (int t = 0; t < nt; t += 2) {
      const bool last = (t == nt - 2);
      const char* a1 = cA + (size_t)(t + 1) * kstep;
      const char* a2 = last ? nA : cA + (size_t)(t + 2) * kstep; const char* b2 = last ? nB : cB + (size_t)(t + 2) * kstep;
      const char* a3 = a2 + kstep; const char* b3 = b2 + kstep;
      PG8_LDB(B0, 0, 0); PG8_SCHED; PG8_LDA(At, 0, 0); PG8_STAGE(PG8_SA(1, 1), a1 + hstep, voffA);
      PG8_WAIT_L(8); PG8_BAR; PG8_WAIT_L(0); PG8_MMA(0, 0, At, B0); PG8_BAR; PG8_SCHED;
      PG8_LDB(B1, 0, 1); PG8_STAGE(PG8_SB(0, 0), b2, voffB);
      PG8_BAR; PG8_WAIT_L(0); PG8_MMA(0, 1, At, B1); PG8_BAR;
      PG8_LDA(At, 0, 1); PG8_STAGE(PG8_SA(0, 0), a2, voffA);
      PG8_BAR; PG8_WAIT_L(0); PG8_MMA(1, 0, At, B0); PG8_BAR; PG8_SCHED;
      PG8_STAGE(PG8_SB(0, 1), b2 + hstep, voffB);
      PG8_WAIT_V(6); PG8_BAR; PG8_MMA(1, 1, At, B1); PG8_BAR;
      PG8_LDB(B0, 1, 0); PG8_SCHED; PG8_LDA(At, 1, 0); PG8_STAGE(PG8_SA(0, 1), a2 + hstep, voffA);
      PG8_WAIT_L(8); PG8_BAR; PG8_WAIT_L(0); PG8_MMA(0, 0, At, B0); PG8_BAR; PG8_SCHED;
      PG8_LDB(B1, 1, 1); PG8_STAGE(PG8_SB(1, 0), b3, voffB);
      PG8_BAR; PG8_WAIT_L(0); PG8_MMA(0, 1, At, B1); PG8_BAR;
      PG8_LDA(At, 1, 1); PG8_STAGE(PG8_SA(1, 0), a3, voffA);
      PG8_BAR; PG8_WAIT_L(0); PG8_MMA(1, 0, At, B0); PG8_BAR; PG8_SCHED;
      PG8_STAGE(PG8_SB(1, 1), b3 + hstep, voffB);
      PG8_WAIT_V(6); PG8_BAR; PG8_MMA(1, 1, At, B1); PG8_BAR;
    }
    uint4 rtn_ = {0u, 0u, 0u, 0u};
    if (has_next) PG8_RTAB_LOAD(rtn_, nxt);
    E(acc, cur, wr, wc, fr, fq, (const PG8_LAS float*)(lds + RT_OFF) + (ui & 1) * 256);
    if (!has_next) break;
    PG8_RTAB_FIN(rtn_, (ui + 1) & 1);
    E.init(acc, nxt, wr, wc, fr, fq);
    cur = nxt; cA = nA; cB = nB; ++ui;
  }
  PG8_WAIT_V(0);
  if (wr == 0) PG8_BAR;
  PG8_BAR;
#undef PG8_RTAB_LOAD
#undef PG8_RTAB_FIN
#undef PG8_SA
#undef PG8_SB
#undef PG8_STAGE
#undef PG8_LDA
#undef PG8_LDB
#undef PG8_MMA
#undef PG8_WAIT_V
#undef PG8_WAIT_L
#undef PG8_BAR
#undef PG8_SCHED
}

DI void bprep_phase(const Params& p) {
  OPAQUE_TID(tid);
  const int pi = tid & 31, tl = tid >> 5;
  const float fr = exp2f(-(float)((pi & 15) * 2) * (1.0f / 32.0f) * 13.287712379549449f);
  const float qg0 = p.ab_qg[2 * pi], qg1 = p.ab_qg[2 * pi + 1], kg0 = p.ab_kg[2 * pi], kg1 = p.ab_kg[2 * pi + 1];
  for (int t = blockIdx.x * 16 + tl; t < NTOK; t += gridDim.x * 16) {
    const int pos = (t < PROMPT_T) ? t : ((t - PROMPT_T) & (SAMPLE_T - 1));
    const float ang = (float)((pi < 16) ? (pos >> 6) : (pos & 63)) * fr;
    const float cs = __cosf(ang), sn = __sinf(ang);
    unsigned* rowp = (unsigned*)(p.big + (size_t)t * 2304);
#pragma unroll
    for (int hd = 0; hd < 10; ++hd) {
      const int col = (hd < 8) ? (1536 + hd * 64) : (2048 + (hd - 8) * 64);
      unsigned u = rowp[(col >> 1) + pi];
      float x1 = bflo(u), x2 = bfhi(u);
      float ss = x1 * x1 + x2 * x2;
#pragma unroll
      for (int o = 16; o > 0; o >>= 1) ss += __shfl_xor(ss, o);
      const float r = rsqrtf(ss * (1.0f / 64.0f) + EPS);
      x1 = x1 * r * ((hd < 8) ? qg0 : kg0); x2 = x2 * r * ((hd < 8) ? qg1 : kg1);
      const float qs = (hd < 8) ? 0.125f * LOG2E : 1.f;
      rowp[(col >> 1) + pi] = pack2((x1 * cs - x2 * sn) * qs, (x1 * sn + x2 * cs) * qs);
    }
  }
}

template <int MODE>
DI void naive_attn(const Params& p, const bf16_t* __restrict__ proj, int ld, int qoff, int koff, int voff, int nqh, int G, bf16_t* cat, int cat_off) {
  const int total = NTOK * nqh;
  for (int idx = blockIdx.x * 256 + threadIdx.x; idx < total; idx += gridDim.x * 256) {
    const int head = idx / NTOK, t = idx % NTOK, hk = head / G;
    const int seq_base = (t < PROMPT_T) ? 0 : (PROMPT_T + ((t - PROMPT_T) / SAMPLE_T) * SAMPLE_T);
    const int T = (t < PROMPT_T) ? PROMPT_T : SAMPLE_T;
    const int pos = t - seq_base;
    float q[64], o[64];
    { const uint4* qp = (const uint4*)(proj + (size_t)t * ld + qoff + head * 64);
#pragma unroll
      for (int c = 0; c < 8; ++c) { uint4 v = qp[c]; q[8*c] = bflo(v.x); q[8*c+1] = bfhi(v.x); q[8*c+2] = bflo(v.y); q[8*c+3] = bfhi(v.y); q[8*c+4] = bflo(v.z); q[8*c+5] = bfhi(v.z); q[8*c+6] = bflo(v.w); q[8*c+7] = bfhi(v.w); } }
#pragma unroll
    for (int d = 0; d < 64; ++d) o[d] = 0.f;
    float m = -1e30f, l = 0.f, slope = 0.f;
    if (MODE == 0) slope = exp2f(-(float)(head + 1));
    if (MODE == 2) { slope = exp2f(-0.5f * (float)(head + 1)); m = p.c_sink[head]; l = 1.f; }
    const int nkeys = (MODE == 0) ? 387 : (MODE == 1 ? T : 257);
    for (int j = 0; j < nkeys; ++j) {
      int off;
      if (MODE == 0) { const int br = j / 129, jj = j % 129 - 64; off = jj * (br == 0 ? 1 : (br == 1 ? 4 : 16)); }
      else if (MODE == 1) off = j - pos;
      else off = j - 128;
      const int kp = pos + off;
      if (kp < 0 || kp >= T) continue;
      const uint4* kptr = (const uint4*)(proj + (size_t)(seq_base + kp) * ld + koff + hk * 64);
      float s = 0.f;
#pragma unroll
      for (int c = 0; c < 8; ++c) { uint4 v = kptr[c];
        s += q[8*c] * bflo(v.x) + q[8*c+1] * bfhi(v.x) + q[8*c+2] * bflo(v.y) + q[8*c+3] * bfhi(v.y) + q[8*c+4] * bflo(v.z) + q[8*c+5] * bfhi(v.z) + q[8*c+6] * bflo(v.w) + q[8*c+7] * bfhi(v.w); }
      s *= 0.125f;
      if (MODE != 1) s -= slope * fabsf((float)off);
      const float mn = fmaxf(m, s); const float al = __expf(m - mn), pw = __expf(s - mn);
      m = mn; l = l * al + pw;
      const uint4* vptr = (const uint4*)(proj + (size_t)(seq_base + kp) * ld + voff + hk * 64);
#pragma unroll
      for (int c = 0; c < 8; ++c) { uint4 v = vptr[c];
        o[8*c] = o[8*c] * al + pw * bflo(v.x); o[8*c+1] = o[8*c+1] * al + pw * bfhi(v.x); o[8*c+2] = o[8*c+2] * al + pw * bflo(v.y); o[8*c+3] = o[8*c+3] * al + pw * bfhi(v.y);
        o[8*c+4] = o[8*c+4] * al + pw * bflo(v.z); o[8*c+5] = o[8*c+5] * al + pw * bfhi(v.z); o[8*c+6] = o[8*c+6] * al + pw * bflo(v.w); o[8*c+7] = o[8*c+7] * al + pw * bfhi(v.w); }
    }
    const float inv = 1.f / l;
    uint4* op = (uint4*)(cat + (size_t)t * DM + cat_off + head * 64);
#pragma unroll
    for (int c = 0; c < 8; ++c) { uint4 v; v.x = pack2(o[8*c] * inv, o[8*c+1] * inv); v.y = pack2(o[8*c+2] * inv, o[8*c+3] * inv); v.z = pack2(o[8*c+4] * inv, o[8*c+5] * inv); v.w = pack2(o[8*c+6] * inv, o[8*c+7] * inv); op[c] = v; }
  }
}

typedef short s16x4 __attribute__((ext_vector_type(4)));
typedef __attribute__((address_space(3))) s16x4* lds_s16x4_ptr;
DI s16x4 vtr(const char* p) { return __builtin_amdgcn_ds_read_tr16_b64_v4i16((lds_s16x4_ptr)p); }

template <int MODE, int NQ, int TS, bool FAST = false>
DI void attn_unit(const bf16_t* __restrict__ proj, int ld, int seq_base, int kt0, int kt1, int koff, int voff,
                  int q0w, int qoff, int ooff, float slope2, float sink2, bf16_t* __restrict__ cat, char* lds, bf16_t* part_o, float* part_ml) {
  OPAQUE_TID(tid);
  const int lane = tid & 63, wave = tid >> 6, r32 = lane & 31, hh = lane >> 5;
  constexpr float C2 = 0.125f * LOG2E;
  constexpr int NS = 6;
  bf16x8 qf[NQ][4];
#pragma unroll
  for (int nq = 0; nq < NQ; ++nq) { const bf16_t* qp = proj + (size_t)(seq_base + TS * (q0w + 32 * nq + r32)) * ld + qoff + hh * 8;
#pragma unroll
    for (int ks = 0; ks < 4; ++ks) qf[nq][ks] = *(const bf16x8*)(qp + ks * 16); }
  f32x16 o[NQ][2];
  float m2[NQ], l[NQ];
#pragma unroll
  for (int nq = 0; nq < NQ; ++nq) {
    if (MODE == 0) {
      const size_t tok = (size_t)(seq_base + q0w + 32 * nq + r32);
      const bf16_t* po = part_o + tok * 512 + ooff + 4 * hh; const float* pm = part_ml + (tok * 8 + (ooff >> 6)) * 2;
      m2[nq] = pm[0]; l[nq] = hh ? 0.f : pm[1];
#pragma unroll
      for (int g = 0; g < 4; ++g) { const uint2 a = *(const uint2*)(po + 8 * g), b = *(const uint2*)(po + 32 + 8 * g);
        o[nq][0][4 * g] = bflo(a.x); o[nq][0][4 * g + 1] = bfhi(a.x); o[nq][0][4 * g + 2] = bflo(a.y); o[nq][0][4 * g + 3] = bfhi(a.y);
        o[nq][1][4 * g] = bflo(b.x); o[nq][1][4 * g + 1] = bfhi(b.x); o[nq][1][4 * g + 2] = bflo(b.y); o[nq][1][4 * g + 3] = bfhi(b.y); }
    } else {
      m2[nq] = (MODE == 2) ? sink2 : -1e30f; l[nq] = 0.f;
#pragma unroll
      for (int r = 0; r < 16; ++r) { o[nq][0][r] = 0.f; o[nq][1][r] = 0.f; }
    }
  }
  PG8_LAS unsigned char* L = (PG8_LAS unsigned char*)lds;
  const int kkey_ = wave * 8 + (lane >> 3);
  const bf16_t* kg = proj + (size_t)(seq_base + TS * kkey_) * ld + koff + (((lane & 7) ^ ((kkey_ >> 1) & 7)) * 8);
  const bf16_t* vg = proj + (size_t)(seq_base + TS * ((wave & 3) * 16 + (lane >> 2))) * ld + voff + ((wave >> 2) * 4 + (lane & 3)) * 8;
  const unsigned sdst = (unsigned)__builtin_amdgcn_readfirstlane(wave * 1024);
#define ATT_ISSUE(tile, slot) do { const size_t go_ = (size_t)(tile) * 64 * TS * ld; \
    __builtin_amdgcn_global_load_lds((const unsigned*)(kg + go_), (PG8_LAS unsigned*)(L + (slot) * 16384 + sdst), 16, 0, 0); \
    __builtin_amdgcn_global_load_lds((const unsigned*)(vg + go_), (PG8_LAS unsigned*)(L + (slot) * 16384 + 8192 + sdst), 16, 0, 0); } while (0)
  const int ktl = kt1 - 1;
  constexpr int TAB_OFF = 6 * 16384, TAB_N = (MODE == 3) ? 640 : 1024, TAB_ZERO = TAB_N / 2;
  if (MODE == 0 || MODE == 3) {
    float* tab = (float*)(lds + TAB_OFF);
    for (int e = tid; e < TAB_N; e += 512) {
      const int oo = e - TAB_ZERO, aa = oo < 0 ? -oo : oo;
      if (MODE == 0) {
        const int c = (aa <= 64 ? 1 : 0) + (((oo & 3) == 0 && aa <= 256) ? 1 : 0) + (((oo & 15) == 0 && aa <= 256) ? 1 : 0);
        tab[e] = c ? (-slope2 * (float)aa + (c == 1 ? 0.f : (c == 2 ? 1.f : 1.5849625007f))) : -1e30f;
      } else {
        tab[e] = (aa >= 17 && aa <= 64) ? -slope2 * (float)(16 * aa) : -1e30f;
      }
    }
  }
  if (MODE == 2) {
    float* tab = (float*)(lds + TAB_OFF) + (wave & 3) * 512;
#pragma unroll
    for (int i = 0; i < 4; ++i) { const int e = (wave >> 2) * 64 + lane + 128 * i; const int oo = e - 256, aa = oo < 0 ? -oo : oo; tab[e] = (aa <= 128) ? -slope2 * (float)aa : -1e30f; }
  }
  ATT_ISSUE(kt0, 0); ATT_ISSUE((kt0 + 1 < ktl ? kt0 + 1 : ktl), 1); ATT_ISSUE((kt0 + 2 < ktl ? kt0 + 2 : ktl), 2); ATT_ISSUE((kt0 + 3 < ktl ? kt0 + 3 : ktl), 3);
  asm volatile("s_waitcnt vmcnt(6) lgkmcnt(0)\n\ts_barrier" ::: "memory");
  int kfo4[4];
#pragma unroll
  for (int ks = 0; ks < 4; ++ks) kfo4[ks] = r32 * 128 + (((2 * ks + hh) ^ ((r32 >> 1) & 7)) << 4);
  const int vfo = 8192 + (4 * hh + ((lane & 15) >> 2)) * 64 + ((lane >> 4) & 1) * 32 + (lane & 3) * 8;
  const bool g2 = wave >= 4;
  f32x16 s[NQ][2];
  bf16x8 pf[NQ][4];
  constexpr int WIN = (MODE == 0) ? 256 : 64;
  auto tile_active = [&](int kt) -> bool { return (MODE != 0 && MODE != 3) || ((kt * 64 + 63 >= q0w - WIN) && (kt * 64 <= q0w + 32 * NQ - 1 + WIN)); };
  auto QK = [&](int slot) {
    const char* kb_ = lds + slot * 16384;
#pragma unroll
    for (int nq = 0; nq < NQ; ++nq)
#pragma unroll
      for (int r = 0; r < 16; ++r) { s[nq][0][r] = 0.f; s[nq][1][r] = 0.f; }
#pragma unroll
    for (int ks = 0; ks < 4; ++ks) {
      const bf16x8 k0 = *(const bf16x8*)(kb_ + kfo4[ks]), k1 = *(const bf16x8*)(kb_ + kfo4[ks] + 4096);
#pragma unroll
      for (int nq = 0; nq < NQ; ++nq) { s[nq][0] = MFMA32(k0, qf[nq][ks], s[nq][0]); s[nq][1] = MFMA32(k1, qf[nq][ks], s[nq][1]); }
    }
  };
  auto SM = [&](int kt) {
#pragma unroll
    for (int nq = 0; nq < NQ; ++nq) {
      f32x16& s0 = s[nq][0]; f32x16& s1 = s[nq][1];
      float mx = -1e30f;
      if (MODE == 1) {
      } else if (MODE == 0 || MODE == 3) {
        const float* tb = (const float*)(lds + TAB_OFF) + (kt * 64 + 4 * hh - (q0w + 32 * nq + r32) + TAB_ZERO);
#pragma unroll
        for (int r = 0; r < 16; ++r) {
          const float va = fmaf(s0[r], C2, tb[(r & 3) + 8 * (r >> 2)]), vb = fmaf(s1[r], C2, tb[(r & 3) + 8 * (r >> 2) + 32]);
          s0[r] = va; s1[r] = vb; mx = fmaxf(mx, fmaxf(va, vb));
        }
      } else {
        const float* tb = (const float*)(lds + TAB_OFF) + (wave & 3) * 512 + (kt * 64 + 4 * hh - (q0w + 32 * nq + r32) + 256);
#pragma unroll
        for (int r = 0; r < 16; ++r) {
          const float va = fmaf(s0[r], C2, tb[(r & 3) + 8 * (r >> 2)]), vb = fmaf(s1[r], C2, tb[(r & 3) + 8 * (r >> 2) + 32]);
          s0[r] = va; s1[r] = vb; mx = fmaxf(mx, fmaxf(va, vb));
        }
      }
      float mn;
      if (MODE == 1) {
        mn = sink2;
      } else {
        if (__any(mx > m2[nq] + 8.f)) {
          mx = fmaxf(mx, __shfl_xor(mx, 32));
          mn = fmaxf(m2[nq], mx);
          const float alpha = __builtin_amdgcn_exp2f(m2[nq] - mn);
          l[nq] *= alpha;
#pragma unroll
          for (int r = 0; r < 16; ++r) { o[nq][0][r] *= alpha; o[nq][1][r] *= alpha; }
          m2[nq] = mn;
        }
        mn = m2[nq];
      }
      float ls = 0.f;
#pragma unroll
      for (int r = 0; r < 16; ++r) {
        float pa, pb;
        if (MODE == 1) {
          if (FAST) { pa = __builtin_amdgcn_exp2f(s0[r]); pb = __builtin_amdgcn_exp2f(s1[r]); }
          else { pa = __builtin_amdgcn_exp2f(s0[r] - mn); pb = __builtin_amdgcn_exp2f(s1[r] - mn); }
        }
        else { pa = __builtin_amdgcn_exp2f(s0[r] - mn); pb = __builtin_amdgcn_exp2f(s1[r] - mn); }
        s0[r] = pa; s1[r] = pb; ls += pa + pb;
      }
      l[nq] += ls;
#pragma unroll
      for (int ks = 0; ks < 4; ++ks) {
        uint4 t4;
        const int rb = 8 * (ks & 1);
        if (ks < 2) { t4.x = pack2(s0[rb], s0[rb + 1]); t4.y = pack2(s0[rb + 2], s0[rb + 3]); t4.z = pack2(s0[rb + 4], s0[rb + 5]); t4.w = pack2(s0[rb + 6], s0[rb + 7]); }
        else { t4.x = pack2(s1[rb], s1[rb + 1]); t4.y = pack2(s1[rb + 2], s1[rb + 3]); t4.z = pack2(s1[rb + 4], s1[rb + 5]); t4.w = pack2(s1[rb + 6], s1[rb + 7]); }
        pf[nq][ks] = __builtin_bit_cast(bf16x8, t4);
      }
    }
  };
  auto PV = [&](int slot) {
    const char* vb_ = lds + slot * 16384 + vfo;
#pragma unroll
    for (int ks = 0; ks < 4; ++ks) {
      const s16x4 a0 = vtr(vb_ + ks * 1024), a1 = vtr(vb_ + ks * 1024 + 512);
      const s16x4 b0 = vtr(vb_ + 4096 + ks * 1024), b1 = vtr(vb_ + 4096 + ks * 1024 + 512);
      const bf16x8 v0 = __builtin_shufflevector(a0, a1, 0, 1, 2, 3, 4, 5, 6, 7);
      const bf16x8 v1 = __builtin_shufflevector(b0, b1, 0, 1, 2, 3, 4, 5, 6, 7);
#pragma unroll
      for (int nq = 0; nq < NQ; ++nq) { o[nq][0] = MFMA32(v0, pf[nq][ks], o[nq][0]); o[nq][1] = MFMA32(v1, pf[nq][ks], o[nq][1]); }
    }
  };
  int slot = 0, sp = 0;
  for (int kt = kt0; kt < kt1; ++kt) {
    { const int tn = (kt + 4 < ktl) ? kt + 4 : ktl; int s4 = slot + 4; if (s4 >= NS) s4 -= NS; ATT_ISSUE(tn, s4); }
    const bool act = tile_active(kt);
    if (!g2) {
      if (act) { QK(slot); SM(kt); PV(slot); }
    } else {
      if (kt > kt0 && tile_active(kt - 1)) PV(sp);
      if (act) { QK(slot); SM(kt); }
    }
    asm volatile("s_waitcnt vmcnt(6) lgkmcnt(0)\n\ts_barrier" ::: "memory");
    sp = slot; slot = (slot + 1 == NS) ? 0 : slot + 1;
  }
  if (g2 && tile_active(ktl)) PV(sp);
  asm volatile("s_waitcnt vmcnt(0)\n\ts_barrier" ::: "memory");
#undef ATT_ISSUE
  if (MODE == 3) {
#pragma unroll
    for (int nq = 0; nq < NQ; ++nq) {
      const float lt = l[nq] + __shfl_xor(l[nq], 32);
      const size_t tok = (size_t)(seq_base + TS * (q0w + 32 * nq + r32));
      bf16_t* po = part_o + tok * 512 + ooff + 4 * hh; float* pm = part_ml + (tok * 8 + (ooff >> 6)) * 2;
      if (hh == 0) { pm[0] = m2[nq]; pm[1] = lt; }
#pragma unroll
      for (int g = 0; g < 4; ++g) {
        uint2 a, b;
        a.x = pack2(o[nq][0][4 * g], o[nq][0][4 * g + 1]); a.y = pack2(o[nq][0][4 * g + 2], o[nq][0][4 * g + 3]);
        b.x = pack2(o[nq][1][4 * g], o[nq][1][4 * g + 1]); b.y = pack2(o[nq][1][4 * g + 2], o[nq][1][4 * g + 3]);
        *(uint2*)(po + 8 * g) = a; *(uint2*)(po + 32 + 8 * g) = b;
      }
    }
    return;
  }
#pragma unroll
  for (int nq = 0; nq < NQ; ++nq) {
    float lt = l[nq] + __shfl_xor(l[nq], 32);
    if (MODE == 2) lt += __builtin_amdgcn_exp2f(sink2 - m2[nq]);
    const float inv = 1.f / lt;
    bf16_t* op = cat + (size_t)(seq_base + q0w + 32 * nq + r32) * DM + ooff + 4 * hh;
#pragma unroll
    for (int g = 0; g < 4; ++g) {
      uint2 a, b;
      a.x = pack2(o[nq][0][4 * g] * inv, o[nq][0][4 * g + 1] * inv); a.y = pack2(o[nq][0][4 * g + 2] * inv, o[nq][0][4 * g + 3] * inv);
      b.x = pack2(o[nq][1][4 * g] * inv, o[nq][1][4 * g + 1] * inv); b.y = pack2(o[nq][1][4 * g + 2] * inv, o[nq][1][4 * g + 3] * inv);
      *(uint2*)(op + 8 * g) = a; *(uint2*)(op + 32 + 8 * g) = b;
    }
  }
}

DI void attn_far_phase(const Params& p, char* lds) {
  OPAQUE_TID(tid0);
  const int wave = tid0 >> 6;
  bf16_t* part_o = (bf16_t*)(p.h + (size_t)NTOK * 512);
  float* part_ml = (float*)(p.big + (size_t)NTOK * 2304);
  for (int u = blockIdx.x; u < 1024; u += gridDim.x) {
    const int head = u >> 7, v = (u & 127) ^ (((u >> 8) & 1) << 6);
    int seq_base, T16, rho, n0;
    if (v < 64) { seq_base = 0; T16 = PROMPT_T / 16; rho = v >> 2; n0 = (v & 3) * 256; }
    else { const int w = v - 64; seq_base = PROMPT_T + (w >> 4) * SAMPLE_T; T16 = SAMPLE_T / 16; rho = w & 15; n0 = 0; }
    int kt0 = (n0 - 64) >> 6; if (kt0 < 0) kt0 = 0;
    int kt1 = ((n0 + 255 + 64) >> 6) + 1; if (kt1 > (T16 >> 6)) kt1 = T16 >> 6;
    attn_unit<3, 1, 16>(p.big, 2304, seq_base + rho, kt0, kt1, 512 + head * 64, 1024 + head * 64, n0 + wave * 32, head * 64, head * 64,
                        exp2f(-(float)(head + 1)) * LOG2E, 0.f, p.xn, lds, part_o, part_ml);
  }
}

DI void attn_phase_l0(const Params& p, char* lds) {
  OPAQUE_TID(tid0);
  const int wave = tid0 >> 6;
  bf16_t* part_o = (bf16_t*)(p.h + (size_t)NTOK * 512);
  float* part_ml = (float*)(p.big + (size_t)NTOK * 2304);
  float mref;
  { float gq = fabsf(p.ab_qg[tid0 & 63]), gk = fabsf(p.ab_kg[tid0 & 63]);
#pragma unroll
    for (int o = 32; o > 0; o >>= 1) { gq = fmaxf(gq, __shfl_xor(gq, o)); gk = fmaxf(gk, __shfl_xor(gk, o)); }
    mref = 8.f * gq * gk * LOG2E; }
  for (int u = blockIdx.x; u < 1536; u += gridDim.x) {
    if (u < 512) {
      int seq_base, T, kvh, qt;
      const int ub = u & 255, xc = ub & 7, xi = ub >> 3;
      if (u < 256) { seq_base = 0; T = PROMPT_T; kvh = xc >> 2; qt = (xc & 3) * 32 + xi; }
      else { seq_base = PROMPT_T + (xc >> 1) * SAMPLE_T; T = SAMPLE_T; kvh = xc & 1; qt = xi; }
      const int head = kvh * 4 + (wave & 3);
      if (mref < 40.f) attn_unit<1, 2, 1, true>(p.big, 2304, seq_base, 0, T >> 6, 2048 + kvh * 64, 2176 + kvh * 64, qt * 128 + (wave >> 2) * 64, 1536 + head * 64, 512 + head * 64, 0.f, mref, p.xn, lds, nullptr, nullptr);
      else attn_unit<1, 2, 1, false>(p.big, 2304, seq_base, 0, T >> 6, 2048 + kvh * 64, 2176 + kvh * 64, qt * 128 + (wave >> 2) * 64, 1536 + head * 64, 512 + head * 64, 0.f, mref, p.xn, lds, nullptr, nullptr);
    } else {
      const int v = u - 512, vb = v & 255, xc = vb & 7, xi = vb >> 3;
      const int head = (v >> 8) * 2 + (xc >> 2), tok0 = ((xc & 3) * 32 + xi) * 256;
      const int seq_base = (tok0 < PROMPT_T) ? 0 : (PROMPT_T + ((tok0 - PROMPT_T) / SAMPLE_T) * SAMPLE_T);
      const int T = (tok0 < PROMPT_T) ? PROMPT_T : SAMPLE_T;
      const int q0b = tok0 - seq_base;
      int kt0 = (q0b - 256) >> 6; if (kt0 < 0) kt0 = 0;
      int kt1 = ((q0b + 255 + 256) >> 6) + 1; if (kt1 > (T >> 6)) kt1 = T >> 6;
      attn_unit<0, 1, 1>(p.big, 2304, seq_base, kt0, kt1, 512 + head * 64, 1024 + head * 64, q0b + wave * 32, head * 64, head * 64,
                         exp2f(-(float)(head + 1)) * LOG2E, 0.f, p.xn, lds, part_o, part_ml);
    }
  }
}

DI void attn_phase_l1(const Params& p, char* lds) {
  OPAQUE_TID(tid0);
  const int wave = tid0 >> 6;
  for (int u = blockIdx.x; u < 1024; u += gridDim.x) {
    const int ub = u & 255, xc = ub & 7, xi = ub >> 3;
    const int kvh = u >> 8, tok0 = (xc * 32 + xi) * 128;
    const int seq_base = (tok0 < PROMPT_T) ? 0 : (PROMPT_T + ((tok0 - PROMPT_T) / SAMPLE_T) * SAMPLE_T);
    const int T = (tok0 < PROMPT_T) ? PROMPT_T : SAMPLE_T;
    const int q0 = tok0 - seq_base, head = kvh * 4 + (wave & 3);
    int kt0 = (q0 - 128) >> 6; if (kt0 < 0) kt0 = 0;
    int kt1 = ((q0 + 127 + 128) >> 6) + 1; if (kt1 > (T >> 6)) kt1 = T >> 6;
    attn_unit<2, 2, 1>(p.big, 1536, seq_base, kt0, kt1, 1024 + kvh * 64, 1280 + kvh * 64, q0 + (wave >> 2) * 64, head * 64, head * 64,
                       exp2f(-0.5f * (float)(head + 1)) * LOG2E, p.c_sink[head] * LOG2E, p.xn, lds, nullptr, nullptr);
  }
}

#define XB_TMO      128
#define XB_XCNT(j)  (256  + 64 * (j))
#define XB_XSUB(j)  (1280 + 64 * (j))
#define XB_XGEN(j)  (2304 + 64 * (j))
#define XB_TOP      3328
#define XB_TOPGEN   3392
#define XCD_BAR_WORDS 3456
#define XB_SPIN_CAP (1u << 22)
DI unsigned xb_ld(unsigned* p) { return __hip_atomic_load(p, __ATOMIC_RELAXED, __HIP_MEMORY_SCOPE_AGENT); }
DI unsigned xb_add(unsigned* p, unsigned v) { return __hip_atomic_fetch_add(p, v, __ATOMIC_RELAXED, __HIP_MEMORY_SCOPE_AGENT); }
DI unsigned xb_xcc_id() { return (unsigned)__builtin_amdgcn_s_getreg((3 << 11) | 20) & 0xFu; }
#define XB_SPIN(cond, bar) do { unsigned _sp = 0; while (cond) { __builtin_amdgcn_s_sleep(1); \
    if ((++_sp & 255u) == 0u) { if (xb_ld(&(bar)[XB_TMO])) break; if (_sp > XB_SPIN_CAP) { atomicAdd(&(bar)[XB_TMO], 1u); break; } } } } while (0)
struct XcdBarrier { unsigned* bar; unsigned x; volatile unsigned* st; };
DI void xcd_barrier_complete(unsigned* bar, unsigned x, unsigned& nloc, unsigned& nx) {
  const unsigned G = gridDim.x;
  unsigned sum, cnt, mine, sp = 0u;
  for (;;) {
    sum = 0u; cnt = 0u; mine = 0u;
#pragma unroll
    for (unsigned j = 0; j < 16; ++j) { const unsigned c = xb_ld(&bar[XB_XCNT(j)]); sum += c; cnt += (c > 0u) ? 1u : 0u; mine = (j == x) ? c : mine; }
    if (sum == G) break;
    __builtin_amdgcn_s_sleep(1);
    if ((++sp & 255u) == 0u) { if (xb_ld(&bar[XB_TMO])) break; if (sp > XB_SPIN_CAP) { atomicAdd(&bar[XB_TMO], 1u); break; } }
  }
  nloc = mine > 0u ? mine : 1u; nx = cnt > 0u ? cnt : 1u;
}
DI void xcd_barrier(const XcdBarrier& b) {
  asm volatile("s_waitcnt vmcnt(0)" ::: "memory");
  __syncthreads();
  if (threadIdx.x == 0) {
    unsigned* bar = b.bar;
    __builtin_amdgcn_s_waitcnt(0);
    unsigned nloc = b.st[0], nx = b.st[1];
    if (nloc == 0u) { xcd_barrier_complete(bar, b.x, nloc, nx); b.st[0] = nloc; b.st[1] = nx; }
    const unsigned old = xb_add(&bar[XB_XSUB(b.x)], 1u);
    const unsigned gen = old / nloc;
    if (old + 1u == (gen + 1u) * nloc) {
      __builtin_amdgcn_fence(__ATOMIC_RELEASE, "agent");
      asm volatile("s_waitcnt vmcnt(0)" ::: "memory");
      const unsigned og = xb_add(&bar[XB_TOP], 1u);
      const unsigned tg = og / nx;
      if (og + 1u == (tg + 1u) * nx) xb_add(&bar[XB_TOPGEN], 1u);
      else XB_SPIN(xb_ld(&bar[XB_TOPGEN]) == tg, bar);
      __builtin_amdgcn_fence(__ATOMIC_ACQUIRE, "agent");
      xb_add(&bar[XB_XGEN(b.x)], 1u);
      asm volatile("s_waitcnt vmcnt(0)" ::: "memory");
    } else {
      XB_SPIN(xb_ld(&bar[XB_XGEN(b.x)]) == gen, bar);
      __builtin_amdgcn_fence(__ATOMIC_ACQUIRE, "agent");
      asm volatile("s_waitcnt vmcnt(0)" ::: "memory");
    }
  }
  __syncthreads();
}

__global__ void __launch_bounds__(512) fwd_megakernel(Params p) {
  cg::grid_group grid = cg::this_grid();
  __shared__ __attribute__((aligned(1024))) char lds[8 * HTB + 64 + 2048];
  volatile unsigned* bst = (volatile unsigned*)(lds + 8 * HTB);
  if (threadIdx.x < 2) bst[threadIdx.x] = 0u;
  __syncthreads();
  XcdBarrier xb; xb.bar = p.bar; xb.x = xb_xcc_id(); xb.st = bst;
  if (threadIdx.x == 0) (void)xb_add(&p.bar[XB_XCNT(xb.x)], 1u);
  convert_phase(p, 0, (float*)lds);
  init_phase(p);
  xcd_barrier(xb);
  if (p.pad) grid.sync();
  for (int layer = 0; layer < 2; ++layer) {
    for (int f = 0; f < 2; ++f) {
      if (f == 1) {
        if (layer == 0) gemm_phase(p.h16, p.wts + W_IN, NTOK, 2304, DM, EpiProj{p.big, 2304, p.ssq}, lds);
        else gemm_phase(p.h16, p.wts + W_IN, NTOK, 1536, DM, EpiProj{p.big, 1536, p.ssq}, lds);
        xcd_barrier(xb);
        if (layer == 0) {
          bprep_phase(p);
          attn_far_phase(p, lds);
          xcd_barrier(xb);
          attn_phase_l0(p, lds);
        } else {
          attn_phase_l1(p, lds);
        }
        xcd_barrier(xb);
        gemm_phase(p.xn, p.wts + W_OUT, NTOK, DM, DM, EpiResid{p.h16, p.h16, 1.0f, p.ssq}, lds);
        xcd_barrier(xb);
      }
      const int rows = NTOK / p.ffn_chunks;
      const bool last = (layer == 1 && f == 1);
      for (int c = 0; c < p.ffn_chunks; ++c) {
        const size_t ro = (size_t)c * rows;
        gemm_phase(p.h16 + ro * DM, p.wts + (f ? W_UPB : W_UPA), rows, 2 * DFF, DM, EpiUp{p.big, p.ssq + ro * 16}, lds);
        xcd_barrier(xb);
        gemm_phase(p.big, p.wts + (f ? W_DNB : W_DNA), rows, DM, DFF, EpiResid{p.h16 + ro * DM, (last ? p.xn : p.h16) + ro * DM, 0.5f, p.ssq + ro * 16}, lds);
        xcd_barrier(xb);
      }
    }
    if (layer == 0) { convert_phase(p, 1, (float*)lds); xcd_barrier(xb); }
  }
  final_norm_phase(p);
}

extern "C" void kernel_launch(void* const* d_in, const int* in_sizes, int n_in, void* d_out, int out_size, void* d_ws, size_t ws_size, hipStream_t stream) {
  static int grid_blocks = 0;
  if (!grid_blocks) {
    int dev = 0, cus = 0, per_cu = 0;
    hipGetDevice(&dev);
    hipDeviceGetAttribute(&cus, hipDeviceAttributeMultiprocessorCount, dev);
    hipOccupancyMaxActiveBlocksPerMultiprocessor(&per_cu, fwd_megakernel, 512, 0);
    if (per_cu > 1) per_cu = 1;
    if (per_cu < 1) per_cu = 1;
    grid_blocks = cus * per_cu;
  }
  Params p{};
  p.x_prompt = (const float*)d_in[0]; p.x_sample = (const float*)d_in[1]; p.norm_g = (const float*)d_in[2];
  p.w1 = (const float*)d_in[3]; p.w3 = (const float*)d_in[4]; p.w2 = (const float*)d_in[5];
  p.ab_w_in = (const float*)d_in[6]; p.ab_w_out = (const float*)d_in[7]; p.ab_qg = (const float*)d_in[8]; p.ab_kg = (const float*)d_in[9];
  p.c_w_in = (const float*)d_in[10]; p.c_w_out = (const float*)d_in[11]; p.c_sink = (const float*)d_in[12]; p.final_g = (const float*)d_in[13];
  p.h = (float*)d_out;
  char* ws = (char*)d_ws;
  const size_t MiB = 1024 * 1024;
  p.wts = (bf16_t*)ws;
  p.xn = (bf16_t*)(ws + 40 * MiB);
  p.big = (bf16_t*)(ws + 104 * MiB);
  p.ffn_chunks = (ws_size >= 283 * MiB) ? 1 : 2;
  { const size_t tail = (p.ffn_chunks == 1 ? 280 : 250) * MiB; p.bar = (unsigned*)(ws + tail); p.ssq = (bf16_t*)(ws + tail + 65536); }
  p.h16 = (bf16_t*)d_out;
  hipMemsetAsync(p.bar, 0, XCD_BAR_WORDS * sizeof(unsigned), stream);
  p.pad = 0;
  void* args[] = {&p};
  hipError_t e = hipLaunchCooperativeKernel((void*)fwd_megakernel, dim3(grid_blocks), dim3(512), args, 0, stream);
  if (e != hipSuccess) fprintf(stderr, "cooperative launch failed: %s (grid %d)\n", hipGetErrorString(e), grid_blocks);
}
```

```cpp
#include <hip/hip_runtime.h>
#include <hip/hip_cooperative_groups.h>
#include <cstdio>
namespace cg = cooperative_groups;

typedef unsigned short bf16_t;
typedef short bf16x8 __attribute__((ext_vector_type(8)));
typedef float f32x16 __attribute__((ext_vector_type(16)));
#define DI __device__ __forceinline__
#define OPAQUE_TID(v) int v = threadIdx.x; asm volatile("" : "+v"(v))
#define MFMA32(a, b, c) __builtin_amdgcn_mfma_f32_32x32x16_bf16((a), (b), (c), 0, 0, 0)

constexpr int NTOK = 32768, DM = 1024, DFF = 2816;
constexpr int PROMPT_T = 16384, SAMPLE_T = 4096;
constexpr float EPS = 1e-6f;
constexpr float LOG2E = 1.4426950408889634f;

constexpr size_t W_UPA = 0, W_DNA = 5767168, W_UPB = 8650752, W_DNB = 14417920, W_IN = 17301504, W_OUT = 19660800, W_TOTAL = 20709376;

struct Params {
  const float* x_prompt; const float* x_sample; const float* norm_g; const float* w1; const float* w3; const float* w2;
  const float* ab_w_in; const float* ab_w_out; const float* ab_qg; const float* ab_kg;
  const float* c_w_in; const float* c_w_out; const float* c_sink; const float* final_g;
  float* h; bf16_t* wts; bf16_t* xn; bf16_t* big; unsigned* bar; bf16_t* ssq; bf16_t* h16;
  int ffn_chunks; int pad;
};

DI bf16_t f2bf(float x) { unsigned u = __float_as_uint(x); u += 0x7fffu + ((u >> 16) & 1u); return (bf16_t)(u >> 16); }
DI float bf2f(bf16_t v) { return __uint_as_float(((unsigned)v) << 16); }
DI float bflo(unsigned u) { return __uint_as_float(u << 16); }
DI float bfhi(unsigned u) { return __uint_as_float(u & 0xffff0000u); }
typedef __bf16 bf16x2_t __attribute__((ext_vector_type(2)));
typedef float f32x2_t __attribute__((ext_vector_type(2)));
DI unsigned pack2(float lo, float hi) { f32x2_t v = {lo, hi}; return __builtin_bit_cast(unsigned, __builtin_convertvector(v, bf16x2_t)); }
DI int crow(int reg, int h) { return (reg & 3) + 8 * (reg >> 2) + 4 * h; }

DI void convert_tile(const float* __restrict__ src, int K, int N, int kt, int nt, bf16_t* __restrict__ dst, int mode, const float* __restrict__ g, float* lds) {
  OPAQUE_TID(tid);
#pragma unroll 8
  for (int i = 0; i < 32; ++i) { const int e = tid + 512 * i, kk = e >> 8, nn = e & 255; lds[kk * 257 + nn] = src[(size_t)(kt * 64 + kk) * N + nt * 256 + nn] * (g ? g[kt * 64 + kk] : 1.f); }
  __syncthreads();
#pragma unroll
  for (int j = 0; j < 4; ++j) {
    const int pc = tid + 512 * j, nn = pc >> 3, kc = pc & 7, n = nt * 256 + nn;
    const int drow = (mode == 0) ? n : ((n >> 7) * 256 + (n & 127) + (mode == 2 ? 128 : 0));
    const float* lp = lds + kc * 8 * 257 + nn;
    uint4 v; v.x = pack2(lp[0], lp[257]); v.y = pack2(lp[514], lp[771]); v.z = pack2(lp[1028], lp[1285]); v.w = pack2(lp[1542], lp[1799]);
    *(uint4*)(dst + (size_t)drow * K + kt * 64 + kc * 8) = v;
  }
  __syncthreads();
}

DI void convert_phase(const Params& p, int layer, float* lds) {
  const int n_in = (layer == 0) ? 2304 : 1536;
  const int t_up = 16 * 11, t_in = 16 * (n_in / 256), t_out = 16 * 4;
  const int total = 6 * t_up + t_in + t_out;
  for (int u = blockIdx.x; u < total; u += gridDim.x) {
    int r = u; const float* src; bf16_t* dst; int K, N, mode; const float* g = nullptr;
    if (r < 6 * t_up) {
      int mtx = r / t_up; r -= mtx * t_up; int f = mtx / 3, which = mtx % 3;
      size_t base = (size_t)(layer * 2 + f) * DM * DFF;
      if (which == 0) { src = p.w1 + base; K = DM; N = DFF; mode = 1; dst = p.wts + (f ? W_UPB : W_UPA); g = p.norm_g + (layer * 3 + (f ? 2 : 0)) * DM; }
      else if (which == 1) { src = p.w3 + base; K = DM; N = DFF; mode = 2; dst = p.wts + (f ? W_UPB : W_UPA); g = p.norm_g + (layer * 3 + (f ? 2 : 0)) * DM; }
      else { src = p.w2 + base; K = DFF; N = DM; mode = 0; dst = p.wts + (f ? W_DNB : W_DNA); }
    } else if (r < 6 * t_up + t_in) {
      r -= 6 * t_up; src = (layer == 0) ? p.ab_w_in : p.c_w_in; K = DM; N = n_in; mode = 0; dst = p.wts + W_IN; g = p.norm_g + (layer * 3 + 1) * DM;
    } else {
      r -= 6 * t_up + t_in; src = (layer == 0) ? p.ab_w_out : p.c_w_out; K = DM; N = DM; mode = 0; dst = p.wts + W_OUT;
    }
    const int ntn = N / 256; const int kt = r / ntn, nt = r % ntn;
    convert_tile(src, K, N, kt, nt, dst, mode, g, lds);
  }
}

DI void init_phase(const Params& p) {
  OPAQUE_TID(tid);
  const int lane = tid & 63, wave = tid >> 6;
  for (int row = blockIdx.x * 8 + wave; row < NTOK; row += gridDim.x * 8) {
    const float* src = (row < PROMPT_T) ? p.x_prompt + (size_t)row * DM : p.x_sample + (size_t)(row - PROMPT_T) * DM;
    float ss = 0.f;
#pragma unroll
    for (int i = 0; i < 4; ++i) { const float4 v = *(const float4*)(src + lane * 4 + 256 * i); ss += v.x * v.x + v.y * v.y + v.z * v.z + v.w * v.w;
      uint2 o2; o2.x = pack2(v.x, v.y); o2.y = pack2(v.z, v.w); *(uint2*)(p.h16 + (size_t)row * DM + lane * 4 + 256 * i) = o2; }
#pragma unroll
    for (int o = 32; o > 0; o >>= 1) ss += __shfl_xor(ss, o);
    if (lane < 16) p.ssq[(size_t)row * 16 + lane] = (lane == 0) ? f2bf(ss) : (bf16_t)0;
  }
}
DI void final_norm_phase(const Params& p) {
  OPAQUE_TID(tid);
  const int lane = tid & 63, wave = tid >> 6;
  float4 gv[4];
#pragma unroll
  for (int i = 0; i < 4; ++i) gv[i] = *(const float4*)(p.final_g + lane * 4 + 256 * i);
  for (int row = blockIdx.x * 8 + wave; row < NTOK; row += gridDim.x * 8) {
    float4 v[4]; float ss = 0.f;
#pragma unroll
    for (int i = 0; i < 4; ++i) { const uint2 u = *(const uint2*)(p.xn + (size_t)row * DM + lane * 4 + 256 * i);
      v[i].x = bflo(u.x); v[i].y = bfhi(u.x); v[i].z = bflo(u.y); v[i].w = bfhi(u.y); ss += v[i].x * v[i].x + v[i].y * v[i].y + v[i].z * v[i].z + v[i].w * v[i].w; }
#pragma unroll
    for (int o = 32; o > 0; o >>= 1) ss += __shfl_xor(ss, o);
    const float r = rsqrtf(ss * (1.0f / DM) + EPS);
#pragma unroll
    for (int i = 0; i < 4; ++i) { float4 y; y.x = v[i].x * r * gv[i].x; y.y = v[i].y * r * gv[i].y; y.z = v[i].z * r * gv[i].z; y.w = v[i].w * r * gv[i].w;
      *(float4*)(p.h + (size_t)row * DM + lane * 4 + 256 * i) = y; }
  }
}

typedef float f32x4 __attribute__((ext_vector_type(4)));
typedef unsigned u32x4 __attribute__((ext_vector_type(4)));
#define PG8_LAS __attribute__((address_space(3)))
constexpr int BM = 256, BK = 64, HALF = 128, HTB = HALF * BK * 2, STAGE_B = 4 * HTB, NXCD = 8, WGM = 8;
DI int lds_byte(int r, int c) { const int st = (r >> 4) * 2 + (c >> 5), rr = r & 15, cc = c & 31, ob = rr * 64 + cc * 2; return st * 1024 + (ob ^ (((ob >> 9) & 1) << 5)); }
DI void stage_rc(int b, int& R, int& C) { const int st = b / 1024, sb = b % 1024, swz = sb ^ (((sb >> 9) & 1) << 5); R = (st >> 1) * 16 + swz / 64; C = (st & 1) * 32 + (swz % 64) / 2; }
DI int perm32(int rho) { const int n = rho >> 4, i = rho & 15; return 8 * (i >> 2) + 4 * n + (i & 3); }
struct Unit { int pm, pn; };
struct StaticOrder {
  int nM, nN, nwg, G, c, rev;
  DI void init(int M, int N, int G_, int c_, int rev_) { nM = M / BM; nN = N / BM; nwg = nM * nN; G = G_; c = c_; rev = rev_; }
  DI bool next(int i, Unit& u) const {
    const long L = (long)i * G + c; if (L >= nwg) return false;
    int wgid = (int)L; { const int q = nwg / NXCD, r = nwg % NXCD, xcd = wgid % NXCD, off = wgid / NXCD; wgid = (xcd < r ? xcd * (q + 1) : r * (q + 1) + (xcd - r) * q) + off; }
    const int nig = WGM * nN, gid = wgid / nig, fm = gid * WGM, gsz = (nM - fm) < WGM ? (nM - fm) : WGM;
    u.pm = fm + ((wgid % nig) % gsz); u.pn = (wgid % nig) / gsz; if (rev) u.pm = nM - 1 - u.pm; return true;
  }
};
constexpr int RT_OFF = 8 * HTB + 64;
DI void acc_zero(f32x4 (&acc)[2][2][4][2]) {
#pragma unroll
  for (int a = 0; a < 2; ++a)
#pragma unroll
    for (int b = 0; b < 2; ++b)
#pragma unroll
      for (int m = 0; m < 4; ++m)
#pragma unroll
        for (int n = 0; n < 2; ++n) acc[a][b][m][n] = (f32x4){0.f, 0.f, 0.f, 0.f};
}
struct EpiProj {
  static constexpr bool PERM = true, NEEDS_R = true;
  bf16_t* O; int ldc; const bf16_t* ssq;
  DI void init(f32x4 (&acc)[2][2][4][2], const Unit&, int, int, int, int) const { acc_zero(acc); }
  DI void operator()(const f32x4 (&acc)[2][2][4][2], const Unit& u, int wr, int wc, int fr, int fq, const PG8_LAS float* rt) const {
    const int row0 = u.pm * BM + wr * 64 + fr, col0 = u.pn * BM + wc * 32 + 8 * fq;
#pragma unroll
    for (int ai = 0; ai < 2; ++ai)
#pragma unroll
      for (int m = 0; m < 4; ++m) { bf16_t* rowp = O + (size_t)(row0 + ai * HALF + m * 16) * ldc + col0; const float r = rt[ai * HALF + wr * 64 + m * 16 + fr];
#pragma unroll
        for (int bj = 0; bj < 2; ++bj) { const f32x4 v0 = acc[ai][bj][m][0] * r, v1 = acc[ai][bj][m][1] * r;
          u32x4 w; w.x = pack2(v0[0], v0[1]); w.y = pack2(v0[2], v0[3]); w.z = pack2(v1[0], v1[1]); w.w = pack2(v1[2], v1[3]);
          *(u32x4*)(rowp + bj * HALF) = w; } }
  }
};
struct EpiUp {
  static constexpr bool PERM = true, NEEDS_R = true;
  bf16_t* O; const bf16_t* ssq;
  DI void init(f32x4 (&acc)[2][2][4][2], const Unit&, int, int, int, int) const { acc_zero(acc); }
  DI void operator()(const f32x4 (&acc)[2][2][4][2], const Unit& u, int wr, int wc, int fr, int fq, const PG8_LAS float* rt) const {
    const int row0 = u.pm * BM + wr * 64 + fr, col0 = u.pn * HALF + wc * 32 + 8 * fq;
#pragma unroll
    for (int ai = 0; ai < 2; ++ai)
#pragma unroll
      for (int m = 0; m < 4; ++m) {
        const float r = rt[ai * HALF + wr * 64 + m * 16 + fr], nr = -LOG2E * r, r2 = r * r;
        float a[8];
#pragma unroll
        for (int n = 0; n < 2; ++n)
#pragma unroll
          for (int j = 0; j < 4; ++j) { const float u1 = acc[ai][0][m][n][j], u3 = acc[ai][1][m][n][j]; a[4 * n + j] = (u1 * u3) * (r2 * __builtin_amdgcn_rcpf(1.f + __builtin_amdgcn_exp2f(u1 * nr))); }
        u32x4 w; w.x = pack2(a[0], a[1]); w.y = pack2(a[2], a[3]); w.z = pack2(a[4], a[5]); w.w = pack2(a[6], a[7]);
        *(u32x4*)(O + (size_t)(row0 + ai * HALF + m * 16) * DFF + col0) = w; }
  }
};
struct EpiResid {
  static constexpr bool PERM = true, NEEDS_R = false;
  const bf16_t* src; bf16_t* dst; float coef; bf16_t* ssq;
  DI void init(f32x4 (&acc)[2][2][4][2], const Unit& u, int wr, int wc, int fr, int fq) const {
    const int row0 = u.pm * BM + wr * 64 + fr, col0 = u.pn * BM + wc * 32 + 8 * fq; const float ic = 1.f / coef;
#pragma unroll
    for (int ai = 0; ai < 2; ++ai)
#pragma unroll
      for (int m = 0; m < 4; ++m) { const bf16_t* rowp = src + (size_t)(row0 + ai * HALF + m * 16) * DM + col0;
#pragma unroll
        for (int bj = 0; bj < 2; ++bj) { const u32x4 w = *(const u32x4*)(rowp + bj * HALF);
          acc[ai][bj][m][0] = (f32x4){bflo(w.x), bfhi(w.x), bflo(w.y), bfhi(w.y)} * ic; acc[ai][bj][m][1] = (f32x4){bflo(w.z), bfhi(w.z), bflo(w.w), bfhi(w.w)} * ic; } }
  }
  DI void operator()(const f32x4 (&acc)[2][2][4][2], const Unit& u, int wr, int wc, int fr, int fq, const PG8_LAS float*) const {
    const int row0 = u.pm * BM + wr * 64 + fr, col0 = u.pn * BM + wc * 32 + 8 * fq;
#pragma unroll
    for (int ai = 0; ai < 2; ++ai)
#pragma unroll
      for (int m = 0; m < 4; ++m) { const int row = row0 + ai * HALF + m * 16; bf16_t* rowp = dst + (size_t)row * DM + col0; float ss = 0.f;
#pragma unroll
        for (int bj = 0; bj < 2; ++bj) { const f32x4 v0 = acc[ai][bj][m][0] * coef, v1 = acc[ai][bj][m][1] * coef;
          ss += v0[0] * v0[0] + v0[1] * v0[1] + v0[2] * v0[2] + v0[3] * v0[3] + v1[0] * v1[0] + v1[1] * v1[1] + v1[2] * v1[2] + v1[3] * v1[3];
          u32x4 w; w.x = pack2(v0[0], v0[1]); w.y = pack2(v0[2], v0[3]); w.z = pack2(v1[0], v1[1]); w.w = pack2(v1[2], v1[3]);
          *(u32x4*)(rowp + bj * HALF) = w; }
        ss += __shfl_xor(ss, 16); ss += __shfl_xor(ss, 32);
        if (fq == 0) ssq[(size_t)row * 16 + u.pn * 4 + wc] = f2bf(ss); }
  }
};

template <class Epi>
DI void gemm_phase(const bf16_t* __restrict__ gA, const bf16_t* __restrict__ gBt, int M, int N, int K, const Epi& E, char* lds_generic, int rev = 0) {
  PG8_LAS unsigned char* lds = (PG8_LAS unsigned char*)lds_generic;
  OPAQUE_TID(tid);
  const int wid = __builtin_amdgcn_readfirstlane(tid >> 6), lane = tid & 63, wr = wid >> 2, wc = wid & 3, fr = lane & 15, fq = lane >> 4;
  const int nt = K / BK;
  StaticOrder S; S.init(M, N, gridDim.x, blockIdx.x, rev);
  unsigned voffA[2], voffB[2];
#pragma unroll
  for (int i = 0; i < 2; ++i) { int R, C; stage_rc(tid * 16 + i * 8192, R, C); const int Rb = Epi::PERM ? ((R & ~31) + perm32(R & 31)) : R;
    voffA[i] = (unsigned)(R * K + C) * 2u; voffB[i] = (unsigned)(Rb * K + C) * 2u; }
  const size_t kstep = (size_t)(BK * 2);
  const size_t hstep = (size_t)HALF * K * 2;
  const size_t tstep = 2 * hstep;
  const unsigned ldsw = (unsigned)wid * 1024u;
  const int aoff = lds_byte(wr * 64 + fr, fq * 8), boff = lds_byte(wc * 32 + fr, fq * 8);
#define PG8_SA(b, h) (((b) * 2 + (h)) * HTB)
#define PG8_SB(b, h) ((4 + (b) * 2 + (h)) * HTB)
#define PG8_STAGE(bufoff, gbase, voff) do { _Pragma("unroll") for (int _i = 0; _i < 2; ++_i) \
    __builtin_amdgcn_global_load_lds((const unsigned*)((const char*)(gbase) + (voff)[_i]), (PG8_LAS unsigned*)(lds + (bufoff) + ldsw + _i * 8192), 16, 0, 0); } while (0)
#define PG8_LDA(dst, b, h) do { _Pragma("unroll") for (int m = 0; m < 4; ++m) _Pragma("unroll") for (int k = 0; k < 2; ++k) dst[m][k] = *(const PG8_LAS bf16x8*)(lds + PG8_SA(b, h) + aoff + m * 2048 + k * 1024); } while (0)
#define PG8_LDB(dst, b, h) do { _Pragma("unroll") for (int n = 0; n < 2; ++n) _Pragma("unroll") for (int k = 0; k < 2; ++k) dst[n][k] = *(const PG8_LAS bf16x8*)(lds + PG8_SB(b, h) + boff + n * 2048 + k * 1024); } while (0)
#define PG8_MMA(ai, bj, At, Bt) do { __builtin_amdgcn_s_setprio(1); _Pragma("unroll") for (int m = 0; m < 4; ++m) _Pragma("unroll") for (int n = 0; n < 2; ++n) _Pragma("unroll") for (int k = 0; k < 2; ++k) \
    acc[ai][bj][m][n] = __builtin_amdgcn_mfma_f32_16x16x32_bf16(Bt[n][k], At[m][k], acc[ai][bj][m][n], 0, 0, 0); __builtin_amdgcn_s_setprio(0); } while (0)
#define PG8_WAIT_V(n) asm volatile("s_waitcnt vmcnt(" #n ")" ::: "memory")
#define PG8_WAIT_L(n) asm volatile("s_waitcnt lgkmcnt(" #n ")" ::: "memory")
#define PG8_BAR __builtin_amdgcn_s_barrier()
#define PG8_SCHED __builtin_amdgcn_sched_barrier(0)
  Unit cur, nxt; int ui = 0;
  if (!S.next(0, cur)) return;
  f32x4 acc[2][2][4][2];
  E.init(acc, cur, wr, wc, fr, fq);
#define PG8_RTAB_LOAD(var, unit) do { if constexpr (Epi::NEEDS_R) { var = *(const uint4*)(E.ssq + (size_t)((unit).pm * BM + (tid >> 1)) * 16 + (tid & 1) * 8); } } while (0)
#define PG8_RTAB_FIN(var, buf) do { if constexpr (Epi::NEEDS_R) { float ss_ = bflo(var.x) + bfhi(var.x) + bflo(var.y) + bfhi(var.y) + bflo(var.z) + bfhi(var.z) + bflo(var.w) + bfhi(var.w); ss_ += __shfl_xor(ss_, 1); \
    if (!(tid & 1)) ((PG8_LAS float*)(lds + RT_OFF))[(buf) * 256 + (tid >> 1)] = rsqrtf(ss_ * (1.0f / DM) + EPS); } } while (0)
  { uint4 rt0_ = {0u, 0u, 0u, 0u}; PG8_RTAB_LOAD(rt0_, cur); PG8_RTAB_FIN(rt0_, 0); }
  bf16x8 At[4][2], B0[2][2], B1[2][2];
  const char* cA = (const char*)gA + (size_t)cur.pm * tstep; const char* cB = (const char*)gBt + (size_t)cur.pn * tstep;
  PG8_STAGE(PG8_SB(0, 0), cB, voffB); PG8_STAGE(PG8_SA(0, 0), cA, voffA); PG8_STAGE(PG8_SB(0, 1), cB + hstep, voffB); PG8_STAGE(PG8_SA(0, 1), cA + hstep, voffA);
  if (wr == 1) PG8_BAR;
  PG8_WAIT_V(4); PG8_BAR;
  PG8_STAGE(PG8_SB(1, 0), cB + kstep, voffB); PG8_STAGE(PG8_SA(1, 0), cA + kstep, voffA); PG8_STAGE(PG8_SB(1, 1), cB + hstep + kstep, voffB);
  PG8_WAIT_V(6); PG8_BAR;
  for (;;) {
    const bool has_next = S.next(ui + 1, nxt);
    const char* nA = has_next ? (const char*)gA + (size_t)nxt.pm * tstep : cA; const char* nB = has_next ? (const char*)gBt + (size_t)nxt.pn * tstep : cB;
    for (int t = 0; t < nt; t += 2) {
      const bool last = (t == nt - 2);
      const char* a1 = cA + (size_t)(t + 1) * kstep;
      const char* a2 = last ? nA : cA + (size_t)(t + 2) * kstep; const char* b2 = last ? nB : cB + (size_t)(t + 2) * kstep;
      const char* a3 = a2 + kstep; const char* b3 = b2 + kstep;
      PG8_LDB(B0, 0, 0); PG8_SCHED; PG8_LDA(At, 0, 0); PG8_STAGE(PG8_SA(1, 1), a1 + hstep, voffA);
      PG8_WAIT_L(8); PG8_BAR; PG8_WAIT_L(0); PG8_MMA(0, 0, At, B0); PG8_BAR; PG8_SCHED;
      PG8_LDB(B1, 0, 1); PG8_STAGE(PG8_SB(0, 0), b2, voffB);
      PG8_BAR; PG8_WAIT_L(0); PG8_MMA(0, 1, At, B1); PG8_BAR;
      PG8_LDA(At, 0, 1); PG8_STAGE(PG8_SA(0, 0), a2, voffA);
      PG8_BAR; PG8_WAIT_L(0); PG8_MMA(1, 0, At, B0); PG8_BAR; PG8_SCHED;
      PG8_STAGE(PG8_SB(0, 1), b2 + hstep, voffB);
      PG8_WAIT_V(6); PG8_BAR; PG8_MMA(1, 1, At, B1); PG8_BAR;
      PG8_LDB(B0, 1, 0); PG8_SCHED; PG8_LDA(At, 1, 0); PG8_STAGE(PG8_SA(0, 1), a2 + hstep, voffA);
      PG8_WAIT_L(8); PG8_BAR; PG8_WAIT_L(0); PG8_MMA(0, 0, At, B0); PG8_BAR; PG8_SCHED;
      PG8_LDB(B1, 1, 1); PG8_STAGE(PG8_SB(1, 0), b3, voffB);
      PG8_BAR; PG8_WAIT_L(0); PG8_MMA(0, 1, At, B1); PG8_BAR;
      PG8_LDA(At, 1, 1); PG8_STAGE(PG8_SA(1, 0), a3, voffA);
      PG8_BAR; PG8_WAIT_L(0); PG8_MMA(1, 0, At, B0); PG8_BAR; PG8_SCHED;
      PG8_STAGE(PG8_SB(1, 1), b3 + hstep, voffB);
      PG8_WAIT_V(6); PG8_BAR; PG8_MMA(1, 1, At, B1); PG8_BAR;
    }
    uint4 rtn_ = {0u, 0u, 0u, 0u};
    if (has_next) PG8_RTAB_LOAD(rtn_, nxt);
    E(acc, cur, wr, wc, fr, fq, (const PG8_LAS float*)(lds + RT_OFF) + (ui & 1) * 256);
    if (!has_next) break;
    PG8_RTAB_FIN(rtn_, (ui + 1) & 1);
    E.init(acc, nxt, wr, wc, fr, fq);
    cur = nxt; cA = nA; cB = nB; ++ui;
  }
  PG8_WAIT_V(0);
  if (wr == 0) PG8_BAR;
  PG8_BAR;
#undef PG8_RTAB_LOAD
#undef PG8_RTAB_FIN
#undef PG8_SA
#undef PG8_SB
#undef PG8_STAGE
#undef PG8_LDA
#undef PG8_LDB
#undef PG8_MMA
#undef PG8_WAIT_V
#undef PG8_WAIT_L
#undef PG8_BAR
#undef PG8_SCHED
}

DI void bprep_phase(const Params& p) {
  OPAQUE_TID(tid);
  const int pi = tid & 31, tl = tid >> 5;
  const float fr = exp2f(-(float)((pi & 15) * 2) * (1.0f / 32.0f) * 13.287712379549449f);
  const float qg0 = p.ab_qg[2 * pi], qg1 = p.ab_qg[2 * pi + 1], kg0 = p.ab_kg[2 * pi], kg1 = p.ab_kg[2 * pi + 1];
  for (int t = blockIdx.x * 16 + tl; t < NTOK; t += gridDim.x * 16) {
    const int pos = (t < PROMPT_T) ? t : ((t - PROMPT_T) & (SAMPLE_T - 1));
    const float ang = (float)((pi < 16) ? (pos >> 6) : (pos & 63)) * fr;
    const float cs = __cosf(ang), sn = __sinf(ang);
    unsigned* rowp = (unsigned*)(p.big + (size_t)t * 2304);
#pragma unroll
    for (int hd = 0; hd < 10; ++hd) {
      const int col = (hd < 8) ? (1536 + hd * 64) : (2048 + (hd - 8) * 64);
      unsigned u = rowp[(col >> 1) + pi];
      float x1 = bflo(u), x2 = bfhi(u);
      float ss = x1 * x1 + x2 * x2;
#pragma unroll
      for (int o = 16; o > 0; o >>= 1) ss += __shfl_xor(ss, o);
      const float r = rsqrtf(ss * (1.0f / 64.0f) + EPS);
      x1 = x1 * r * ((hd < 8) ? qg0 : kg0); x2 = x2 * r * ((hd < 8) ? qg1 : kg1);
      const float qs = (hd < 8) ? 0.125f * LOG2E : 1.f;
      rowp[(col >> 1) + pi] = pack2((x1 * cs - x2 * sn) * qs, (x1 * sn + x2 * cs) * qs);
    }
  }
}

template <int MODE>
DI void naive_attn(const Params& p, const bf16_t* __restrict__ proj, int ld, int qoff, int koff, int voff, int nqh, int G, bf16_t* cat, int cat_off) {
  const int total = NTOK * nqh;
  for (int idx = blockIdx.x * 256 + threadIdx.x; idx < total; idx += gridDim.x * 256) {
    const int head = idx / NTOK, t = idx % NTOK, hk = head / G;
    const int seq_base = (t < PROMPT_T) ? 0 : (PROMPT_T + ((t - PROMPT_T) / SAMPLE_T) * SAMPLE_T);
    const int T = (t < PROMPT_T) ? PROMPT_T : SAMPLE_T;
    const int pos = t - seq_base;
    float q[64], o[64];
    { const uint4* qp = (const uint4*)(proj + (size_t)t * ld + qoff + head * 64);
#pragma unroll
      for (int c = 0; c < 8; ++c) { uint4 v = qp[c]; q[8*c] = bflo(v.x); q[8*c+1] = bfhi(v.x); q[8*c+2] = bflo(v.y); q[8*c+3] = bfhi(v.y); q[8*c+4] = bflo(v.z); q[8*c+5] = bfhi(v.z); q[8*c+6] = bflo(v.w); q[8*c+7] = bfhi(v.w); } }
#pragma unroll
    for (int d = 0; d < 64; ++d) o[d] = 0.f;
    float m = -1e30f, l = 0.f, slope = 0.f;
    if (MODE == 0) slope = exp2f(-(float)(head + 1));
    if (MODE == 2) { slope = exp2f(-0.5f * (float)(head + 1)); m = p.c_sink[head]; l = 1.f; }
    const int nkeys = (MODE == 0) ? 387 : (MODE == 1 ? T : 257);
    for (int j = 0; j < nkeys; ++j) {
      int off;
      if (MODE == 0) { const int br = j / 129, jj = j % 129 - 64; off = jj * (br == 0 ? 1 : (br == 1 ? 4 : 16)); }
      else if (MODE == 1) off = j - pos;
      else off = j - 128;
      const int kp = pos + off;
      if (kp < 0 || kp >= T) continue;
      const uint4* kptr = (const uint4*)(proj + (size_t)(seq_base + kp) * ld + koff + hk * 64);
      float s = 0.f;
#pragma unroll
      for (int c = 0; c < 8; ++c) { uint4 v = kptr[c];
        s += q[8*c] * bflo(v.x) + q[8*c+1] * bfhi(v.x) + q[8*c+2] * bflo(v.y) + q[8*c+3] * bfhi(v.y) + q[8*c+4] * bflo(v.z) + q[8*c+5] * bfhi(v.z) + q[8*c+6] * bflo(v.w) + q[8*c+7] * bfhi(v.w); }
      s *= 0.125f;
      if (MODE != 1) s -= slope * fabsf((float)off);
      const float mn = fmaxf(m, s); const float al = __expf(m - mn), pw = __expf(s - mn);
      m = mn; l = l * al + pw;
      const uint4* vptr = (const uint4*)(proj + (size_t)(seq_base + kp) * ld + voff + hk * 64);
#pragma unroll
      for (int c = 0; c < 8; ++c) { uint4 v = vptr[c];
        o[8*c] = o[8*c] * al + pw * bflo(v.x); o[8*c+1] = o[8*c+1] * al + pw * bfhi(v.x); o[8*c+2] = o[8*c+2] * al + pw * bflo(v.y); o[8*c+3] = o[8*c+3] * al + pw * bfhi(v.y);
        o[8*c+4] = o[8*c+4] * al + pw * bflo(v.z); o[8*c+5] = o[8*c+5] * al + pw * bfhi(v.z); o[8*c+6] = o[8*c+6] * al + pw * bflo(v.w); o[8*c+7] = o[8*c+7] * al + pw * bfhi(v.w); }
    }
    const float inv = 1.f / l;
    uint4* op = (uint4*)(cat + (size_t)t * DM + cat_off + head * 64);
#pragma unroll
    for (int c = 0; c < 8; ++c) { uint4 v; v.x = pack2(o[8*c] * inv, o[8*c+1] * inv); v.y = pack2(o[8*c+2] * inv, o[8*c+3] * inv); v.z = pack2(o[8*c+4] * inv, o[8*c+5] * inv); v.w = pack2(o[8*c+6] * inv, o[8*c+7] * inv); op[c] = v; }
  }
}

typedef short s16x4 __attribute__((ext_vector_type(4)));
typedef __attribute__((address_space(3))) s16x4* lds_s16x4_ptr;
DI s16x4 vtr(const char* p) { return __builtin_amdgcn_ds_read_tr16_b64_v4i16((lds_s16x4_ptr)p); }

template <int MODE, int NQ, int TS, bool FAST = false>
DI void attn_unit(const bf16_t* __restrict__ proj, int ld, int seq_base, int kt0, int kt1, int koff, int voff,
                  int q0w, int qoff, int ooff, float slope2, float sink2, bf16_t* __restrict__ cat, char* lds, bf16_t* part_o, float* part_ml) {
  OPAQUE_TID(tid);
  const int lane = tid & 63, wave = tid >> 6, r32 = lane & 31, hh = lane >> 5;
  constexpr float C2 = 0.125f * LOG2E;
  constexpr int NS = 6;
  bf16x8 qf[NQ][4];
#pragma unroll
  for (int nq = 0; nq < NQ; ++nq) { const bf16_t* qp = proj + (size_t)(seq_base + TS * (q0w + 32 * nq + r32)) * ld + qoff + hh * 8;
#pragma unroll
    for (int ks = 0; ks < 4; ++ks) qf[nq][ks] = *(const bf16x8*)(qp + ks * 16); }
  f32x16 o[NQ][2];
  float m2[NQ], l[NQ];
#pragma unroll
  for (int nq = 0; nq < NQ; ++nq) {
    if (MODE == 0) {
      const size_t tok = (size_t)(seq_base + q0w + 32 * nq + r32);
      const bf16_t* po = part_o + tok * 512 + ooff + 4 * hh; const float* pm = part_ml + (tok * 8 + (ooff >> 6)) * 2;
      m2[nq] = pm[0]; l[nq] = hh ? 0.f : pm[1];
#pragma unroll
      for (int g = 0; g < 4; ++g) { const uint2 a = *(const uint2*)(po + 8 * g), b = *(const uint2*)(po + 32 + 8 * g);
        o[nq][0][4 * g] = bflo(a.x); o[nq][0][4 * g + 1] = bfhi(a.x); o[nq][0][4 * g + 2] = bflo(a.y); o[nq][0][4 * g + 3] = bfhi(a.y);
        o[nq][1][4 * g] = bflo(b.x); o[nq][1][4 * g + 1] = bfhi(b.x); o[nq][1][4 * g + 2] = bflo(b.y); o[nq][1][4 * g + 3] = bfhi(b.y); }
    } else {
      m2[nq] = (MODE == 2) ? sink2 : -1e30f; l[nq] = 0.f;
#pragma unroll
      for (int r = 0; r < 16; ++r) { o[nq][0][r] = 0.f; o[nq][1][r] = 0.f; }
    }
  }
  PG8_LAS unsigned char* L = (PG8_LAS unsigned char*)lds;
  const int kkey_ = wave * 8 + (lane >> 3);
  const bf16_t* kg = proj + (size_t)(seq_base + TS * kkey_) * ld + koff + (((lane & 7) ^ ((kkey_ >> 1) & 7)) * 8);
  const bf16_t* vg = proj + (size_t)(seq_base + TS * ((wave & 3) * 16 + (lane >> 2))) * ld + voff + ((wave >> 2) * 4 + (lane & 3)) * 8;
  const unsigned sdst = (unsigned)__builtin_amdgcn_readfirstlane(wave * 1024);
#define ATT_ISSUE(tile, slot) do { const size_t go_ = (size_t)(tile) * 64 * TS * ld; \
    __builtin_amdgcn_global_load_lds((const unsigned*)(kg + go_), (PG8_LAS unsigned*)(L + (slot) * 16384 + sdst), 16, 0, 0); \
    __builtin_amdgcn_global_load_lds((const unsigned*)(vg + go_), (PG8_LAS unsigned*)(L + (slot) * 16384 + 8192 + sdst), 16, 0, 0); } while (0)
  const int ktl = kt1 - 1;
  constexpr int TAB_OFF = 6 * 16384, TAB_N = (MODE == 3) ? 640 : 1024, TAB_ZERO = TAB_N / 2;
  if (MODE == 0 || MODE == 3) {
    float* tab = (float*)(lds + TAB_OFF);
    for (int e = tid; e < TAB_N; e += 512) {
      const int oo = e - TAB_ZERO, aa = oo < 0 ? -oo : oo;
      if (MODE == 0) {
        const int c = (aa <= 64 ? 1 : 0) + (((oo & 3) == 0 && aa <= 256) ? 1 : 0) + (((oo & 15) == 0 && aa <= 256) ? 1 : 0);
        tab[e] = c ? (-slope2 * (float)aa + (c == 1 ? 0.f : (c == 2 ? 1.f : 1.5849625007f))) : -1e30f;
      } else {
        tab[e] = (aa >= 17 && aa <= 64) ? -slope2 * (float)(16 * aa) : -1e30f;
      }
    }
  }
  if (MODE == 2) {
    float* tab = (float*)(lds + TAB_OFF) + (wave & 3) * 512;
#pragma unroll
    for (int i = 0; i < 4; ++i) { const int e = (wave >> 2) * 64 + lane + 128 * i; const int oo = e - 256, aa = oo < 0 ? -oo : oo; tab[e] = (aa <= 128) ? -slope2 * (float)aa : -1e30f; }
  }
  ATT_ISSUE(kt0, 0); ATT_ISSUE((kt0 + 1 < ktl ? kt0 + 1 : ktl), 1); ATT_ISSUE((kt0 + 2 < ktl ? kt0 + 2 : ktl), 2); ATT_ISSUE((kt0 + 3 < ktl ? kt0 + 3 : ktl), 3);
  asm volatile("s_waitcnt vmcnt(6) lgkmcnt(0)\n\ts_barrier" ::: "memory");
  int kfo4[4];
#pragma unroll
  for (int ks = 0; ks < 4; ++ks) kfo4[ks] = r32 * 128 + (((2 * ks + hh) ^ ((r32 >> 1) & 7)) << 4);
  const int vfo = 8192 + (4 * hh + ((lane & 15) >> 2)) * 64 + ((lane >> 4) & 1) * 32 + (lane & 3) * 8;
  const bool g2 = wave >= 4;
  f32x16 s[NQ][2];
  bf16x8 pf[NQ][4];
  constexpr int WIN = (MODE == 0) ? 256 : 64;
  auto tile_active = [&](int kt) -> bool { return (MODE != 0 && MODE != 3) || ((kt * 64 + 63 >= q0w - WIN) && (kt * 64 <= q0w + 32 * NQ - 1 + WIN)); };
  auto QK = [&](int slot) {
    const char* kb_ = lds + slot * 16384;
#pragma unroll
    for (int nq = 0; nq < NQ; ++nq)
#pragma unroll
      for (int r = 0; r < 16; ++r) { s[nq][0][r] = 0.f; s[nq][1][r] = 0.f; }
#pragma unroll
    for (int ks = 0; ks < 4; ++ks) {
      const bf16x8 k0 = *(const bf16x8*)(kb_ + kfo4[ks]), k1 = *(const bf16x8*)(kb_ + kfo4[ks] + 4096);
#pragma unroll
      for (int nq = 0; nq < NQ; ++nq) { s[nq][0] = MFMA32(k0, qf[nq][ks], s[nq][0]); s[nq][1] = MFMA32(k1, qf[nq][ks], s[nq][1]); }
    }
  };
  auto SM = [&](int kt) {
#pragma unroll
    for (int nq = 0; nq < NQ; ++nq) {
      f32x16& s0 = s[nq][0]; f32x16& s1 = s[nq][1];
      float mx = -1e30f;
      if (MODE == 1) {
      } else if (MODE == 0 || MODE == 3) {
        const float* tb = (const float*)(lds + TAB_OFF) + (kt * 64 + 4 * hh - (q0w + 32 * nq + r32) + TAB_ZERO);
#pragma unroll
        for (int r = 0; r < 16; ++r) {
          const float va = fmaf(s0[r], C2, tb[(r & 3) + 8 * (r >> 2)]), vb = fmaf(s1[r], C2, tb[(r & 3) + 8 * (r >> 2) + 32]);
          s0[r] = va; s1[r] = vb; mx = fmaxf(mx, fmaxf(va, vb));
        }
      } else {
        const float* tb = (const float*)(lds + TAB_OFF) + (wave & 3) * 512 + (kt * 64 + 4 * hh - (q0w + 32 * nq + r32) + 256);
#pragma unroll
        for (int r = 0; r < 16; ++r) {
          const float va = fmaf(s0[r], C2, tb[(r & 3) + 8 * (r >> 2)]), vb = fmaf(s1[r], C2, tb[(r & 3) + 8 * (r >> 2) + 32]);
          s0[r] = va; s1[r] = vb; mx = fmaxf(mx, fmaxf(va, vb));
        }
      }
      float mn;
      if (MODE == 1) {
        mn = sink2;
      } else {
        if (__any(mx > m2[nq] + 8.f)) {
          mx = fmaxf(mx, __shfl_xor(mx, 32));
          mn = fmaxf(m2[nq], mx);
          const float alpha = __builtin_amdgcn_exp2f(m2[nq] - mn);
          l[nq] *= alpha;
#pragma unroll
          for (int r = 0; r < 16; ++r) { o[nq][0][r] *= alpha; o[nq][1][r] *= alpha; }
          m2[nq] = mn;
        }
        mn = m2[nq];
      }
      float ls = 0.f;
#pragma unroll
      for (int r = 0; r < 16; ++r) {
        float pa, pb;
        if (MODE == 1) {
          if (FAST) { pa = __builtin_amdgcn_exp2f(s0[r]); pb = __builtin_amdgcn_exp2f(s1[r]); }
          else { pa = __builtin_amdgcn_exp2f(s0[r] - mn); pb = __builtin_amdgcn_exp2f(s1[r] - mn); }
        }
        else { pa = __builtin_amdgcn_exp2f(s0[r] - mn); pb = __builtin_amdgcn_exp2f(s1[r] - mn); }
        s0[r] = pa; s1[r] = pb; ls += pa + pb;
      }
      l[nq] += ls;
#pragma unroll
      for (int ks = 0; ks < 4; ++ks) {
        uint4 t4;
        const int rb = 8 * (ks & 1);
        if (ks < 2) { t4.x = pack2(s0[rb], s0[rb + 1]); t4.y = pack2(s0[rb + 2], s0[rb + 3]); t4.z = pack2(s0[rb + 4], s0[rb + 5]); t4.w = pack2(s0[rb + 6], s0[rb + 7]); }
        else { t4.x = pack2(s1[rb], s1[rb + 1]); t4.y = pack2(s1[rb + 2], s1[rb + 3]); t4.z = pack2(s1[rb + 4], s1[rb + 5]); t4.w = pack2(s1[rb + 6], s1[rb + 7]); }
        pf[nq][ks] = __builtin_bit_cast(bf16x8, t4);
      }
    }
  };
  auto PV = [&](int slot) {
    const char* vb_ = lds + slot * 16384 + vfo;
#pragma unroll
    for (int ks = 0; ks < 4; ++ks) {
      const s16x4 a0 = vtr(vb_ + ks * 1024), a1 = vtr(vb_ + ks * 1024 + 512);
      const s16x4 b0 = vtr(vb_ + 4096 + ks * 1024), b1 = vtr(vb_ + 4096 + ks * 1024 + 512);
      const bf16x8 v0 = __builtin_shufflevector(a0, a1, 0, 1, 2, 3, 4, 5, 6, 7);
      const bf16x8 v1 = __builtin_shufflevector(b0, b1, 0, 1, 2, 3, 4, 5, 6, 7);
#pragma unroll
      for (int nq = 0; nq < NQ; ++nq) { o[nq][0] = MFMA32(v0, pf[nq][ks], o[nq][0]); o[nq][1] = MFMA32(v1, pf[nq][ks], o[nq][1]); }
    }
  };
  int slot = 0, sp = 0;
  for (int kt = kt0; kt < kt1; ++kt) {
    { const int tn = (kt + 4 < ktl) ? kt + 4 : ktl; int s4 = slot + 4; if (s4 >= NS) s4 -= NS; ATT_ISSUE(tn, s4); }
    const bool act = tile_active(kt);
    if (!g2) {
      if (act) { QK(slot); SM(kt); PV(slot); }
    } else {
      if (kt > kt0 && tile_active(kt - 1)) PV(sp);
      if (act) { QK(slot); SM(kt); }
    }
    asm volatile("s_waitcnt vmcnt(6) lgkmcnt(0)\n\ts_barrier" ::: "memory");
    sp = slot; slot = (slot + 1 == NS) ? 0 : slot + 1;
  }
  if (g2 && tile_active(ktl)) PV(sp);
  asm volatile("s_waitcnt vmcnt(0)\n\ts_barrier" ::: "memory");
#undef ATT_ISSUE
  if (MODE == 3) {
#pragma unroll
    for (int nq = 0; nq < NQ; ++nq) {
      const float lt = l[nq] + __shfl_xor(l[nq], 32);
      const size_t tok = (size_t)(seq_base + TS * (q0w + 32 * nq + r32));
      bf16_t* po = part_o + tok * 512 + ooff + 4 * hh; float* pm = part_ml + (tok * 8 + (ooff >> 6)) * 2;
      if (hh == 0) { pm[0] = m2[nq]; pm[1] = lt; }
#pragma unroll
      for (int g = 0; g < 4; ++g) {
        uint2 a, b;
        a.x = pack2(o[nq][0][4 * g], o[nq][0][4 * g + 1]); a.y = pack2(o[nq][0][4 * g + 2], o[nq][0][4 * g + 3]);
        b.x = pack2(o[nq][1][4 * g], o[nq][1][4 * g + 1]); b.y = pack2(o[nq][1][4 * g + 2], o[nq][1][4 * g + 3]);
        *(uint2*)(po + 8 * g) = a; *(uint2*)(po + 32 + 8 * g) = b;
      }
    }
    return;
  }
#pragma unroll
  for (int nq = 0; nq < NQ; ++nq) {
    float lt = l[nq] + __shfl_xor(l[nq], 32);
    if (MODE == 2) lt += __builtin_amdgcn_exp2f(sink2 - m2[nq]);
    const float inv = 1.f / lt;
    bf16_t* op = cat + (size_t)(seq_base + q0w + 32 * nq + r32) * DM + ooff + 4 * hh;
#pragma unroll
    for (int g = 0; g < 4; ++g) {
      uint2 a, b;
      a.x = pack2(o[nq][0][4 * g] * inv, o[nq][0][4 * g + 1] * inv); a.y = pack2(o[nq][0][4 * g + 2] * inv, o[nq][0][4 * g + 3] * inv);
      b.x = pack2(o[nq][1][4 * g] * inv, o[nq][1][4 * g + 1] * inv); b.y = pack2(o[nq][1][4 * g + 2] * inv, o[nq][1][4 * g + 3] * inv);
      *(uint2*)(op + 8 * g) = a; *(uint2*)(op + 32 + 8 * g) = b;
    }
  }
}

DI void attn_far_phase(const Params& p, char* lds) {
  OPAQUE_TID(tid0);
  const int wave = tid0 >> 6;
  bf16_t* part_o = (bf16_t*)(p.h + (size_t)NTOK * 512);
  float* part_ml = (float*)(p.big + (size_t)NTOK * 2304);
  for (int u = blockIdx.x; u < 1024; u += gridDim.x) {
    const int head = u >> 7, v = (u & 127) ^ (((u >> 8) & 1) << 6);
    int seq_base, T16, rho, n0;
    if (v < 64) { seq_base = 0; T16 = PROMPT_T / 16; rho = v >> 2; n0 = (v & 3) * 256; }
    else { const int w = v - 64; seq_base = PROMPT_T + (w >> 4) * SAMPLE_T; T16 = SAMPLE_T / 16; rho = w & 15; n0 = 0; }
    int kt0 = (n0 - 64) >> 6; if (kt0 < 0) kt0 = 0;
    int kt1 = ((n0 + 255 + 64) >> 6) + 1; if (kt1 > (T16 >> 6)) kt1 = T16 >> 6;
    attn_unit<3, 1, 16>(p.big, 2304, seq_base + rho, kt0, kt1, 512 + head * 64, 1024 + head * 64, n0 + wave * 32, head * 64, head * 64,
                        exp2f(-(float)(head + 1)) * LOG2E, 0.f, p.xn, lds, part_o, part_ml);
  }
}

DI void attn_phase_l0(const Params& p, char* lds) {
  OPAQUE_TID(tid0);
  const int wave = tid0 >> 6;
  bf16_t* part_o = (bf16_t*)(p.h + (size_t)NTOK * 512);
  float* part_ml = (float*)(p.big + (size_t)NTOK * 2304);
  float mref;
  { float gq = fabsf(p.ab_qg[tid0 & 63]), gk = fabsf(p.ab_kg[tid0 & 63]);
#pragma unroll
    for (int o = 32; o > 0; o >>= 1) { gq = fmaxf(gq, __shfl_xor(gq, o)); gk = fmaxf(gk, __shfl_xor(gk, o)); }
    mref = 8.f * gq * gk * LOG2E; }
  for (int u = blockIdx.x; u < 1536; u += gridDim.x) {
    if (u < 512) {
      int seq_base, T, kvh, qt;
      const int ub = u & 255, xc = ub & 7, xi = ub >> 3;
      if (u < 256) { seq_base = 0; T = PROMPT_T; kvh = xc >> 2; qt = (xc & 3) * 32 + xi; }
      else { seq_base = PROMPT_T + (xc >> 1) * SAMPLE_T; T = SAMPLE_T; kvh = xc & 1; qt = xi; }
      const int head = kvh * 4 + (wave & 3);
      if (mref < 40.f) attn_unit<1, 2, 1, true>(p.big, 2304, seq_base, 0, T >> 6, 2048 + kvh * 64, 2176 + kvh * 64, qt * 128 + (wave >> 2) * 64, 1536 + head * 64, 512 + head * 64, 0.f, mref, p.xn, lds, nullptr, nullptr);
      else attn_unit<1, 2, 1, false>(p.big, 2304, seq_base, 0, T >> 6, 2048 + kvh * 64, 2176 + kvh * 64, qt * 128 + (wave >> 2) * 64, 1536 + head * 64, 512 + head * 64, 0.f, mref, p.xn, lds, nullptr, nullptr);
    } else {
      const int v = u - 512, vb = v & 255, xc = vb & 7, xi = vb >> 3;
      const int head = (v >> 8) * 2 + (xc >> 2), tok0 = ((xc & 3) * 32 + xi) * 256;
      const int seq_base = (tok0 < PROMPT_T) ? 0 : (PROMPT_T + ((tok0 - PROMPT_T) / SAMPLE_T) * SAMPLE_T);
      const int T = (tok0 < PROMPT_T) ? PROMPT_T : SAMPLE_T;
      const int q0b = tok0 - seq_base;
      int kt0 = (q0b - 256) >> 6; if (kt0 < 0) kt0 = 0;
      int kt1 = ((q0b + 255 + 256) >> 6) + 1; if (kt1 > (T >> 6)) kt1 = T >> 6;
      attn_unit<0, 1, 1>(p.big, 2304, seq_base, kt0, kt1, 512 + head * 64, 1024 + head * 64, q0b + wave * 32, head * 64, head * 64,
                         exp2f(-(float)(head + 1)) * LOG2E, 0.f, p.xn, lds, part_o, part_ml);
    }
  }
}

DI void attn_phase_l1(const Params& p, char* lds) {
  OPAQUE_TID(tid0);
  const int wave = tid0 >> 6;
  for (int u = blockIdx.x; u < 1024; u += gridDim.x) {
    const int ub = u & 255, xc = ub & 7, xi = ub >> 3;
    const int kvh = u >> 8, tok0 = (xc * 32 + xi) * 128;
    const int seq_base = (tok0 < PROMPT_T) ? 0 : (PROMPT_T + ((tok0 - PROMPT_T) / SAMPLE_T) * SAMPLE_T);
    const int T = (tok0 < PROMPT_T) ? PROMPT_T : SAMPLE_T;
    const int q0 = tok0 - seq_base, head = kvh * 4 + (wave & 3);
    int kt0 = (q0 - 128) >> 6; if (kt0 < 0) kt0 = 0;
    int kt1 = ((q0 + 127 + 128) >> 6) + 1; if (kt1 > (T >> 6)) kt1 = T >> 6;
    attn_unit<2, 2, 1>(p.big, 1536, seq_base, kt0, kt1, 1024 + kvh * 64, 1280 + kvh * 64, q0 + (wave >> 2) * 64, head * 64, head * 64,
                       exp2f(-0.5f * (float)(head + 1)) * LOG2E, p.c_sink[head] * LOG2E, p.xn, lds, nullptr, nullptr);
  }
}

#define XB_TMO      128
#define XB_XCNT(j)  (256  + 64 * (j))
#define XB_XSUB(j)  (1280 + 64 * (j))
#define XB_XGEN(j)  (2304 + 64 * (j))
#define XB_TOP      3328
#define XB_TOPGEN   3392
#define XCD_BAR_WORDS 3456
#define XB_SPIN_CAP (1u << 22)
DI unsigned xb_ld(unsigned* p) { return __hip_atomic_load(p, __ATOMIC_RELAXED, __HIP_MEMORY_SCOPE_AGENT); }
DI unsigned xb_add(unsigned* p, unsigned v) { return __hip_atomic_fetch_add(p, v, __ATOMIC_RELAXED, __HIP_MEMORY_SCOPE_AGENT); }
DI unsigned xb_xcc_id() { return (unsigned)__builtin_amdgcn_s_getreg((3 << 11) | 20) & 0xFu; }
#define XB_SPIN(cond, bar) do { unsigned _sp = 0; while (cond) { __builtin_amdgcn_s_sleep(1); \
    if ((++_sp & 255u) == 0u) { if (xb_ld(&(bar)[XB_TMO])) break; if (_sp > XB_SPIN_CAP) { atomicAdd(&(bar)[XB_TMO], 1u); break; } } } } while (0)
struct XcdBarrier { unsigned* bar; unsigned x; volatile unsigned* st; };
DI void xcd_barrier_complete(unsigned* bar, unsigned x, unsigned& nloc, unsigned& nx) {
  const unsigned G = gridDim.x;
  unsigned sum, cnt, mine, sp = 0u;
  for (;;) {
    sum = 0u; cnt = 0u; mine = 0u;
#pragma unroll
    for (unsigned j = 0; j < 16; ++j) { const unsigned c = xb_ld(&bar[XB_XCNT(j)]); sum += c; cnt += (c > 0u) ? 1u : 0u; mine = (j == x) ? c : mine; }
    if (sum == G) break;
    __builtin_amdgcn_s_sleep(1);
    if ((++sp & 255u) == 0u) { if (xb_ld(&bar[XB_TMO])) break; if (sp > XB_SPIN_CAP) { atomicAdd(&bar[XB_TMO], 1u); break; } }
  }
  nloc = mine > 0u ? mine : 1u; nx = cnt > 0u ? cnt : 1u;
}
DI void xcd_barrier(const XcdBarrier& b) {
  asm volatile("s_waitcnt vmcnt(0)" ::: "memory");
  __syncthreads();
  if (threadIdx.x == 0) {
    unsigned* bar = b.bar;
    __builtin_amdgcn_s_waitcnt(0);
    unsigned nloc = b.st[0], nx = b.st[1];
    if (nloc == 0u) { xcd_barrier_complete(bar, b.x, nloc, nx); b.st[0] = nloc; b.st[1] = nx; }
    const unsigned old = xb_add(&bar[XB_XSUB(b.x)], 1u);
    const unsigned gen = old / nloc;
    if (old + 1u == (gen + 1u) * nloc) {
      __builtin_amdgcn_fence(__ATOMIC_RELEASE, "agent");
      asm volatile("s_waitcnt vmcnt(0)" ::: "memory");
      const unsigned og = xb_add(&bar[XB_TOP], 1u);
      const unsigned tg = og / nx;
      if (og + 1u == (tg + 1u) * nx) xb_add(&bar[XB_TOPGEN], 1u);
      else XB_SPIN(xb_ld(&bar[XB_TOPGEN]) == tg, bar);
      __builtin_amdgcn_fence(__ATOMIC_ACQUIRE, "agent");
      xb_add(&bar[XB_XGEN(b.x)], 1u);
      asm volatile("s_waitcnt vmcnt(0)" ::: "memory");
    } else {
      XB_SPIN(xb_ld(&bar[XB_XGEN(b.x)]) == gen, bar);
      __builtin_amdgcn_fence(__ATOMIC_ACQUIRE, "agent");
      asm volatile("s_waitcnt vmcnt(0)" ::: "memory");
    }
  }
  __syncthreads();
}

__global__ void __launch_bounds__(512) fwd_megakernel(Params p) {
  cg::grid_group grid = cg::this_grid();
  __shared__ __attribute__((aligned(1024))) char lds[8 * HTB + 64 + 2048];
  volatile unsigned* bst = (volatile unsigned*)(lds + 8 * HTB);
  if (threadIdx.x < 2) bst[threadIdx.x] = 0u;
  __syncthreads();
  XcdBarrier xb; xb.bar = p.bar; xb.x = xb_xcc_id(); xb.st = bst;
  if (threadIdx.x == 0) (void)xb_add(&p.bar[XB_XCNT(xb.x)], 1u);
  convert_phase(p, 0, (float*)lds);
  init_phase(p);
  xcd_barrier(xb);
  if (p.pad) grid.sync();
  for (int layer = 0; layer < 2; ++layer) {
    for (int f = 0; f < 2; ++f) {
      if (f == 1) {
        if (layer == 0) gemm_phase(p.h16, p.wts + W_IN, NTOK, 2304, DM, EpiProj{p.big, 2304, p.ssq}, lds);
        else gemm_phase(p.h16, p.wts + W_IN, NTOK, 1536, DM, EpiProj{p.big, 1536, p.ssq}, lds);
        xcd_barrier(xb);
        if (layer == 0) {
          bprep_phase(p);
          attn_far_phase(p, lds);
          xcd_barrier(xb);
          attn_phase_l0(p, lds);
        } else {
          attn_phase_l1(p, lds);
        }
        xcd_barrier(xb);
        gemm_phase(p.xn, p.wts + W_OUT, NTOK, DM, DM, EpiResid{p.h16, p.h16, 1.0f, p.ssq}, lds);
        xcd_barrier(xb);
      }
      const int rows = NTOK / p.ffn_chunks;
      const bool last = (layer == 1 && f == 1);
      for (int c = 0; c < p.ffn_chunks; ++c) {
        const size_t ro = (size_t)c * rows;
        gemm_phase(p.h16 + ro * DM, p.wts + (f ? W_UPB : W_UPA), rows, 2 * DFF, DM, EpiUp{p.big, p.ssq + ro * 16}, lds);
        xcd_barrier(xb);
        gemm_phase(p.big, p.wts + (f ? W_DNB : W_DNA), rows, DM, DFF, EpiResid{p.h16 + ro * DM, (last ? p.xn : p.h16) + ro * DM, 0.5f, p.ssq + ro * 16}, lds, 1);
        xcd_barrier(xb);
      }
    }
    if (layer == 0) { convert_phase(p, 1, (float*)lds); xcd_barrier(xb); }
  }
  final_norm_phase(p);
}

extern "C" void kernel_launch(void* const* d_in, const int* in_sizes, int n_in, void* d_out, int out_size, void* d_ws, size_t ws_size, hipStream_t stream) {
  static int grid_blocks = 0;
  if (!grid_blocks) {
    int dev = 0, cus = 0, per_cu = 0;
    hipGetDevice(&dev);
    hipDeviceGetAttribute(&cus, hipDeviceAttributeMultiprocessorCount, dev);
    hipOccupancyMaxActiveBlocksPerMultiprocessor(&per_cu, fwd_megakernel, 512, 0);
    if (per_cu > 1) per_cu = 1;
    if (per_cu < 1) per_cu = 1;
    grid_blocks = cus * per_cu;
  }
  Params p{};
  p.x_prompt = (const float*)d_in[0]; p.x_sample = (const float*)d_in[1]; p.norm_g = (const float*)d_in[2];
  p.w1 = (const float*)d_in[3]; p.w3 = (const float*)d_in[4]; p.w2 = (const float*)d_in[5];
  p.ab_w_in = (const float*)d_in[6]; p.ab_w_out = (const float*)d_in[7]; p.ab_qg = (const float*)d_in[8]; p.ab_kg = (const float*)d_in[9];
  p.c_w_in = (const float*)d_in[10]; p.c_w_out = (const float*)d_in[11]; p.c_sink = (const float*)d_in[12]; p.final_g = (const float*)d_in[13];
  p.h = (float*)d_out;
  char* ws = (char*)d_ws;
  const size_t MiB = 1024 * 1024;
  p.wts = (bf16_t*)ws;
  p.xn = (bf16_t*)(ws + 40 * MiB);
  p.big = (bf16_t*)(ws + 104 * MiB);
  p.ffn_chunks = (ws_size >= 283 * MiB) ? 1 : 2;
  { const size_t tail = (p.ffn_chunks == 1 ? 280 : 250) * MiB; p.bar = (unsigned*)(ws + tail); p.ssq = (bf16_t*)(ws + tail + 65536); }
  p.h16 = (bf16_t*)d_out;
  hipMemsetAsync(p.bar, 0, XCD_BAR_WORDS * sizeof(unsigned), stream);
  p.pad = 0;
  void* args[] = {&p};
  hipError_t e = hipLaunchCooperativeKernel((void*)fwd_megakernel, dim3(grid_blocks), dim3(512), args, 0, stream);
  if (e != hipSuccess) fprintf(stderr, "cooperative launch failed: %s (grid %d)\n", hipGetErrorString(e), grid_blocks);
}
```
